# Optimizing an MI355X kernel written in HIP

```python
import math
import jax, jax.numpy as jnp
from jax import lax
import numpy as np

D_MODEL = 1024
BATCH = 2
SEQ = 8192
DEPTH = 1

HEAD_DIM = 64
FOX_HEADS = 8
DIFF_HEADS = 4
FOX_W = FOX_HEADS * HEAD_DIM
DIFF_QK_W = DIFF_HEADS * 2 * HEAD_DIM
DIFF_V_W = DIFF_HEADS * 2 * HEAD_DIM
N_BRANCH = 2
IN_COLS = 3 * FOX_W + FOX_HEADS + 2 * DIFF_QK_W + DIFF_V_W + N_BRANCH * D_MODEL
Q_BLOCK = 128
T5_BUCKETS = 32
T5_MAX_DIST = 128
N_EXPERTS = 32
TOP_K = 4
D_EXPERT = D_MODEL
SWIGLU_ALPHA = 1.702
SWIGLU_LIMIT = 7.0
EXPERT_BLOCK = 512
NORM_EPS = 1e-6
SUBLN_EPS = 1e-5

kernel_name = "hybrid_fox_diffattn_gptoss_moe_adaln"


def _rmsnorm(x, g, eps=NORM_EPS):
    xf = x.astype(jnp.float32)
    y = xf * lax.rsqrt(jnp.mean(xf * xf, axis=-1, keepdims=True) + eps)
    return (y * g.astype(jnp.float32)).astype(x.dtype)


def _t5_bucket(rel):
    n = jnp.maximum(rel, 0)
    max_exact = T5_BUCKETS // 2
    nf = jnp.maximum(n, max_exact).astype(jnp.float32)
    large = max_exact + (jnp.log(nf / max_exact) / math.log(T5_MAX_DIST / max_exact)
                         * (T5_BUCKETS - max_exact)).astype(jnp.int32)
    large = jnp.minimum(large, T5_BUCKETS - 1)
    return jnp.where(n < max_exact, n, large)


def _fox_attention(q, k, v, log_f):
    B, S, H, Dh = q.shape
    nb = S // Q_BLOCK
    F = jnp.cumsum(log_f, axis=1)
    Fk = F.transpose(0, 2, 1)
    qb = q.reshape(B, nb, Q_BLOCK, H, Dh).swapaxes(0, 1)
    Fb = F.reshape(B, nb, Q_BLOCK, H).swapaxes(0, 1)
    k_pos = jnp.arange(S)
    scale = Dh ** -0.5

    def block(args):
        qi, Fq, i = args
        q_pos = i * Q_BLOCK + jnp.arange(Q_BLOCK)
        s = jnp.einsum('bqhd,bkhd->bhqk', qi, k, preferred_element_type=jnp.float32) * scale
        s = s + (Fq.transpose(0, 2, 1)[..., None] - Fk[:, :, None, :])
        s = jnp.where(k_pos[None, :] <= q_pos[:, None], s, -jnp.inf)
        p = jax.nn.softmax(s, axis=-1)
        return jnp.einsum('bhqk,bkhd->bqhd', p.astype(v.dtype), v)

    out = lax.map(block, (qb, Fb, jnp.arange(nb)))
    return out.swapaxes(0, 1).reshape(B, S, H * Dh)


def _diff_attention(q1, q2, k1, k2, v, bias_table, lam):
    B, S, H, Dh = q1.shape
    nb = S // Q_BLOCK
    q1b = q1.reshape(B, nb, Q_BLOCK, H, Dh).swapaxes(0, 1)
    q2b = q2.reshape(B, nb, Q_BLOCK, H, Dh).swapaxes(0, 1)
    k_pos = jnp.arange(S)
    scale = Dh ** -0.5

    def block(args):
        q1i, q2i, i = args
        q_pos = i * Q_BLOCK + jnp.arange(Q_BLOCK)
        rel = q_pos[:, None] - k_pos[None, :]
        bias = bias_table[_t5_bucket(rel)].transpose(2, 0, 1)[None].astype(jnp.float32)
        causal = rel >= 0
        s1 = jnp.einsum('bqhd,bkhd->bhqk', q1i, k1, preferred_element_type=jnp.float32) * scale + bias
        s2 = jnp.einsum('bqhd,bkhd->bhqk', q2i, k2, preferred_element_type=jnp.float32) * scale + bias
        a1 = jax.nn.softmax(jnp.where(causal, s1, -jnp.inf), axis=-1)
        a2 = jax.nn.softmax(jnp.where(causal, s2, -jnp.inf), axis=-1)
        a = a1 - lam * a2
        return jnp.einsum('bhqk,bkhd->bqhd', a.astype(v.dtype), v)

    out = lax.map(block, (q1b, q2b, jnp.arange(nb)))
    return out.swapaxes(0, 1).reshape(B, S, H, 2 * Dh)


def _mixer(h, w_in, b_fgate, b_merge, lam_q1, lam_k1, lam_q2, lam_k2, diff_norm_g,
           t5_bias, w_br_fox, w_br_diff, w_o, lambda_init):
    B, S, _ = h.shape
    proj = h @ w_in
    sizes = [FOX_W, FOX_W, FOX_W, FOX_HEADS, DIFF_QK_W, DIFF_QK_W, DIFF_V_W]
    cuts = list(np.cumsum(sizes))
    fq, fk, fv, fl, dq, dk, dv, gl = jnp.split(proj, cuts, axis=-1)

    sh = (B, S, FOX_HEADS, HEAD_DIM)
    log_f = jax.nn.log_sigmoid(fl.astype(jnp.float32) + b_fgate.astype(jnp.float32))
    y_fox = _fox_attention(fq.reshape(sh), fk.reshape(sh), fv.reshape(sh), log_f)

    dq = dq.reshape(B, S, DIFF_HEADS, 2, HEAD_DIM)
    dk = dk.reshape(B, S, DIFF_HEADS, 2, HEAD_DIM)
    dv = dv.reshape(B, S, DIFF_HEADS, 2 * HEAD_DIM)
    lam = (jnp.exp(jnp.sum(lam_q1.astype(jnp.float32) * lam_k1.astype(jnp.float32)))
           - jnp.exp(jnp.sum(lam_q2.astype(jnp.float32) * lam_k2.astype(jnp.float32)))
           + lambda_init)
    yd = _diff_attention(dq[..., 0, :], dq[..., 1, :], dk[..., 0, :], dk[..., 1, :], dv, t5_bias, lam)
    yd = _rmsnorm(yd, diff_norm_g, SUBLN_EPS) * (1.0 - lambda_init)
    y_diff = yd.reshape(B, S, DIFF_V_W)

    gates = jax.nn.sigmoid(gl + b_merge)
    g_fox, g_diff = jnp.split(gates, N_BRANCH, axis=-1)
    merged = g_fox * (y_fox @ w_br_fox) + g_diff * (y_diff @ w_br_diff)
    return merged @ w_o


def _clamped_swiglu(u):
    x_glu = jnp.minimum(u[..., ::2], SWIGLU_LIMIT)
    x_lin = jnp.clip(u[..., 1::2], -SWIGLU_LIMIT, SWIGLU_LIMIT)
    return x_glu * jax.nn.sigmoid(SWIGLU_ALPHA * x_glu) * (x_lin + 1.0)


def _moe(h, w_router, b_router, w_up, b_up, w_down, b_down):
    N, D = h.shape
    logits = (h @ w_router + b_router).astype(jnp.float32)
    top_val, top_idx = lax.top_k(logits, TOP_K)
    gate = jax.nn.softmax(top_val, axis=-1)
    M = N * TOP_K
    flat_e = top_idx.reshape(M)
    flat_tok = jnp.arange(M, dtype=jnp.int32) // TOP_K
    flat_g = gate.reshape(M)
    order = jnp.argsort(flat_e)
    e_sorted = flat_e[order]
    counts = jnp.bincount(flat_e, length=N_EXPERTS)
    starts = jnp.cumsum(counts) - counts
    padded = ((counts + EXPERT_BLOCK - 1) // EXPERT_BLOCK) * EXPERT_BLOCK
    pends = jnp.cumsum(padded)
    pstarts = pends - padded
    dest = pstarts[e_sorted] + (jnp.arange(M) - starts[e_sorted])
    n_blocks = (M + EXPERT_BLOCK - 1) // EXPERT_BLOCK + N_EXPERTS
    P = n_blocks * EXPERT_BLOCK
    row_tok = jnp.zeros((P,), jnp.int32).at[dest].set(flat_tok[order])
    row_gate = jnp.zeros((P,), jnp.float32).at[dest].set(flat_g[order])
    block_e = jnp.minimum(jnp.searchsorted(pends, jnp.arange(n_blocks) * EXPERT_BLOCK, side='right'),
                          N_EXPERTS - 1).astype(jnp.int32)

    def block(args):
        tok, gw, e = args
        xb = h[tok]
        u = xb @ w_up[e] + b_up[e]
        y = _clamped_swiglu(u) @ w_down[e] + b_down[e]
        return y * gw[:, None].astype(y.dtype)

    yr = lax.map(block, (row_tok.reshape(n_blocks, EXPERT_BLOCK),
                         row_gate.reshape(n_blocks, EXPERT_BLOCK), block_e))
    return jnp.zeros((N, D), h.dtype).at[row_tok].add(yr.reshape(P, D))


def setup_inputs(seed: int = 0) -> dict:
    key = jax.random.key(seed)
    ks = jax.random.split(key, 26)
    f32 = jnp.float32
    nrm = lambda k, shape, s: (jax.random.normal(k, shape, f32) * s)
    D, L = D_MODEL, DEPTH
    return {
        "x": nrm(ks[0], (BATCH, SEQ, D), 1.0),
        "c": nrm(ks[1], (BATCH, D), 1.0),
        "w_ada": nrm(ks[2], (L, D, 6 * D), 0.5 * D ** -0.5),
        "b_ada": nrm(ks[3], (L, 6 * D), 0.02),
        "ln1_g": 1.0 + nrm(ks[4], (L, D), 0.02),
        "w_in": nrm(ks[5], (L, D, IN_COLS), D ** -0.5),
        "b_fgate": 2.0 + nrm(ks[6], (L, FOX_HEADS), 0.3),
        "b_merge": nrm(ks[7], (L, N_BRANCH * D), 0.02),
        "lam_q1": nrm(ks[8], (L, HEAD_DIM), 0.1),
        "lam_k1": nrm(ks[9], (L, HEAD_DIM), 0.1),
        "lam_q2": nrm(ks[10], (L, HEAD_DIM), 0.1),
        "lam_k2": nrm(ks[11], (L, HEAD_DIM), 0.1),
        "diff_norm_g": 1.0 + nrm(ks[12], (L, 2 * HEAD_DIM), 0.02),
        "t5_bias": nrm(ks[13], (T5_BUCKETS, DIFF_HEADS), 0.5),
        "w_br_fox": nrm(ks[14], (L, FOX_W, D), FOX_W ** -0.5),
        "w_br_diff": nrm(ks[15], (L, DIFF_V_W, D), DIFF_V_W ** -0.5),
        "w_o": nrm(ks[16], (L, D, D), D ** -0.5),
        "ln2_g": 1.0 + nrm(ks[17], (L, D), 0.02),
        "w_router": nrm(ks[18], (L, D, N_EXPERTS), D ** -0.5),
        "b_router": nrm(ks[19], (L, N_EXPERTS), 0.01),
        "w_up": nrm(ks[20], (L, N_EXPERTS, D, 2 * D_EXPERT), D ** -0.5),
        "b_up": nrm(ks[21], (L, N_EXPERTS, 2 * D_EXPERT), 0.01),
        "w_down": nrm(ks[22], (L, N_EXPERTS, D_EXPERT, D), D_EXPERT ** -0.5),
        "b_down": nrm(ks[23], (L, N_EXPERTS, D), 0.01),
        "final_g": 1.0 + nrm(ks[24], (D,), 0.02),
    }


def reference(x, c, w_ada, b_ada, ln1_g, w_in, b_fgate, b_merge, lam_q1, lam_k1, lam_q2, lam_k2,
              diff_norm_g, t5_bias, w_br_fox, w_br_diff, w_o, ln2_g, w_router, b_router,
              w_up, b_up, w_down, b_down, final_g):
    B, S, D = x.shape
    for l in range(DEPTH):
        lambda_init = 0.8 - 0.6 * math.exp(-0.3 * l)
        mod = jax.nn.silu(c) @ w_ada[l] + b_ada[l]
        sh1, sc1, g1, sh2, sc2, g2 = jnp.split(mod[:, None, :], 6, axis=-1)
        h = _rmsnorm(x, ln1_g[l]) * (1.0 + sc1) + sh1
        x = x + g1 * _mixer(h, w_in[l], b_fgate[l], b_merge[l], lam_q1[l], lam_k1[l], lam_q2[l],
                            lam_k2[l], diff_norm_g[l], t5_bias, w_br_fox[l], w_br_diff[l], w_o[l],
                            lambda_init)
        h = _rmsnorm(x, ln2_g[l]) * (1.0 + sc2) + sh2
        y = _moe(h.reshape(B * S, D), w_router[l], b_router[l], w_up[l], b_up[l], w_down[l], b_down[l])
        x = x + g2 * y.reshape(B, S, D)
    return _rmsnorm(x, final_g)
```

```cpp
#define MK_PER_PHASE 1
#include <hip/hip_runtime.h>
#include <cstdio>
#include <cstdint>

constexpr int NB = 2, SEQ = 8192, DM = 1024, M = NB * SEQ;
constexpr int INCOLS = 5128, NPROJ = 5120;
constexpr int PC_FQ = 0, PC_FK = 512, PC_FV = 1024, PC_DQ = 1536, PC_DK = 2048, PC_DV = 2560, PC_G = 3072;
constexpr int NE = 32, TOPK = 4, NUP = 2048, DFF = 1024;
constexpr int PMAX = 73728;
constexpr float LOG2E = 1.4426950408889634f;
constexpr float QSCALE = 0.125f * LOG2E;
constexpr float LAMBDA_INIT = 0.2f;
namespace pg8 {
#define PG8_LAS __attribute__((address_space(3)))
typedef unsigned short bf16_t;
typedef short bf16x8 __attribute__((ext_vector_type(8)));
typedef float f32x4 __attribute__((ext_vector_type(4)));
typedef unsigned u32x4 __attribute__((ext_vector_type(4)));
constexpr int BM = 256, BK = 64, HALF = 128, HTB = HALF * BK * 2  , STAGE_BYTES = 8 * HTB, NXCD = 8, WGM = 8;

__host__ __device__ __forceinline__ int lds_byte(int r, int c) { const int st = (r >> 4) * 2 + (c >> 5), rr = r & 15, cc = c & 31, ob = rr * 64 + cc * 2; return st * 1024 + (ob ^ (((ob >> 9) & 1) << 5)); }
__host__ __device__ __forceinline__ void stage_rc(int b, int& R, int& C) { const int st = b / 1024, sb = b % 1024, swz = sb ^ (((sb >> 9) & 1) << 5); R = (st >> 1) * 16 + swz / 64; C = (st & 1) * 32 + (swz % 64) / 2; }
__host__ __device__ __forceinline__ int perm32(int rho) { const int n = rho >> 4, i = rho & 15; return 8 * (i >> 2) + 4 * n + (i & 3); }

struct Unit { int pm, pn, pb, e; };
struct Gemm { const bf16_t* A; const bf16_t* Bt; int M, N, K; };

struct StaticOrder {
    int nM, nN, nwg, G, c;
    __host__ __device__ void init(int M, int N, int G_, int c_) { nM = M / BM; nN = N / BM; nwg = nM * nN; G = G_; c = c_; }
    __host__ __device__ bool next(int i, Unit& u) const {
        const long L = (long)i * G + c; if (L >= nwg) return false;
        int wgid = (int)L; { const int q = nwg / NXCD, r = nwg % NXCD, xcd = wgid % NXCD, off = wgid / NXCD; wgid = (xcd < r ? xcd * (q + 1) : r * (q + 1) + (xcd - r) * q) + off; }
        const int nig = WGM * nN, gid = wgid / nig, fm = gid * WGM, gsz = (nM - fm) < WGM ? (nM - fm) : WGM;
        u.pm = fm + ((wgid % nig) % gsz); u.pn = (wgid % nig) / gsz; u.pb = u.pn; u.e = 0; return true;
    }
    __device__ __forceinline__ void a_ready(const Unit&) const {}
    __device__ __forceinline__ void done(const Unit&) const {}
};

__device__ __forceinline__ unsigned cvt_pk_bf16(float lo, float hi) { unsigned r; asm volatile("v_cvt_pk_bf16_f32 %0, %1, %2" : "=v"(r) : "v"(lo), "v"(hi)); return r; }
typedef float f32x2 __attribute__((ext_vector_type(2)));
template <class Epi, class Sched, bool ALIGN_EPI = false, bool SP2 = false>
__device__ __forceinline__ void gemm_phase(PG8_LAS unsigned char* lds, const Gemm g, const Sched& S, const Epi& E) {
    const int tid = threadIdx.x, wid = __builtin_amdgcn_readfirstlane(tid >> 6), lane = tid & 63, wr = wid >> 2, wc = wid & 3, fr = lane & 15, fq = lane >> 4;
    const int K = g.K, nt = K / BK;
    unsigned voffA[2], voffB[2];
#pragma unroll
    for (int i = 0; i < 2; ++i) { int R, C; stage_rc(tid * 16 + i * 8192, R, C); const int Rb = Epi::PERM ? ((R & ~31) + perm32(R & 31)) : R;
        voffA[i] = (unsigned)(R * K + C) * 2u; voffB[i] = (unsigned)(Rb * K + C) * 2u; }
    const size_t kstep = (size_t)(BK * 2);
    const size_t hstep = (size_t)HALF * K * 2;
    const size_t tstep = 2 * hstep;
    const unsigned ldsw = (unsigned)wid * 1024u;
    const int aoff = lds_byte(wr * 64 + fr, fq * 8), boff = lds_byte(wc * 32 + fr, fq * 8);
#define PG8_SA(b, h) (((b) * 2 + (h)) * HTB)
#define PG8_SB(b, h) ((4 + (b) * 2 + (h)) * HTB)
#define PG8_STAGE(bufoff, gbase, voff) do { _Pragma("unroll") for (int _i = 0; _i < 2; ++_i) \
        __builtin_amdgcn_global_load_lds((const unsigned*)((const char*)(gbase) + (voff)[_i]), (PG8_LAS unsigned*)(lds + (bufoff) + ldsw + _i * 8192), 16, 0, 0); } while (0)
#define PG8_LDA(dst, b, h) do { _Pragma("unroll") for (int m = 0; m < 4; ++m) _Pragma("unroll") for (int k = 0; k < 2; ++k) dst[m][k] = *(const PG8_LAS bf16x8*)(lds + PG8_SA(b, h) + aoff + m * 2048 + k * 1024); } while (0)
#define PG8_LDB(dst, b, h) do { _Pragma("unroll") for (int n = 0; n < 2; ++n) _Pragma("unroll") for (int k = 0; k < 2; ++k) dst[n][k] = *(const PG8_LAS bf16x8*)(lds + PG8_SB(b, h) + boff + n * 2048 + k * 1024); } while (0)
#define PG8_MMA(ai, bj, At, Bt) do { __builtin_amdgcn_s_setprio(1); _Pragma("unroll") for (int m = 0; m < 4; ++m) _Pragma("unroll") for (int n = 0; n < 2; ++n) _Pragma("unroll") for (int k = 0; k < 2; ++k) \
        acc[ai][bj][m][n] = __builtin_amdgcn_mfma_f32_16x16x32_bf16(Bt[n][k], At[m][k], acc[ai][bj][m][n], 0, 0, 0); __builtin_amdgcn_s_setprio(0); } while (0)
#define PG8_WAIT_V(n) asm volatile("s_waitcnt vmcnt(" #n ")" ::: "memory")
#define PG8_WAIT_L(n) asm volatile("s_waitcnt lgkmcnt(" #n ")" ::: "memory")
#define PG8_BAR __builtin_amdgcn_s_barrier()
#define PG8_SCHED __builtin_amdgcn_sched_barrier(0)
    Unit cur, nxt; int ui = 0;
    if (!S.next(0, cur)) return;
    f32x4 acc[2][2][4][2];
#pragma unroll
    for (int a = 0; a < 2; ++a)
#pragma unroll
        for (int b = 0; b < 2; ++b)
#pragma unroll
            for (int m = 0; m < 4; ++m)
#pragma unroll
                for (int n = 0; n < 2; ++n) acc[a][b][m][n] = (f32x4){0.f, 0.f, 0.f, 0.f};
    bf16x8 At[4][2], B0[2][2], B1[2][2];
    const char* cA = (const char*)g.A + (size_t)cur.pm * tstep; const char* cB = (const char*)g.Bt + (size_t)cur.pb * tstep;
    S.a_ready(cur);
    if constexpr (SP2) {
        PG8_STAGE(PG8_SB(0, 0), cB, voffB); PG8_STAGE(PG8_SB(0, 1), cB + hstep, voffB); PG8_STAGE(PG8_SA(0, 0), cA, voffA); PG8_STAGE(PG8_SA(0, 1), cA + hstep, voffA);
        if (wr == 1) PG8_BAR;
        PG8_WAIT_V(2); PG8_BAR;
        PG8_STAGE(PG8_SB(1, 0), cB + kstep, voffB); PG8_STAGE(PG8_SA(1, 0), cA + kstep, voffA); PG8_STAGE(PG8_SB(1, 1), cB + hstep + kstep, voffB);
        PG8_WAIT_V(6); PG8_BAR;
    } else {
        PG8_STAGE(PG8_SB(0, 0), cB, voffB); PG8_STAGE(PG8_SA(0, 0), cA, voffA); PG8_STAGE(PG8_SB(0, 1), cB + hstep, voffB); PG8_STAGE(PG8_SA(0, 1), cA + hstep, voffA);
        if (wr == 1) PG8_BAR;
        PG8_WAIT_V(4); PG8_BAR;
        PG8_STAGE(PG8_SB(1, 0), cB + kstep, voffB); PG8_STAGE(PG8_SA(1, 0), cA + kstep, voffA); PG8_STAGE(PG8_SB(1, 1), cB + hstep + kstep, voffB);
        PG8_WAIT_V(6); PG8_BAR;
    }
    for (;;) {
        const bool has_next = S.next(ui + 1, nxt);
        const char* nA = has_next ? (const char*)g.A + (size_t)nxt.pm * tstep : cA; const char* nB = has_next ? (const char*)g.Bt + (size_t)nxt.pb * tstep : cB;
        for (int t = 0; t < nt; t += 2) {
            const bool last = (t == nt - 2);
            const char* a1 = cA + (size_t)(t + 1) * kstep;
            const char* a2 = last ? nA : cA + (size_t)(t + 2) * kstep; const char* b2 = last ? nB : cB + (size_t)(t + 2) * kstep;
            const char* a3 = a2 + kstep; const char* b3 = b2 + kstep;
            if (last && has_next) S.a_ready(nxt);
            if constexpr (SP2) {
            PG8_LDB(B0, 0, 0); PG8_LDB(B1, 0, 1); PG8_SCHED; PG8_LDA(At, 0, 0); PG8_STAGE(PG8_SA(1, 1), a1 + hstep, voffA);
            PG8_WAIT_V(8); PG8_WAIT_L(0); PG8_BAR; PG8_MMA(0, 0, At, B0); PG8_MMA(0, 1, At, B1); PG8_BAR; PG8_SCHED;
            PG8_LDA(At, 0, 1); PG8_STAGE(PG8_SB(0, 0), b2, voffB); PG8_STAGE(PG8_SB(0, 1), b2 + hstep, voffB); PG8_STAGE(PG8_SA(0, 0), a2, voffA);
            PG8_WAIT_V(8); PG8_WAIT_L(0); PG8_BAR; PG8_MMA(1, 0, At, B0); PG8_MMA(1, 1, At, B1); PG8_BAR; PG8_SCHED;
            PG8_LDB(B0, 1, 0); PG8_LDB(B1, 1, 1); PG8_SCHED; PG8_LDA(At, 1, 0); PG8_STAGE(PG8_SA(0, 1), a2 + hstep, voffA);
            PG8_WAIT_V(8); PG8_WAIT_L(0); PG8_BAR; PG8_MMA(0, 0, At, B0); PG8_MMA(0, 1, At, B1); PG8_BAR; PG8_SCHED;
            PG8_LDA(At, 1, 1); PG8_STAGE(PG8_SB(1, 0), b3, voffB); PG8_STAGE(PG8_SB(1, 1), b3 + hstep, voffB); PG8_STAGE(PG8_SA(1, 0), a3, voffA);
            PG8_WAIT_V(8); PG8_WAIT_L(0); PG8_BAR; PG8_MMA(1, 0, At, B0); PG8_MMA(1, 1, At, B1); PG8_BAR; PG8_SCHED;
            } else {
            PG8_LDB(B0, 0, 0); PG8_SCHED; PG8_LDA(At, 0, 0); PG8_STAGE(PG8_SA(1, 1), a1 + hstep, voffA);
            PG8_WAIT_L(8); PG8_BAR; PG8_WAIT_L(0); PG8_MMA(0, 0, At, B0); PG8_BAR; PG8_SCHED;
            PG8_LDB(B1, 0, 1); PG8_STAGE(PG8_SB(0, 0), b2, voffB);
            PG8_BAR; PG8_WAIT_L(0); PG8_MMA(0, 1, At, B1); PG8_BAR;
            PG8_LDA(At, 0, 1); PG8_STAGE(PG8_SA(0, 0), a2, voffA);
            PG8_BAR; PG8_WAIT_L(0); PG8_MMA(1, 0, At, B0); PG8_BAR; PG8_SCHED;
            PG8_STAGE(PG8_SB(0, 1), b2 + hstep, voffB);
            PG8_WAIT_V(6); PG8_BAR; PG8_MMA(1, 1, At, B1); PG8_BAR;
            PG8_LDB(B0, 1, 0); PG8_SCHED; PG8_LDA(At, 1, 0); PG8_STAGE(PG8_SA(0, 1), a2 + hstep, voffA);
            PG8_WAIT_L(8); PG8_BAR; PG8_WAIT_L(0); PG8_MMA(0, 0, At, B0); PG8_BAR; PG8_SCHED;
            PG8_LDB(B1, 1, 1); PG8_STAGE(PG8_SB(1, 0), b3, voffB);
            PG8_BAR; PG8_WAIT_L(0); PG8_MMA(0, 1, At, B1); PG8_BAR;
            PG8_LDA(At, 1, 1); PG8_STAGE(PG8_SA(1, 0), a3, voffA);
            PG8_BAR; PG8_WAIT_L(0); PG8_MMA(1, 0, At, B0); PG8_BAR; PG8_SCHED;
            PG8_STAGE(PG8_SB(1, 1), b3 + hstep, voffB);
            PG8_WAIT_V(6); PG8_BAR; PG8_MMA(1, 1, At, B1); PG8_BAR;
            }
        }
        if constexpr (ALIGN_EPI) { if (wr == 0) PG8_BAR; }
        if constexpr (!Epi::AFTER_DRAIN) { E(acc, cur, wr, wc, fr, fq); S.done(cur); }
        if (!has_next) break;
#pragma unroll
        for (int a = 0; a < 2; ++a)
#pragma unroll
            for (int b = 0; b < 2; ++b)
#pragma unroll
                for (int m = 0; m < 4; ++m)
#pragma unroll
                    for (int n = 0; n < 2; ++n) acc[a][b][m][n] = (f32x4){0.f, 0.f, 0.f, 0.f};
        cur = nxt; cA = nA; cB = nB; ++ui;
        if constexpr (ALIGN_EPI) { if (wr == 1) PG8_BAR; }
    }
    PG8_WAIT_V(0);
    if constexpr (!ALIGN_EPI) { if (wr == 0) PG8_BAR; }
    PG8_BAR;
    if constexpr (Epi::AFTER_DRAIN) { E.fused(acc, cur, wr, wc, fr, fq, lds, wid, lane); S.done(cur); }
#undef PG8_SA
#undef PG8_SB
#undef PG8_STAGE
#undef PG8_LDA
#undef PG8_LDB
#undef PG8_MMA
#undef PG8_WAIT_V
#undef PG8_WAIT_L
#undef PG8_BAR
#undef PG8_SCHED
}
}
namespace epi {
using pg8::f32x4; using pg8::u32x4; using pg8::Unit; using pg8::bf16_t; using pg8::BM; using pg8::HALF; using pg8::cvt_pk_bf16;
typedef unsigned u32x2 __attribute__((ext_vector_type(2)));
__device__ __forceinline__ float bflo(unsigned w) { return __uint_as_float(w << 16); }
__device__ __forceinline__ float bfhi(unsigned w) { return __uint_as_float(w & 0xffff0000u); }
__device__ __forceinline__ float sigmoidf_fast(float z) { return __builtin_amdgcn_rcpf(1.0f + __builtin_amdgcn_exp2f(-z * LOG2E)); }

struct EpiProj {
    static constexpr bool PERM = true, AFTER_DRAIN = false;
    bf16_t* O; const float* bmerge;
    __device__ __forceinline__ void operator()(const f32x4 (&acc)[2][2][4][2], const Unit& u, int wr, int wc, int fr, int fq) const {
        const int row0 = u.pm * BM + wr * 64 + fr, col0 = u.pn * BM + wc * 32 + 8 * fq;
        const bool isq = (u.pn < 2) || (u.pn == 6) || (u.pn == 7), isg = (u.pn >= 12);
        const float sc = isq ? QSCALE : 1.0f;
        f32x4 bv[2][2];
#pragma unroll
        for (int bj = 0; bj < 2; ++bj)
#pragma unroll
            for (int n = 0; n < 2; ++n) bv[bj][n] = isg ? *(const f32x4*)(bmerge + (col0 - PC_G) + bj * HALF + 4 * n) : (f32x4){0.f, 0.f, 0.f, 0.f};
#pragma unroll
        for (int ai = 0; ai < 2; ++ai)
#pragma unroll
            for (int m = 0; m < 4; ++m) { bf16_t* rowp = O + (size_t)(row0 + ai * HALF + m * 16) * NPROJ + col0;
#pragma unroll
                for (int bj = 0; bj < 2; ++bj) { f32x4 v0 = acc[ai][bj][m][0], v1 = acc[ai][bj][m][1];
                    if (isg) { v0 = v0 + bv[bj][0]; v1 = v1 + bv[bj][1];
#pragma unroll
                        for (int e = 0; e < 4; ++e) { v0[e] = sigmoidf_fast(v0[e]); v1[e] = sigmoidf_fast(v1[e]); } }
                    else { v0 = v0 * sc; v1 = v1 * sc; }
                    u32x4 w; w.x = cvt_pk_bf16(v0[0], v0[1]); w.y = cvt_pk_bf16(v0[2], v0[3]); w.z = cvt_pk_bf16(v1[0], v1[1]); w.w = cvt_pk_bf16(v1[2], v1[3]);
                    *(u32x4*)(rowp + bj * HALF) = w; } }
    }
};
template <int MODE> struct EpiBranch {
    static constexpr bool PERM = true, AFTER_DRAIN = false;
    const bf16_t* PROJ; const bf16_t* T1in; bf16_t* O;
    __device__ __forceinline__ void operator()(const f32x4 (&acc)[2][2][4][2], const Unit& u, int wr, int wc, int fr, int fq) const {
        const int row0 = u.pm * BM + wr * 64 + fr, col0 = u.pn * BM + wc * 32 + 8 * fq;
#pragma unroll
        for (int ai = 0; ai < 2; ++ai)
#pragma unroll
            for (int m = 0; m < 4; ++m) { const size_t row = (size_t)(row0 + ai * HALF + m * 16);
#pragma unroll
                for (int bj = 0; bj < 2; ++bj) { const int col = col0 + bj * HALF;
                    const u32x4 g = *(const u32x4*)(PROJ + row * NPROJ + PC_G + MODE * 1024 + col);
                    f32x4 v0 = acc[ai][bj][m][0], v1 = acc[ai][bj][m][1];
                    v0[0] *= bflo(g.x); v0[1] *= bfhi(g.x); v0[2] *= bflo(g.y); v0[3] *= bfhi(g.y); v1[0] *= bflo(g.z); v1[1] *= bfhi(g.z); v1[2] *= bflo(g.w); v1[3] *= bfhi(g.w);
                    if (MODE == 1) { const u32x4 t = *(const u32x4*)(T1in + row * DM + col);
                        v0[0] += bflo(t.x); v0[1] += bfhi(t.x); v0[2] += bflo(t.y); v0[3] += bfhi(t.y); v1[0] += bflo(t.z); v1[1] += bfhi(t.z); v1[2] += bflo(t.w); v1[3] += bfhi(t.w); }
                    u32x4 w; w.x = cvt_pk_bf16(v0[0], v0[1]); w.y = cvt_pk_bf16(v0[2], v0[3]); w.z = cvt_pk_bf16(v1[0], v1[1]); w.w = cvt_pk_bf16(v1[2], v1[3]);
                    *(u32x4*)(O + row * DM + col) = w; } }
    }
};
struct EpiWo {
    static constexpr bool PERM = false, AFTER_DRAIN = false;
    const float* x; const float* mod; float* X1;
    __device__ __forceinline__ void operator()(const f32x4 (&acc)[2][2][4][2], const Unit& u, int wr, int wc, int fr, int fq) const {
        const int row0 = u.pm * BM + wr * 64 + fr, col0 = u.pn * BM + wc * 32 + 4 * fq;
        const float* g1 = mod + (size_t)((u.pm * BM) / SEQ) * (6 * DM) + 2 * DM;
        f32x4 gv[2][2];
#pragma unroll
        for (int bj = 0; bj < 2; ++bj)
#pragma unroll
            for (int n = 0; n < 2; ++n) gv[bj][n] = *(const f32x4*)(g1 + col0 + bj * HALF + n * 16);
#pragma unroll
        for (int ai = 0; ai < 2; ++ai)
#pragma unroll
            for (int m = 0; m < 4; ++m) { const size_t off = (size_t)(row0 + ai * HALF + m * 16) * DM + col0;
#pragma unroll
                for (int bj = 0; bj < 2; ++bj)
#pragma unroll
                    for (int n = 0; n < 2; ++n) { const f32x4 xv = *(const f32x4*)(x + off + bj * HALF + n * 16);
                        *(f32x4*)(X1 + off + bj * HALF + n * 16) = xv + gv[bj][n] * acc[ai][bj][m][n]; } }
    }
};
struct EpiUp {
    static constexpr bool PERM = true, AFTER_DRAIN = false;
    const float* bup; bf16_t* ACT;
    __device__ __forceinline__ float act1(float a, float b) const {
        const float glu = fminf(a, 7.0f), lin = fminf(fmaxf(b, -7.0f), 7.0f);
        return glu * sigmoidf_fast(1.702f * glu) * (lin + 1.0f);
    }
    __device__ __forceinline__ void operator()(const f32x4 (&acc)[2][2][4][2], const Unit& u, int wr, int wc, int fr, int fq) const {
        const int row0 = u.pm * BM + wr * 64 + fr, col0 = u.pn * BM + wc * 32 + 8 * fq;
        const float* bb = bup + (size_t)u.e * NUP;
        f32x4 bv[2][2];
#pragma unroll
        for (int bj = 0; bj < 2; ++bj)
#pragma unroll
            for (int n = 0; n < 2; ++n) bv[bj][n] = *(const f32x4*)(bb + col0 + bj * HALF + 4 * n);
#pragma unroll
        for (int ai = 0; ai < 2; ++ai)
#pragma unroll
            for (int m = 0; m < 4; ++m) { bf16_t* rowp = ACT + (size_t)(row0 + ai * HALF + m * 16) * DFF + (col0 >> 1);
#pragma unroll
                for (int bj = 0; bj < 2; ++bj) { const f32x4 v0 = acc[ai][bj][m][0] + bv[bj][0], v1 = acc[ai][bj][m][1] + bv[bj][1];
                    u32x2 w; w.x = cvt_pk_bf16(act1(v0[0], v0[1]), act1(v0[2], v0[3])); w.y = cvt_pk_bf16(act1(v1[0], v1[1]), act1(v1[2], v1[3]));
                    *(u32x2*)(rowp + bj * (HALF / 2)) = w; } }
    }
};
struct EpiDown {
    static constexpr bool PERM = true, AFTER_DRAIN = false;
    const float* bdn; const float* sgate; bf16_t* YP;
    __device__ __forceinline__ void operator()(const f32x4 (&acc)[2][2][4][2], const Unit& u, int wr, int wc, int fr, int fq) const {
        const int row0 = u.pm * BM + wr * 64 + fr, col0 = u.pn * BM + wc * 32 + 8 * fq;
        const float* bb = bdn + (size_t)u.e * DM;
        f32x4 bv[2][2];
#pragma unroll
        for (int bj = 0; bj < 2; ++bj)
#pragma unroll
            for (int n = 0; n < 2; ++n) bv[bj][n] = *(const f32x4*)(bb + col0 + bj * HALF + 4 * n);
#pragma unroll
        for (int ai = 0; ai < 2; ++ai)
#pragma unroll
            for (int m = 0; m < 4; ++m) { const size_t row = (size_t)(row0 + ai * HALF + m * 16); const float gt = sgate[row]; bf16_t* rowp = YP + row * DM + col0;
#pragma unroll
                for (int bj = 0; bj < 2; ++bj) { const f32x4 v0 = (acc[ai][bj][m][0] + bv[bj][0]) * gt, v1 = (acc[ai][bj][m][1] + bv[bj][1]) * gt;
                    u32x4 w; w.x = cvt_pk_bf16(v0[0], v0[1]); w.y = cvt_pk_bf16(v0[2], v0[3]); w.z = cvt_pk_bf16(v1[0], v1[1]); w.w = cvt_pk_bf16(v1[2], v1[3]);
                    *(u32x4*)(rowp + bj * HALF) = w; } }
    }
};
struct ListOrder {
    const PG8_LAS int* lst; int n;
    __device__ __forceinline__ bool next(int i, Unit& u) const { if (i >= n) return false; u.pm = lst[4 * i]; u.pn = lst[4 * i + 1]; u.pb = lst[4 * i + 2]; u.e = lst[4 * i + 3]; return true; }
    __device__ __forceinline__ void a_ready(const Unit&) const {}
    __device__ __forceinline__ void done(const Unit&) const {}
};
}
constexpr size_t MiB = 1u << 20;
constexpr size_t WS_CTL = 0, CTL_ZERO_BYTES = 1 * MiB;
constexpr size_t WS_MOD = 1 * MiB;
constexpr size_t WS_SCAL = WS_MOD + 64 * 1024;
constexpr size_t WS_LUT = WS_MOD + 128 * 1024;
constexpr size_t WS_BT = WS_MOD + 256 * 1024;
constexpr size_t WS_FLOC = 2 * MiB;
constexpr size_t WS_F2 = 3 * MiB;
constexpr size_t WS_TOPE = 4 * MiB, WS_RANK = WS_TOPE + 256 * 1024, WS_GATE = WS_RANK + 256 * 1024, WS_SLOT = WS_GATE + 256 * 1024;
constexpr size_t WS_SGATE = 5 * MiB;
constexpr size_t WS_WIN = 6 * MiB;
constexpr size_t WS_WBF = 16 * MiB, WS_WBD = 17 * MiB, WS_WO = 18 * MiB;
constexpr size_t WS_WUP = 20 * MiB;
constexpr size_t WS_WDN = 148 * MiB;
constexpr size_t WS_XN = 212 * MiB;
constexpr size_t WS_PROJ = 244 * MiB;
constexpr size_t WS_XG = WS_PROJ;
constexpr size_t WS_YFOX = 404 * MiB;
constexpr size_t WS_OD = 420 * MiB;
constexpr size_t WS_YD = 452 * MiB;
constexpr size_t WS_T1 = 468 * MiB;
constexpr size_t WS_MRG = 500 * MiB;
constexpr size_t WS_ACT = 532 * MiB;
constexpr size_t WS_YP = 676 * MiB;
constexpr size_t WS_END = 820 * MiB;
static_assert(WS_PROJ + (size_t)M * NPROJ * 2 <= WS_YFOX && WS_XG + (size_t)PMAX * DM * 2 <= WS_YFOX && WS_ACT + (size_t)PMAX * DM * 2 <= WS_YP && WS_YP + (size_t)PMAX * DM * 2 <= WS_END, "d_ws map");
constexpr int CW_CNT = 1024;
constexpr int CW_BAR = 4096;

constexpr int RING_OFF = 0, RING_BYTES = 131072;
constexpr int LDSCTL_OFF = RING_BYTES, MISC_OFF = LDSCTL_OFF + 320;
constexpr int TAB_OFF = LDSCTL_OFF + 1024;
constexpr int LDS_BYTES = 147456;
constexpr int NWAVES = 8;
#define GAS __attribute__((address_space(1)))
#define LAS __attribute__((address_space(3)))
typedef unsigned short bf16;
typedef unsigned v4u __attribute__((ext_vector_type(4)));
typedef float f32x4 __attribute__((ext_vector_type(4)));
typedef short bf16x8 __attribute__((ext_vector_type(8)));
typedef GAS unsigned gu32;
typedef GAS unsigned long long gu64;
#define RLX_AGENT __ATOMIC_RELAXED, __HIP_MEMORY_SCOPE_AGENT
#define LDS_WAIT() asm volatile("s_waitcnt lgkmcnt(0)" ::: "memory")
#define VM_WAIT() asm volatile("s_waitcnt vmcnt(0)" ::: "memory")
__device__ __forceinline__ unsigned long long rt() { return __builtin_amdgcn_s_memrealtime(); }
__device__ __forceinline__ unsigned f2bf(float f) { unsigned u = __builtin_bit_cast(unsigned, f); return (u + 0x7fffu + ((u >> 16) & 1u)) >> 16; }
__device__ __forceinline__ unsigned pk2(float lo, float hi) { return f2bf(lo) | (f2bf(hi) << 16); }

#define XB_TMO      128
#define XB_XCNT(j)  (256  + 64 * (j))
#define XB_XSUB(j)  (1280 + 64 * (j))
#define XB_XGEN(j)  (2304 + 64 * (j))
#define XB_TOP      3328
#define XB_TOPGEN   3392
#define XCD_BAR_WORDS 3456
#define XB_SPIN_CAP (1u << 18)

__device__ __forceinline__ unsigned xb_ld(unsigned* p)              { return __hip_atomic_load(p, __ATOMIC_RELAXED, __HIP_MEMORY_SCOPE_AGENT); }
__device__ __forceinline__ unsigned xb_add(unsigned* p, unsigned v) { return __hip_atomic_fetch_add(p, v, __ATOMIC_RELAXED, __HIP_MEMORY_SCOPE_AGENT); }
__device__ __forceinline__ unsigned xb_xcc_id() { return (unsigned)__builtin_amdgcn_s_getreg((3 << 11) | 20) & 0xFu; }
#define XB_SPIN(cond, bar) do { unsigned _sp = 0; while (cond) { __builtin_amdgcn_s_sleep(1); \
    if ((++_sp & 255u) == 0u) { if (xb_ld(&(bar)[XB_TMO])) break; if (_sp > XB_SPIN_CAP) { atomicAdd(&(bar)[XB_TMO], 1u); break; } } } } while (0)

struct XcdBarrier {
    unsigned* bar; unsigned x;
    volatile LAS unsigned* st;
};

__device__ __forceinline__ XcdBarrier xcd_barrier_post(unsigned* bar, volatile LAS unsigned* st) {
    XcdBarrier b; b.bar = bar; b.x = xb_xcc_id(); b.st = st;
    if (threadIdx.x == 0) (void)xb_add(&bar[XB_XCNT(b.x)], 1u);
    return b;
}
__device__ __forceinline__ void xcd_barrier_complete(unsigned* bar, unsigned x, unsigned& nloc, unsigned& nx) {
    const unsigned G = gridDim.x * gridDim.y * gridDim.z;
    unsigned sum, cnt, mine, sp = 0u;
    for (;;) {
        sum = 0u; cnt = 0u; mine = 0u;
#pragma unroll
        for (unsigned j = 0; j < 16; ++j) { const unsigned c = xb_ld(&bar[XB_XCNT(j)]); sum += c; cnt += (c > 0u) ? 1u : 0u; mine = (j == x) ? c : mine; }
        if (sum == G) break;
        __builtin_amdgcn_s_sleep(1);
        if ((++sp & 255u) == 0u) { if (xb_ld(&bar[XB_TMO])) break; if (sp > XB_SPIN_CAP) { atomicAdd(&bar[XB_TMO], 1u); break; } }
    }
    nloc = mine > 0u ? mine : 1u; nx = cnt > 0u ? cnt : 1u;
}

__device__ __forceinline__ void xcd_barrier(const XcdBarrier& b) {
    asm volatile("s_waitcnt vmcnt(0)" ::: "memory");
    __syncthreads();
    if (threadIdx.x == 0) {
        unsigned* bar = b.bar;
        __builtin_amdgcn_s_waitcnt(0);
        unsigned nloc = b.st[0], nx = b.st[1];
        if (nloc == 0u) { xcd_barrier_complete(bar, b.x, nloc, nx); b.st[0] = nloc; b.st[1] = nx; }
        const unsigned old = xb_add(&bar[XB_XSUB(b.x)], 1u);
        const unsigned gen = old / nloc;
        if (old + 1u == (gen + 1u) * nloc) {
            __builtin_amdgcn_fence(__ATOMIC_RELEASE, "agent");
            asm volatile("s_waitcnt vmcnt(0)" ::: "memory");
            const unsigned og = xb_add(&bar[XB_TOP], 1u);
            const unsigned tg = og / nx;
            if (og + 1u == (tg + 1u) * nx) xb_add(&bar[XB_TOPGEN], 1u);
            else XB_SPIN(xb_ld(&bar[XB_TOPGEN]) == tg, bar);
            __builtin_amdgcn_fence(__ATOMIC_ACQUIRE, "agent");
            xb_add(&bar[XB_XGEN(b.x)], 1u);
            asm volatile("s_waitcnt vmcnt(0)" ::: "memory");
        } else {
            XB_SPIN(xb_ld(&bar[XB_XGEN(b.x)]) == gen, bar);
            __builtin_amdgcn_fence(__ATOMIC_ACQUIRE, "agent");
            asm volatile("s_waitcnt vmcnt(0)" ::: "memory");
        }
    }
    __syncthreads();
}
struct Frame {
    LAS unsigned char* lds;
    volatile LAS unsigned* MISC;
    gu32* ctl;
    int tid, lane, wave, vcu, G;
    const float* in[25]; float* out; unsigned char* ws;
};
#define WSP(T, off) ((T*)(F.ws + (off)))
enum { I_X = 0, I_C, I_WADA, I_BADA, I_LN1G, I_WIN, I_BFG, I_BMERGE, I_LQ1, I_LK1, I_LQ2, I_LK2, I_DNG, I_T5, I_WBF, I_WBD, I_WO, I_LN2G, I_WR, I_BR, I_WUP, I_BUP, I_WDN, I_BDN, I_FING };

__device__ __forceinline__ float wave_sum(float v) {
#pragma unroll
    for (int o = 1; o < 64; o <<= 1) v += __shfl_xor(v, o);
    return v;
}
__device__ __forceinline__ float bflo(unsigned w) { return __uint_as_float(w << 16); }
__device__ __forceinline__ float bfhi(unsigned w) { return __uint_as_float(w & 0xffff0000u); }

__device__ __forceinline__ void transpose_item(const float* W, int ldw, int src_col0, int K, bf16* WT, int dst_row0, LAS float* scr, int kb, int nb, int lane) {
    const int k0 = 64 * kb, n0 = 32 * nb;
#pragma unroll 8
    for (int i = 0; i < 32; ++i) { const int kk = 2 * i + (lane >> 5); scr[kk * 33 + (lane & 31)] = W[(size_t)(k0 + kk) * ldw + src_col0 + n0 + (lane & 31)]; }
    LDS_WAIT(); asm volatile("" ::: "memory");
    const int c = lane & 7;
#pragma unroll
    for (int j = 0; j < 4; ++j) { const int n = (lane >> 3) + 8 * j; const LAS float* s = scr + (8 * c) * 33 + n;
        v4u o; o.x = pk2(s[0 * 33], s[1 * 33]); o.y = pk2(s[2 * 33], s[3 * 33]); o.z = pk2(s[4 * 33], s[5 * 33]); o.w = pk2(s[6 * 33], s[7 * 33]);
        *(GAS v4u*)(WT + (size_t)(dst_row0 + n0 + n) * K + k0 + 8 * c) = o; }
    LDS_WAIT(); asm volatile("" ::: "memory");
}

__device__ __forceinline__ int t5_bucket(int n) {
    if (n < 16) return n;
    int large = 16 + (int)(logf((float)n / 16.0f) / logf(8.0f) * 16.0f);
    return large < 31 ? large : 31;
}

__device__ __forceinline__ void p0_prologue(Frame& F) {
    float* MOD = WSP(float, WS_MOD);
    {
        LAS float* red = (LAS float*)(F.lds + RING_OFF);
        const float* c = F.in[I_C]; const float* wa = F.in[I_WADA]; const float* ba = F.in[I_BADA];
        for (int it = F.vcu; it < 96; it += F.G) {
            const int j = it * 64 + F.lane; float a0 = 0.f, a1 = 0.f;
            const int kb = __builtin_amdgcn_readfirstlane(F.wave * 128);
#pragma unroll 8
            for (int k = kb; k < kb + 128; ++k) { const float wv = wa[(size_t)k * (6 * DM) + j]; const float c0 = c[k], c1 = c[DM + k];
                const float s0 = c0 / (1.0f + __expf(-c0)), s1 = c1 / (1.0f + __expf(-c1)); a0 += s0 * wv; a1 += s1 * wv; }
            red[(F.wave * 2 + 0) * 64 + F.lane] = a0; red[(F.wave * 2 + 1) * 64 + F.lane] = a1;
            __syncthreads();
            if (F.wave < 2) { float s = ba[j];
#pragma unroll
                for (int w = 0; w < 8; ++w) s += red[(w * 2 + F.wave) * 64 + F.lane];
                MOD[(size_t)F.wave * (6 * DM) + j] = s; }
            __syncthreads();
        }
    }
    if (F.vcu == F.G - 1) {
        if (F.tid < 512) { const int h = F.tid >> 7, n = F.tid & 127; WSP(float, WS_LUT)[F.tid] = F.in[I_T5][t5_bucket(n) * 4 + h] * LOG2E; }
        if (F.tid == 0) { float s1 = 0.f, s2 = 0.f;
            for (int i = 0; i < 64; ++i) { s1 += F.in[I_LQ1][i] * F.in[I_LK1][i]; s2 += F.in[I_LQ2][i] * F.in[I_LK2][i]; }
            WSP(float, WS_SCAL)[0] = expf(s1) - expf(s2) + LAMBDA_INIT; }
    }
    __syncthreads();
    {
        LAS float* scr = (LAS float*)(F.lds + RING_OFF + F.wave * 16384);
        const int gw = F.vcu * NWAVES + F.wave, NGW = F.G * NWAVES;
        constexpr int I_IN = 16 * 160, I_BF = 8 * 32, I_BD = 8 * 32, I_OO = 16 * 32, I_UP = 32 * 16 * 64, I_DN = 32 * 16 * 32;
        constexpr int NITEMS = I_IN + I_BF + I_BD + I_OO + I_UP + I_DN;
        for (int it = gw; it < NITEMS; it += NGW) {
            int r = it;
            if (r < I_IN) { const int kb = r / 160, nb = r % 160; transpose_item(F.in[I_WIN], INCOLS, (nb >= 48) ? 8 : 0, DM, WSP(bf16, WS_WIN), 0, scr, kb, nb, F.lane); continue; } r -= I_IN;
            if (r < I_BF) { transpose_item(F.in[I_WBF], DM, 0, 512, WSP(bf16, WS_WBF), 0, scr, r / 32, r % 32, F.lane); continue; } r -= I_BF;
            if (r < I_BD) { transpose_item(F.in[I_WBD], DM, 0, 512, WSP(bf16, WS_WBD), 0, scr, r / 32, r % 32, F.lane); continue; } r -= I_BD;
            if (r < I_OO) { transpose_item(F.in[I_WO], DM, 0, DM, WSP(bf16, WS_WO), 0, scr, r / 32, r % 32, F.lane); continue; } r -= I_OO;
            if (r < I_UP) { const int e = r / 1024, q = r % 1024; transpose_item(F.in[I_WUP] + (size_t)e * DM * NUP, NUP, 0, DM, WSP(bf16, WS_WUP) + (size_t)e * NUP * DM, 0, scr, q / 64, q % 64, F.lane); continue; } r -= I_UP;
            { const int e = r / 512, q = r % 512; transpose_item(F.in[I_WDN] + (size_t)e * DFF * DM, DM, 0, DFF, WSP(bf16, WS_WDN) + (size_t)e * DM * DFF, 0, scr, q / 32, q % 32, F.lane); }
        }
    }
}

__device__ __forceinline__ void norm_mod_row(const float* xrow, const float* g, const float* shift, const float* scale, int lane, f32x4 (&v)[4]) {
    const GAS f32x4* xr = (const GAS f32x4*)xrow + lane; float s = 0.f;
#pragma unroll
    for (int j = 0; j < 4; ++j) { v[j] = xr[64 * j]; s += (v[j].x * v[j].x + v[j].y * v[j].y) + (v[j].z * v[j].z + v[j].w * v[j].w); }
    const float rstd = 1.0f / sqrtf(wave_sum(s) * (1.0f / DM) + 1e-6f);
#pragma unroll
    for (int j = 0; j < 4; ++j) { const f32x4 gg = ((const GAS f32x4*)g)[64 * j + lane], sh = ((const GAS f32x4*)shift)[64 * j + lane], sc = ((const GAS f32x4*)scale)[64 * j + lane];
        v[j] = v[j] * rstd * gg * (sc + 1.0f) + sh; }
}
__device__ __forceinline__ void store_row_bf16(bf16* orow, int lane, const f32x4 (&v)[4]) {
    GAS unsigned long long* o8 = (GAS unsigned long long*)orow + lane;
#pragma unroll
    for (int j = 0; j < 4; ++j) o8[64 * j] = (unsigned long long)pk2(v[j].x, v[j].y) | ((unsigned long long)pk2(v[j].z, v[j].w) << 32);
}

__device__ __forceinline__ void p1_norm_fgate(Frame& F) {
    LAS float* wfl = (LAS float*)(F.lds + RING_OFF);
    LAS float* lfs = (LAS float*)(F.lds + RING_OFF + 32768);
    const float* win = F.in[I_WIN]; const float* MOD = WSP(float, WS_MOD);
    for (int u = F.tid; u < 8192; u += NWAVES * 64) wfl[u] = win[(size_t)(u >> 3) * INCOLS + 1536 + (u & 7)];
    __syncthreads();
    for (int g = F.vcu; g < M / 64; g += F.G) {
        for (int i = 0; i < 8; ++i) {
            const int rl = F.wave * 8 + i, row = g * 64 + rl, b = row / SEQ;
            f32x4 v[4]; norm_mod_row(F.in[I_X] + (size_t)row * DM, F.in[I_LN1G], MOD + (size_t)b * 6 * DM, MOD + (size_t)b * 6 * DM + DM, F.lane, v);
            store_row_bf16(WSP(bf16, WS_XN) + (size_t)row * DM, F.lane, v);
            float a[8];
#pragma unroll
            for (int hh = 0; hh < 8; ++hh) a[hh] = 0.f;
#pragma unroll
            for (int j = 0; j < 4; ++j)
#pragma unroll
                for (int e = 0; e < 4; ++e) { const int k = 256 * j + 4 * F.lane + e; const f32x4 w0 = *(const LAS f32x4*)(wfl + k * 8), w1 = *(const LAS f32x4*)(wfl + k * 8 + 4); const float hv = v[j][e];
                    a[0] += hv * w0.x; a[1] += hv * w0.y; a[2] += hv * w0.z; a[3] += hv * w0.w; a[4] += hv * w1.x; a[5] += hv * w1.y; a[6] += hv * w1.z; a[7] += hv * w1.w; }
            float mine = 0.f;
#pragma unroll
            for (int hh = 0; hh < 8; ++hh) { const float s = wave_sum(a[hh]); if (F.lane == hh) mine = s; }
            if (F.lane < 8) { const float z = mine + F.in[I_BFG][F.lane]; lfs[rl * 8 + F.lane] = fminf(z, 0.f) - log1pf(expf(-fabsf(z))); }
        }
        __syncthreads();
        if (F.tid < 8) { float run = 0.f; float* floc = WSP(float, WS_FLOC);
            for (int r = 0; r < 64; ++r) { run += lfs[r * 8 + F.tid]; floc[(size_t)(g * 64 + r) * 8 + F.tid] = run; }
            WSP(float, WS_BT)[g * 8 + F.tid] = run; }
        __syncthreads();
    }
}
__device__ __forceinline__ void p2_finish_f(Frame& F) {
    LAS float* base = (LAS float*)(F.lds + RING_OFF);
    const float* BT = WSP(float, WS_BT); const float* floc = WSP(float, WS_FLOC); float* F2 = WSP(float, WS_F2);
    for (int g = F.vcu; g < M / 64; g += F.G) {
        const int g0 = (g / 128) * 128;
        if (F.tid < 8) { double s = 0.0; for (int q = g0; q < g; ++q) s += (double)BT[q * 8 + F.tid]; base[F.tid] = (float)s; }
        __syncthreads();
        { const int r = F.tid >> 3, hh = F.tid & 7, row = g * 64 + r, b = row / SEQ, s = row % SEQ;
          F2[((size_t)b * 8 + hh) * SEQ + s] = (floc[(size_t)row * 8 + hh] + base[hh]) * LOG2E; }
        __syncthreads();
    }
}

__device__ __forceinline__ void p3_attn_naive(Frame& F) {
    const bf16* P = WSP(bf16, WS_PROJ); const float* F2 = WSP(float, WS_F2); const float* LUT = WSP(float, WS_LUT);
    for (int item = F.vcu; item < 768; item += F.G) {
        const int qblk = 15 - item / 48, rem = item % 48, b = rem / 24, job = rem % 24;
        int qc, kc, vc, oc, hd, opitch; bool fox; bf16* O;
        if (job < 8) { fox = true; hd = job; qc = PC_FQ + 64 * job; kc = PC_FK + 64 * job; vc = PC_FV + 64 * job; O = WSP(bf16, WS_YFOX); opitch = 512; oc = 64 * job; }
        else { const int j = job - 8, i = (j >> 1) & 1, vh = j & 1; hd = j >> 2; fox = false; qc = PC_DQ + hd * 128 + i * 64; kc = PC_DK + hd * 128 + i * 64; vc = PC_DV + hd * 128 + vh * 64;
               O = WSP(bf16, WS_OD); opitch = 1024; oc = i * 512 + hd * 128 + vh * 64; }
        const int r = qblk * 512 + F.tid; const size_t rowbase = (size_t)b * SEQ;
        float q[64], o[64];
        { const v4u* qp = (const v4u*)(P + (rowbase + r) * NPROJ + qc);
#pragma unroll
          for (int c = 0; c < 8; ++c) { const v4u w = qp[c]; q[8 * c] = bflo(w.x); q[8 * c + 1] = bfhi(w.x); q[8 * c + 2] = bflo(w.y); q[8 * c + 3] = bfhi(w.y); q[8 * c + 4] = bflo(w.z); q[8 * c + 5] = bfhi(w.z); q[8 * c + 6] = bflo(w.w); q[8 * c + 7] = bfhi(w.w); } }
#pragma unroll
        for (int d = 0; d < 64; ++d) o[d] = 0.f;
        float m = -1e30f, l = 0.f;
        const float* F2h = F2 + ((size_t)b * 8 + hd) * SEQ; const float f2t = fox ? F2h[r] : 0.f; const float* lut = LUT + hd * 128;
        const int smax = qblk * 512 + F.wave * 64 + 63;
        for (int s = smax; s >= 0; --s) {
            const v4u* kp = (const v4u*)(P + (rowbase + s) * NPROJ + kc); float x = 0.f;
#pragma unroll
            for (int c = 0; c < 8; ++c) { const v4u w = kp[c];
                x += q[8 * c] * bflo(w.x) + q[8 * c + 1] * bfhi(w.x) + q[8 * c + 2] * bflo(w.y) + q[8 * c + 3] * bfhi(w.y) + q[8 * c + 4] * bflo(w.z) + q[8 * c + 5] * bfhi(w.z) + q[8 * c + 6] * bflo(w.w) + q[8 * c + 7] * bfhi(w.w); }
            if (fox) x += f2t - F2h[s]; else { int d = r - s; d = d < 0 ? 0 : (d > 127 ? 127 : d); x += lut[d]; }
            const bool valid = s <= r;
            if (valid && x > m) { const float sc = __builtin_amdgcn_exp2f(m - x); l *= sc;
#pragma unroll
                for (int d = 0; d < 64; ++d) o[d] *= sc;
                m = x; }
            const float p = valid ? __builtin_amdgcn_exp2f(x - m) : 0.f; l += p;
            const v4u* vp = (const v4u*)(P + (rowbase + s) * NPROJ + vc);
#pragma unroll
            for (int c = 0; c < 8; ++c) { const v4u w = vp[c];
                o[8 * c] += p * bflo(w.x); o[8 * c + 1] += p * bfhi(w.x); o[8 * c + 2] += p * bflo(w.y); o[8 * c + 3] += p * bfhi(w.y); o[8 * c + 4] += p * bflo(w.z); o[8 * c + 5] += p * bfhi(w.z); o[8 * c + 6] += p * bflo(w.w); o[8 * c + 7] += p * bfhi(w.w); }
        }
        const float inv = 1.0f / l; v4u* op = (v4u*)(O + (rowbase + r) * opitch + oc);
#pragma unroll
        for (int c = 0; c < 8; ++c) { v4u w; w.x = pk2(o[8 * c] * inv, o[8 * c + 1] * inv); w.y = pk2(o[8 * c + 2] * inv, o[8 * c + 3] * inv); w.z = pk2(o[8 * c + 4] * inv, o[8 * c + 5] * inv); w.w = pk2(o[8 * c + 6] * inv, o[8 * c + 7] * inv); op[c] = w; }
    }
}

__device__ __forceinline__ void p4_diff_post(Frame& F) {
    const bf16* OD = WSP(bf16, WS_OD); bf16* YD = WSP(bf16, WS_YD); const float lam = WSP(float, WS_SCAL)[0]; const float* gn = F.in[I_DNG];
    const int gw = F.vcu * NWAVES + F.wave, NGW = F.G * NWAVES; const int e0 = (F.lane & 15) * 8;
    float gv[8];
#pragma unroll
    for (int e = 0; e < 8; ++e) gv[e] = gn[e0 + e] * (1.0f - LAMBDA_INIT);
    for (int row = gw; row < M; row += NGW) {
        const v4u a = *(const v4u*)(OD + (size_t)row * 1024 + F.lane * 8), bq = *(const v4u*)(OD + (size_t)row * 1024 + 512 + F.lane * 8);
        float y[8]; y[0] = bflo(a.x) - lam * bflo(bq.x); y[1] = bfhi(a.x) - lam * bfhi(bq.x); y[2] = bflo(a.y) - lam * bflo(bq.y); y[3] = bfhi(a.y) - lam * bfhi(bq.y);
        y[4] = bflo(a.z) - lam * bflo(bq.z); y[5] = bfhi(a.z) - lam * bfhi(bq.z); y[6] = bflo(a.w) - lam * bflo(bq.w); y[7] = bfhi(a.w) - lam * bfhi(bq.w);
        float ss = 0.f;
#pragma unroll
        for (int e = 0; e < 8; ++e) ss += y[e] * y[e];
        ss += __shfl_xor(ss, 1); ss += __shfl_xor(ss, 2); ss += __shfl_xor(ss, 4); ss += __shfl_xor(ss, 8);
        const float rstd = 1.0f / sqrtf(ss * (1.0f / 128.0f) + 1e-5f);
        v4u w; w.x = pk2(y[0] * rstd * gv[0], y[1] * rstd * gv[1]); w.y = pk2(y[2] * rstd * gv[2], y[3] * rstd * gv[3]); w.z = pk2(y[4] * rstd * gv[4], y[5] * rstd * gv[5]); w.w = pk2(y[6] * rstd * gv[6], y[7] * rstd * gv[7]);
        *(v4u*)(YD + (size_t)row * 512 + F.lane * 8) = w;
    }
}

__device__ __forceinline__ void p7_route(Frame& F) {
    LAS float* hs = (LAS float*)(F.lds + RING_OFF + F.wave * 4096);
    const float* X1 = F.out; const float* MOD = WSP(float, WS_MOD); const float* wr = F.in[I_WR]; const float* br = F.in[I_BR];
    int* TOPE = WSP(int, WS_TOPE); int* RANK = WSP(int, WS_RANK); float* GATE = WSP(float, WS_GATE);
    const int gw = F.vcu * NWAVES + F.wave, NGW = F.G * NWAVES; const int e = F.lane & 31, kh = F.lane >> 5;
    for (int row = gw; row < M; row += NGW) {
        const int b = row / SEQ; f32x4 v[4];
        norm_mod_row(X1 + (size_t)row * DM, F.in[I_LN2G], MOD + (size_t)b * 6 * DM + 3 * DM, MOD + (size_t)b * 6 * DM + 4 * DM, F.lane, v);
        store_row_bf16(WSP(bf16, WS_XN) + (size_t)row * DM, F.lane, v);
#pragma unroll
        for (int j = 0; j < 4; ++j) *(LAS f32x4*)(hs + 256 * j + 4 * F.lane) = v[j];
        LDS_WAIT(); asm volatile("" ::: "memory");
        float acc = 0.f;
#pragma unroll 8
        for (int k = 0; k < 512; ++k) acc += hs[kh * 512 + k] * wr[(size_t)(kh * 512 + k) * NE + e];
        acc += __shfl_xor(acc, 32);
        float val = acc + br[e]; if (F.lane >= 32) val = -INFINITY;
        float tv[4]; int te[4];
#pragma unroll
        for (int kk = 0; kk < 4; ++kk) { float best = val; int bi = F.lane;
#pragma unroll
            for (int o = 1; o < 32; o <<= 1) { const float ov = __shfl_xor(best, o); const int oi = __shfl_xor(bi, o); if (ov > best || (ov == best && oi < bi)) { best = ov; bi = oi; } }
            tv[kk] = __shfl(best, 0); te[kk] = __shfl(bi, 0); if (F.lane == te[kk]) val = -INFINITY; }
        const float p1 = __expf(tv[1] - tv[0]), p2 = __expf(tv[2] - tv[0]), p3 = __expf(tv[3] - tv[0]); const float inv = 1.0f / (1.0f + p1 + p2 + p3);
        if (F.lane < 4) { const int me = F.lane == 0 ? te[0] : F.lane == 1 ? te[1] : F.lane == 2 ? te[2] : te[3]; const float mg = (F.lane == 0 ? 1.0f : F.lane == 1 ? p1 : F.lane == 2 ? p2 : p3) * inv;
            const int rk = (int)__hip_atomic_fetch_add(F.ctl + CW_CNT + me, 1u, __ATOMIC_RELAXED, __HIP_MEMORY_SCOPE_AGENT);
            TOPE[(size_t)row * 4 + F.lane] = me; RANK[(size_t)row * 4 + F.lane] = rk; GATE[(size_t)row * 4 + F.lane] = mg; }
        LDS_WAIT(); asm volatile("" ::: "memory");
    }
}
__device__ __forceinline__ void load_expert_tables(Frame& F) {
    LAS int* tab = (LAS int*)(F.lds + TAB_OFF);
    if (F.tid < 32) tab[F.tid] = (int)__hip_atomic_load(F.ctl + CW_CNT + F.tid, __ATOMIC_RELAXED, __HIP_MEMORY_SCOPE_AGENT);
    __syncthreads();
    if (F.tid == 0) { int run = 0; for (int e = 0; e < 32; ++e) { const int mt = (tab[e] + 255) >> 8; tab[32 + e] = run; tab[65 + e] = mt; run += mt * 256; } tab[64] = run; }
    __syncthreads();
}
__device__ __forceinline__ void p8_scatter(Frame& F) {
    load_expert_tables(F);
    const LAS int* tab = (const LAS int*)(F.lds + TAB_OFF);
    const int* TOPE = WSP(int, WS_TOPE); const int* RANK = WSP(int, WS_RANK); const float* GATE = WSP(float, WS_GATE); int* SLOT = WSP(int, WS_SLOT); float* SGATE = WSP(float, WS_SGATE);
    const bf16* H2 = WSP(bf16, WS_XN); bf16* XG = WSP(bf16, WS_XG);
    const int gw = F.vcu * NWAVES + F.wave, NGW = F.G * NWAVES;
    for (int pair = gw; pair < M * 4; pair += NGW) {
        const int tok = pair >> 2, e = TOPE[pair], slot = tab[32 + e] + RANK[pair];
        const v4u* src = (const v4u*)(H2 + (size_t)tok * DM); v4u* dst = (v4u*)(XG + (size_t)slot * DM);
        const v4u a = src[F.lane], c = src[64 + F.lane]; dst[F.lane] = a; dst[64 + F.lane] = c;
        if (F.lane == 0) { SLOT[pair] = slot; SGATE[slot] = GATE[pair]; }
    }
}
__device__ __forceinline__ int build_units(Frame& F, int NT) {
    load_expert_tables(F);
    LAS int* tab = (LAS int*)(F.lds + TAB_OFF); LAS int* lst = (LAS int*)(F.lds + TAB_OFF + 1024);
    if (F.tid == 0) { int n = 0; int total = 0; for (int e = 0; e < 32; ++e) total += tab[65 + e] * NT;
        for (int i = 0;; ++i) { const int L = i * F.G + F.vcu; if (L >= total || n >= 400) break;
            int e = 0, r = L; while (r >= tab[65 + e] * NT) { r -= tab[65 + e] * NT; ++e; }
            const int mt = tab[65 + e], pn = r / mt, pml = r % mt;
            lst[4 * n] = (tab[32 + e] >> 8) + pml; lst[4 * n + 1] = pn; lst[4 * n + 2] = e * NT + pn; lst[4 * n + 3] = e; ++n; }
        tab[128] = n; }
    __syncthreads();
    return tab[128];
}
__device__ __forceinline__ void p11_final(Frame& F) {
    const float* MOD = WSP(float, WS_MOD); const int* SLOT = WSP(int, WS_SLOT); const bf16* YP = WSP(bf16, WS_YP); const float* fg = F.in[I_FING];
    const int gw = F.vcu * NWAVES + F.wave, NGW = F.G * NWAVES;
    for (int row = gw; row < M; row += NGW) {
        const int b = row / SEQ; const float* g2 = MOD + (size_t)b * 6 * DM + 5 * DM;
        GAS f32x4* xr = (GAS f32x4*)(F.out + (size_t)row * DM) + F.lane;
        int sl[4];
#pragma unroll
        for (int k = 0; k < 4; ++k) sl[k] = SLOT[(size_t)row * 4 + k];
        f32x4 v[4]; float s = 0.f;
#pragma unroll
        for (int j = 0; j < 4; ++j) { f32x4 y = (f32x4){0.f, 0.f, 0.f, 0.f};
#pragma unroll
            for (int k = 0; k < 4; ++k) { const unsigned long long w = *(const unsigned long long*)(YP + (size_t)sl[k] * DM + 256 * j + 4 * F.lane); const unsigned lo = (unsigned)w, hi = (unsigned)(w >> 32);
                y.x += bflo(lo); y.y += bfhi(lo); y.z += bflo(hi); y.w += bfhi(hi); }
            const f32x4 gg = ((const GAS f32x4*)g2)[64 * j + F.lane];
            v[j] = xr[64 * j] + gg * y; s += (v[j].x * v[j].x + v[j].y * v[j].y) + (v[j].z * v[j].z + v[j].w * v[j].w); }
        const float rstd = 1.0f / sqrtf(wave_sum(s) * (1.0f / DM) + 1e-6f);
#pragma unroll
        for (int j = 0; j < 4; ++j) { const f32x4 gg = ((const GAS f32x4*)fg)[64 * j + F.lane]; xr[64 * j] = v[j] * rstd * gg; }
    }
}

#ifndef MK_PER_PHASE
#define MK_PER_PHASE 0
#endif
constexpr int N_PHASES = 12;
struct Args { const float* in[25]; float* out; unsigned char* ws; int ph_lo, ph_hi; };
__global__ void __launch_bounds__(NWAVES * 64, 2) skel_fwd(Args args) {
    extern __shared__ __attribute__((aligned(16))) unsigned char lds[];
    Frame F;
    F.lds = (LAS unsigned char*)lds;
    F.MISC = (volatile LAS unsigned*)(F.lds + MISC_OFF);
    F.tid = threadIdx.x; F.lane = F.tid & 63; F.wave = __builtin_amdgcn_readfirstlane(F.tid >> 6);
    F.G = gridDim.x; { const int bx = blockIdx.x; F.vcu = (F.G % 8 == 0) ? (bx % 8) * (F.G / 8) + bx / 8 : bx; }
    F.ws = args.ws; F.out = args.out; F.ctl = (gu32*)(args.ws + WS_CTL);
#pragma unroll
    for (int i = 0; i < 25; ++i) F.in[i] = args.in[i];
    for (int u = F.tid; u < (LDS_BYTES - LDSCTL_OFF) / 4; u += NWAVES * 64) ((LAS unsigned*)(F.lds + LDSCTL_OFF))[u] = 0u;
    __syncthreads();
    XcdBarrier bar; bar.bar = (unsigned*)(F.ctl + CW_BAR); bar.x = 0; bar.st = nullptr;
    const int lo = args.ph_lo, hi = args.ph_hi;
    if (hi - lo > 1) bar = xcd_barrier_post((unsigned*)(F.ctl + CW_BAR), F.MISC + 8);
#define IN(k) (lo <= (k) && (k) < hi)
#define SEAM(k) do { if (IN(k) && IN((k) + 1)) xcd_barrier(bar); } while (0)

    if (IN(0)) { p0_prologue(F); } SEAM(0);
    if (IN(1)) { p1_norm_fgate(F); } SEAM(1);
    if (IN(2)) {
        p2_finish_f(F); __syncthreads();
        pg8::Gemm g{WSP(pg8::bf16_t, WS_XN), WSP(pg8::bf16_t, WS_WIN), M, NPROJ, DM}; pg8::StaticOrder S; S.init(M, NPROJ, F.G, (int)blockIdx.x);
        epi::EpiProj E{WSP(pg8::bf16_t, WS_PROJ), F.in[I_BMERGE]};
        pg8::gemm_phase<epi::EpiProj, pg8::StaticOrder, true, true>(F.lds + RING_OFF, g, S, E);
    } SEAM(2);
    if (IN(3)) { p3_attn_naive(F); } SEAM(3);
    if (IN(4)) { p4_diff_post(F); } SEAM(4);
    if (IN(5)) {
        { pg8::Gemm g{WSP(pg8::bf16_t, WS_YFOX), WSP(pg8::bf16_t, WS_WBF), M, DM, 512}; pg8::StaticOrder S; S.init(M, DM, F.G, (int)blockIdx.x);
          epi::EpiBranch<0> E{WSP(pg8::bf16_t, WS_PROJ), nullptr, WSP(pg8::bf16_t, WS_T1)};
          pg8::gemm_phase<epi::EpiBranch<0>, pg8::StaticOrder, true, true>(F.lds + RING_OFF, g, S, E); }
        VM_WAIT(); __syncthreads();
        { pg8::Gemm g{WSP(pg8::bf16_t, WS_YD), WSP(pg8::bf16_t, WS_WBD), M, DM, 512}; pg8::StaticOrder S; S.init(M, DM, F.G, (int)blockIdx.x);
          epi::EpiBranch<1> E{WSP(pg8::bf16_t, WS_PROJ), WSP(pg8::bf16_t, WS_T1), WSP(pg8::bf16_t, WS_MRG)};
          pg8::gemm_phase<epi::EpiBranch<1>, pg8::StaticOrder, true, true>(F.lds + RING_OFF, g, S, E); }
    } SEAM(5);
    if (IN(6)) {
        pg8::Gemm g{WSP(pg8::bf16_t, WS_MRG), WSP(pg8::bf16_t, WS_WO), M, DM, DM}; pg8::StaticOrder S; S.init(M, DM, F.G, (int)blockIdx.x);
        epi::EpiWo E{F.in[I_X], WSP(float, WS_MOD), F.out};
        pg8::gemm_phase<epi::EpiWo, pg8::StaticOrder, true, true>(F.lds + RING_OFF, g, S, E);
    } SEAM(6);
    if (IN(7)) { p7_route(F); } SEAM(7);
    if (IN(8)) { p8_scatter(F); } SEAM(8);
    if (IN(9)) {
        const int n = build_units(F, NUP / 256);
        pg8::Gemm g{WSP(pg8::bf16_t, WS_XG), WSP(pg8::bf16_t, WS_WUP), PMAX, NUP, DM}; epi::ListOrder S{(const PG8_LAS int*)(F.lds + TAB_OFF + 1024), n};
        epi::EpiUp E{F.in[I_BUP], WSP(pg8::bf16_t, WS_ACT)};
        pg8::gemm_phase<epi::EpiUp, epi::ListOrder, true, true>(F.lds + RING_OFF, g, S, E);
    } SEAM(9);
    if (IN(10)) {
        const int n = build_units(F, DM / 256);
        pg8::Gemm g{WSP(pg8::bf16_t, WS_ACT), WSP(pg8::bf16_t, WS_WDN), PMAX, DM, DFF}; epi::ListOrder S{(const PG8_LAS int*)(F.lds + TAB_OFF + 1024), n};
        epi::EpiDown E{F.in[I_BDN], WSP(float, WS_SGATE), WSP(pg8::bf16_t, WS_YP)};
        pg8::gemm_phase<epi::EpiDown, epi::ListOrder, true, true>(F.lds + RING_OFF, g, S, E);
    } SEAM(10);
    if (IN(11)) { p11_final(F); }
#undef IN
#undef SEAM
}

extern "C" void kernel_launch(void* const* d_in, const int* in_sizes, int n_in, void* d_out, int out_size, void* d_ws, size_t ws_size, hipStream_t stream) {
    static int grid = 0;
    if (grid == 0) {
        if (n_in != 25 || in_sizes[0] != M * DM || out_size != M * DM || ws_size < WS_END) { fprintf(stderr, "kernel_launch: unexpected problem (n_in %d, in0 %d, out %d, ws %zu, need %zu); nothing launched\n", n_in, n_in > 0 ? in_sizes[0] : -1, out_size, ws_size, (size_t)WS_END); grid = -1; return; }
        int dev = 0, cus = 0, per_cu = 0;
        if (hipGetDevice(&dev) != hipSuccess || hipDeviceGetAttribute(&cus, hipDeviceAttributeMultiprocessorCount, dev) != hipSuccess) { grid = -1; return; }
        if (hipFuncSetAttribute((const void*)skel_fwd, hipFuncAttributeMaxDynamicSharedMemorySize, LDS_BYTES) != hipSuccess) { fprintf(stderr, "kernel_launch: hipFuncSetAttribute failed\n"); grid = -1; return; }
        if (hipOccupancyMaxActiveBlocksPerMultiprocessor(&per_cu, (const void*)skel_fwd, NWAVES * 64, LDS_BYTES) != hipSuccess || per_cu < 1) { fprintf(stderr, "kernel_launch: occupancy query reports %d blocks per CU\n", per_cu); }
        (void)hipGetLastError();
        grid = cus;
    }
    if (grid < 0) return;
    if (hipMemsetAsync((char*)d_ws + WS_CTL, 0, CTL_ZERO_BYTES, stream) != hipSuccess) { fprintf(stderr, "kernel_launch: memset failed\n"); return; }
    Args a{};
    for (int i = 0; i < 25; ++i) a.in[i] = (const float*)d_in[i];
    a.out = (float*)d_out; a.ws = (unsigned char*)d_ws;
#if MK_PER_PHASE
    for (int p = 0; p < N_PHASES; ++p) { a.ph_lo = p; a.ph_hi = p + 1; hipLaunchKernelGGL(skel_fwd, dim3(grid), dim3(NWAVES * 64), LDS_BYTES, stream, a); }
#else
    a.ph_lo = 0; a.ph_hi = N_PHASES; hipLaunchKernelGGL(skel_fwd, dim3(grid), dim3(NWAVES * 64), LDS_BYTES, stream, a);
#endif
    const hipError_t le = hipPeekAtLastError();
    if (le != hipSuccess) fprintf(stderr, "kernel_launch: launch failed: %s\n", hipGetErrorName(le));
}
```

```cpp
#include <hip/hip_runtime.h>
#include <cstdio>
#include <cstdint>

constexpr int NB = 2, SEQ = 8192, DM = 1024, M = NB * SEQ;
constexpr int INCOLS = 5128, NPROJ = 5120;
constexpr int PC_FQ = 0, PC_FK = 512, PC_FV = 1024, PC_DQ = 1536, PC_DK = 2048, PC_DV = 2560, PC_G = 3072;
constexpr int NE = 32, TOPK = 4, NUP = 2048, DFF = 1024;
constexpr int PMAX = 73728;
constexpr float LOG2E = 1.4426950408889634f;
constexpr float QSCALE = 0.125f * LOG2E;
constexpr float LAMBDA_INIT = 0.2f;
namespace pg8 {
#define PG8_LAS __attribute__((address_space(3)))
typedef unsigned short bf16_t;
typedef short bf16x8 __attribute__((ext_vector_type(8)));
typedef float f32x4 __attribute__((ext_vector_type(4)));
typedef unsigned u32x4 __attribute__((ext_vector_type(4)));
constexpr int BM = 256, BK = 64, HALF = 128, HTB = HALF * BK * 2  , STAGE_BYTES = 8 * HTB, NXCD = 8, WGM = 4;

__host__ __device__ __forceinline__ int lds_byte(int r, int c) { const int st = (r >> 4) * 2 + (c >> 5), rr = r & 15, cc = c & 31, ob = rr * 64 + cc * 2; return st * 1024 + (ob ^ (((ob >> 9) & 1) << 5)); }
__host__ __device__ __forceinline__ void stage_rc(int b, int& R, int& C) { const int st = b / 1024, sb = b % 1024, swz = sb ^ (((sb >> 9) & 1) << 5); R = (st >> 1) * 16 + swz / 64; C = (st & 1) * 32 + (swz % 64) / 2; }
__host__ __device__ __forceinline__ int perm32(int rho) { const int n = rho >> 4, i = rho & 15; return 8 * (i >> 2) + 4 * n + (i & 3); }

struct Unit { int pm, pn, pb, e, ar, nr, md; };
struct Gemm { const bf16_t* A; const bf16_t* Bt; int M, N, K; const int* idx; unsigned aoff2; };

struct StaticOrder {
    int nM, nN, nwg, G, c;
    __host__ __device__ void init(int M, int N, int G_, int c_) { nM = M / BM; nN = N / BM; nwg = nM * nN; G = G_; c = c_; }
    __host__ __device__ bool next(int i, Unit& u) const {
        const long L = (long)i * G + c; if (L >= nwg) return false;
        int wgid = (int)L; { const int q = nwg / NXCD, r = nwg % NXCD, xcd = wgid % NXCD, off = wgid / NXCD; wgid = (xcd < r ? xcd * (q + 1) : r * (q + 1) + (xcd - r) * q) + off; }
        const int nig = WGM * nN, gid = wgid / nig, fm = gid * WGM, gsz = (nM - fm) < WGM ? (nM - fm) : WGM;
        u.pm = fm + ((wgid % nig) % gsz); u.pn = (wgid % nig) / gsz; u.pb = u.pn; u.e = 0; u.ar = 0; u.nr = 0; u.md = 0; return true;
    }
    __device__ __forceinline__ void a_ready(const Unit&) const {}
    __device__ __forceinline__ void done(const Unit&) const {}
};

__device__ __forceinline__ unsigned cvt_pk_bf16(float lo, float hi) { unsigned r; asm volatile("v_cvt_pk_bf16_f32 %0, %1, %2" : "=v"(r) : "v"(lo), "v"(hi)); return r; }
typedef float f32x2 __attribute__((ext_vector_type(2)));
template <class Epi, class Sched, bool ALIGN_EPI = false, bool SP2 = false, bool GATHER = false, bool FP8 = false>
__device__ __forceinline__ void gemm_phase(PG8_LAS unsigned char* lds, const Gemm g, const Sched& S, const Epi& E) {
    const int tid = threadIdx.x, wid = __builtin_amdgcn_readfirstlane(tid >> 6), lane = tid & 63, wr = wid >> 2, wc = wid & 3, fr = lane & 15, fq = lane >> 4;
    const int K = g.K, nt = K / BK;
    unsigned voffA[2], voffB[2];
#pragma unroll
    for (int i = 0; i < 2; ++i) { int R, C; stage_rc(tid * 16 + i * 8192, R, C); const int Rb = Epi::PERM ? ((R & ~31) + perm32(R & 31)) : R;
        voffA[i] = (unsigned)(R * K + C) * 2u; voffB[i] = (unsigned)(Rb * K + C) * 2u; }
    unsigned vgc[2][2] = {{0u, 0u}, {0u, 0u}}, vgn[2][2] = {{0u, 0u}, {0u, 0u}};
#define PG8_GOFF(dst, u) do { _Pragma("unroll") for (int h_ = 0; h_ < 2; ++h_) _Pragma("unroll") for (int i_ = 0; i_ < 2; ++i_) { int R_, C_; stage_rc(tid * 16 + i_ * 8192, R_, C_); const int r_ = R_ + 128 * h_; \
        if ((u).md == 0) { const int tok_ = (r_ < (u).nr) ? g.idx[(u).ar + r_] : 0; dst[h_][i_] = (unsigned)(tok_ * K + C_) * 2u; } \
        else { dst[h_][i_] = g.aoff2 + (unsigned)((256 * (u).pm + r_) * K + C_) * 2u; } } } while (0)
    const size_t kstep = (size_t)(BK * 2);
    const size_t hstep = (size_t)HALF * K * 2;
    const size_t tstep = 2 * hstep;
    const unsigned ldsw = (unsigned)wid * 1024u;
    const int aoff = lds_byte(wr * 64 + fr, fq * 8), boff = lds_byte(wc * 32 + fr, fq * 8);
    const int aofk0 = FP8 ? lds_byte(wr * 64 + fr, fq * 16) : aoff, bofk0 = FP8 ? lds_byte(wc * 32 + fr, fq * 16) : boff;
    constexpr int KOFF = FP8 ? 16 : 1024;
#define PG8_SA(b, h) (((b) * 2 + (h)) * HTB)
#define PG8_SB(b, h) ((4 + (b) * 2 + (h)) * HTB)
#define PG8_STAGE(bufoff, gbase, voff) do { _Pragma("unroll") for (int _i = 0; _i < 2; ++_i) \
        __builtin_amdgcn_global_load_lds((const unsigned*)((const char*)(gbase) + (voff)[_i]), (PG8_LAS unsigned*)(lds + (bufoff) + ldsw + _i * 8192), 16, 0, 0); } while (0)
#define PG8_STAGE_A(bufoff, P, h, NX) do { if constexpr (GATHER) { unsigned vo_[2]; vo_[0] = (NX) ? vgn[h][0] : vgc[h][0]; vo_[1] = (NX) ? vgn[h][1] : vgc[h][1]; PG8_STAGE(bufoff, P, vo_); } \
        else { PG8_STAGE(bufoff, (P) + (h) * hstep, voffA); } } while (0)
#define PG8_LDA(dst, b, h) do { if constexpr (FP8) { _Pragma("unroll") for (int m = 0; m < 4; ++m) { dst##8[m].lo = *(const PG8_LAS i32x4_t*)(lds + PG8_SA(b, h) + aofk0 + m * 2048); dst##8[m].hi = *(const PG8_LAS i32x4_t*)(lds + PG8_SA(b, h) + aofk0 + m * 2048 + 16); } } \
        else { _Pragma("unroll") for (int m = 0; m < 4; ++m) _Pragma("unroll") for (int k = 0; k < 2; ++k) dst[m][k] = *(const PG8_LAS bf16x8*)(lds + PG8_SA(b, h) + aofk0 + m * 2048 + k * KOFF); } } while (0)
#define PG8_LDB(dst, b, h) do { if constexpr (FP8) { _Pragma("unroll") for (int n = 0; n < 2; ++n) { dst##8[n].lo = *(const PG8_LAS i32x4_t*)(lds + PG8_SB(b, h) + bofk0 + n * 2048); dst##8[n].hi = *(const PG8_LAS i32x4_t*)(lds + PG8_SB(b, h) + bofk0 + n * 2048 + 16); } } \
        else { _Pragma("unroll") for (int n = 0; n < 2; ++n) _Pragma("unroll") for (int k = 0; k < 2; ++k) dst[n][k] = *(const PG8_LAS bf16x8*)(lds + PG8_SB(b, h) + bofk0 + n * 2048 + k * KOFF); } } while (0)
#define PG8_MMA(ai, bj, At, Bt) do { if constexpr (FP8) __builtin_amdgcn_sched_barrier(0); __builtin_amdgcn_s_setprio(1); _Pragma("unroll") for (int m = 0; m < 4; ++m) _Pragma("unroll") for (int n = 0; n < 2; ++n) { \
        if constexpr (FP8) { asm volatile("s_nop 1\n\tv_mfma_scale_f32_16x16x128_f8f6f4 %0, %1, %2, %0, %3, %4 op_sel_hi:[0,0,0]" : "+v"(acc[ai][bj][m][n]) : "v"(Bt##8[n]), "v"(At##8[m]), "v"(sc_w), "v"(sc_a)); } \
        else { _Pragma("unroll") for (int k = 0; k < 2; ++k) acc[ai][bj][m][n] = __builtin_amdgcn_mfma_f32_16x16x32_bf16(Bt[n][k], At[m][k], acc[ai][bj][m][n], 0, 0, 0); } } \
        __builtin_amdgcn_s_setprio(0); if constexpr (FP8) __builtin_amdgcn_sched_barrier(0); } while (0)
#define PG8_WAIT_V(n) asm volatile("s_waitcnt vmcnt(" #n ")" ::: "memory")
#define PG8_WAIT_L(n) asm volatile("s_waitcnt lgkmcnt(" #n ")" ::: "memory")
#define PG8_BAR __builtin_amdgcn_s_barrier()
#define PG8_SCHED __builtin_amdgcn_sched_barrier(0)
    Unit cur, nxt; int ui = 0;
    if (!S.next(0, cur)) return;
    f32x4 acc[2][2][4][2];
#pragma unroll
    for (int a = 0; a < 2; ++a)
#pragma unroll
        for (int b = 0; b < 2; ++b)
#pragma unroll
            for (int m = 0; m < 4; ++m)
#pragma unroll
                for (int n = 0; n < 2; ++n) acc[a][b][m][n] = (f32x4){0.f, 0.f, 0.f, 0.f};
    typedef int i32x4_t __attribute__((ext_vector_type(4))); typedef int i32x8_t __attribute__((ext_vector_type(8)));
    bf16x8 At[4][2], B0[2][2], B1[2][2]; i32x8_t At8[4], B08[2], B18[2];
    int sc_w = 0x7a7a7a7a, sc_a = 0x7f7f7f7f; asm volatile("" : "+v"(sc_w), "+v"(sc_a));
    const char* cA = (const char*)g.A + (GATHER ? (size_t)0 : (size_t)cur.pm * tstep); const char* cB = (const char*)g.Bt + (size_t)cur.pb * tstep;
    if constexpr (GATHER) PG8_GOFF(vgc, cur);
    S.a_ready(cur);
    if constexpr (SP2) {
        PG8_STAGE(PG8_SB(0, 0), cB, voffB); PG8_STAGE(PG8_SB(0, 1), cB + hstep, voffB); PG8_STAGE_A(PG8_SA(0, 0), cA, 0, false); PG8_STAGE_A(PG8_SA(0, 1), cA, 1, false);
        if (wr == 1) PG8_BAR;
        PG8_WAIT_V(2); PG8_BAR;
        PG8_STAGE(PG8_SB(1, 0), cB + kstep, voffB); PG8_STAGE_A(PG8_SA(1, 0), cA + kstep, 0, false); PG8_STAGE(PG8_SB(1, 1), cB + hstep + kstep, voffB);
        PG8_WAIT_V(6); PG8_BAR;
    } else {
        PG8_STAGE(PG8_SB(0, 0), cB, voffB); PG8_STAGE_A(PG8_SA(0, 0), cA, 0, false); PG8_STAGE(PG8_SB(0, 1), cB + hstep, voffB); PG8_STAGE_A(PG8_SA(0, 1), cA, 1, false);
        if (wr == 1) PG8_BAR;
        PG8_WAIT_V(4); PG8_BAR;
        PG8_STAGE(PG8_SB(1, 0), cB + kstep, voffB); PG8_STAGE_A(PG8_SA(1, 0), cA + kstep, 0, false); PG8_STAGE(PG8_SB(1, 1), cB + hstep + kstep, voffB);
        PG8_WAIT_V(6); PG8_BAR;
    }
    for (;;) {
        const bool has_next = S.next(ui + 1, nxt);
        if constexpr (GATHER) { if (has_next) { PG8_GOFF(vgn, nxt); } else { _Pragma("unroll") for (int h_ = 0; h_ < 2; ++h_) _Pragma("unroll") for (int i_ = 0; i_ < 2; ++i_) vgn[h_][i_] = vgc[h_][i_]; } }
        const char* nA = (has_next && !GATHER) ? (const char*)g.A + (size_t)nxt.pm * tstep : cA; const char* nB = has_next ? (const char*)g.Bt + (size_t)nxt.pb * tstep : cB;
#pragma nounroll
        for (int t = 0; t < nt; t += 2) {
            const bool last = (t == nt - 2);
            const char* a1 = cA + (size_t)(t + 1) * kstep;
            const char* a2 = last ? nA : cA + (size_t)(t + 2) * kstep; const char* b2 = last ? nB : cB + (size_t)(t + 2) * kstep;
            const char* a3 = a2 + kstep; const char* b3 = b2 + kstep;
            if (last && has_next) S.a_ready(nxt);
            if constexpr (SP2) {
            PG8_LDB(B0, 0, 0); PG8_LDB(B1, 0, 1); PG8_SCHED; PG8_LDA(At, 0, 0); PG8_STAGE_A(PG8_SA(1, 1), a1, 1, false);
            PG8_WAIT_V(8); PG8_WAIT_L(0); PG8_BAR; PG8_MMA(0, 0, At, B0); PG8_MMA(0, 1, At, B1); PG8_BAR; PG8_SCHED;
            PG8_LDA(At, 0, 1); PG8_STAGE(PG8_SB(0, 0), b2, voffB); PG8_STAGE(PG8_SB(0, 1), b2 + hstep, voffB); PG8_STAGE_A(PG8_SA(0, 0), a2, 0, last);
            PG8_WAIT_V(8); PG8_WAIT_L(0); PG8_BAR; PG8_MMA(1, 0, At, B0); PG8_MMA(1, 1, At, B1); PG8_BAR; PG8_SCHED;
            PG8_LDB(B0, 1, 0); PG8_LDB(B1, 1, 1); PG8_SCHED; PG8_LDA(At, 1, 0); PG8_STAGE_A(PG8_SA(0, 1), a2, 1, last);
            PG8_WAIT_V(8); PG8_WAIT_L(0); PG8_BAR; PG8_MMA(0, 0, At, B0); PG8_MMA(0, 1, At, B1); PG8_BAR; PG8_SCHED;
            PG8_LDA(At, 1, 1); PG8_STAGE(PG8_SB(1, 0), b3, voffB); PG8_STAGE(PG8_SB(1, 1), b3 + hstep, voffB); PG8_STAGE_A(PG8_SA(1, 0), a3, 0, last);
            PG8_WAIT_V(8); PG8_WAIT_L(0); PG8_BAR; PG8_MMA(1, 0, At, B0); PG8_MMA(1, 1, At, B1); PG8_BAR; PG8_SCHED;
            } else {
            PG8_LDB(B0, 0, 0); PG8_SCHED; PG8_LDA(At, 0, 0); PG8_STAGE_A(PG8_SA(1, 1), a1, 1, false);
            PG8_WAIT_L(8); PG8_BAR; PG8_WAIT_L(0); PG8_MMA(0, 0, At, B0); PG8_BAR; PG8_SCHED;
            PG8_LDB(B1, 0, 1); PG8_STAGE(PG8_SB(0, 0), b2, voffB);
            PG8_BAR; PG8_WAIT_L(0); PG8_MMA(0, 1, At, B1); PG8_BAR;
            PG8_LDA(At, 0, 1); PG8_STAGE_A(PG8_SA(0, 0), a2, 0, last);
            PG8_BAR; PG8_WAIT_L(0); PG8_MMA(1, 0, At, B0); PG8_BAR; PG8_SCHED;
            PG8_STAGE(PG8_SB(0, 1), b2 + hstep, voffB);
            PG8_WAIT_V(6); PG8_BAR; PG8_MMA(1, 1, At, B1); PG8_BAR;
            PG8_LDB(B0, 1, 0); PG8_SCHED; PG8_LDA(At, 1, 0); PG8_STAGE_A(PG8_SA(0, 1), a2, 1, last);
            PG8_WAIT_L(8); PG8_BAR; PG8_WAIT_L(0); PG8_MMA(0, 0, At, B0); PG8_BAR; PG8_SCHED;
            PG8_LDB(B1, 1, 1); PG8_STAGE(PG8_SB(1, 0), b3, voffB);
            PG8_BAR; PG8_WAIT_L(0); PG8_MMA(0, 1, At, B1); PG8_BAR;
            PG8_LDA(At, 1, 1); PG8_STAGE_A(PG8_SA(1, 0), a3, 0, last);
            PG8_BAR; PG8_WAIT_L(0); PG8_MMA(1, 0, At, B0); PG8_BAR; PG8_SCHED;
            PG8_STAGE(PG8_SB(1, 1), b3 + hstep, voffB);
            PG8_WAIT_V(6); PG8_BAR; PG8_MMA(1, 1, At, B1); PG8_BAR;
            }
        }
        if constexpr (ALIGN_EPI) { if (wr == 0) PG8_BAR; }
        if constexpr (FP8) asm volatile("s_nop 15\n\ts_nop 15" ::: "memory");
        if constexpr (!Epi::AFTER_DRAIN) { int fr_ = fr, fq_ = fq; asm volatile("" : "+v"(fr_), "+v"(fq_));
            E(acc, cur, wr, wc, fr_, fq_); S.done(cur); }
        if (!has_next) break;
#pragma unroll
        for (int a = 0; a < 2; ++a)
#pragma unroll
            for (int b = 0; b < 2; ++b)
#pragma unroll
                for (int m = 0; m < 4; ++m)
#pragma unroll
                    for (int n = 0; n < 2; ++n) acc[a][b][m][n] = (f32x4){0.f, 0.f, 0.f, 0.f};
        cur = nxt; cA = nA; cB = nB; ++ui;
        if constexpr (GATHER) { _Pragma("unroll") for (int h_ = 0; h_ < 2; ++h_) _Pragma("unroll") for (int i_ = 0; i_ < 2; ++i_) vgc[h_][i_] = vgn[h_][i_]; }
        if constexpr (ALIGN_EPI) { if (wr == 1) PG8_BAR; }
    }
    PG8_WAIT_V(0);
    if constexpr (!ALIGN_EPI) { if (wr == 0) PG8_BAR; }
    PG8_BAR;
    if constexpr (Epi::AFTER_DRAIN) { E.fused(acc, cur, wr, wc, fr, fq, lds, wid, lane); S.done(cur); }
#undef PG8_SA
#undef PG8_SB
#undef PG8_STAGE
#undef PG8_STAGE_A
#undef PG8_GOFF
#undef PG8_LDA
#undef PG8_LDB
#undef PG8_MMA
#undef PG8_WAIT_V
#undef PG8_WAIT_L
#undef PG8_BAR
#undef PG8_SCHED
}
}
namespace epi {
using pg8::f32x4; using pg8::u32x4; using pg8::Unit; using pg8::bf16_t; using pg8::BM; using pg8::HALF; using pg8::cvt_pk_bf16;
typedef unsigned u32x2 __attribute__((ext_vector_type(2)));
__device__ __forceinline__ float bflo(unsigned w) { return __uint_as_float(w << 16); }
__device__ __forceinline__ float bfhi(unsigned w) { return __uint_as_float(w & 0xffff0000u); }
__device__ __forceinline__ float sigmoidf_fast(float z) { return __builtin_amdgcn_rcpf(1.0f + __builtin_amdgcn_exp2f(-z * LOG2E)); }

struct EpiProj {
    static constexpr bool PERM = true, AFTER_DRAIN = false;
    bf16_t* O; const float* bmerge; unsigned* nrm;
    __device__ __forceinline__ void operator()(const f32x4 (&acc)[2][2][4][2], const Unit& u, int wr, int wc, int fr, int fq) const {
        const int row0 = u.pm * BM + wr * 64 + fr, col0 = u.pn * BM + wc * 32 + 8 * fq;
        const bool isq = (u.pn < 2) || (u.pn == 6) || (u.pn == 7), isg = (u.pn >= 12);
        const float sc = isq ? QSCALE : 1.0f; const bool isn = (u.pn < 4); float nmx[2] = {0.f, 0.f};
        f32x4 bv[2][2];
#pragma unroll
        for (int bj = 0; bj < 2; ++bj)
#pragma unroll
            for (int n = 0; n < 2; ++n) bv[bj][n] = isg ? *(const f32x4*)(bmerge + (col0 - PC_G) + bj * HALF + 4 * n) : (f32x4){0.f, 0.f, 0.f, 0.f};
#pragma unroll
        for (int ai = 0; ai < 2; ++ai)
#pragma unroll
            for (int m = 0; m < 4; ++m) { bf16_t* rowp = O + (size_t)(row0 + ai * HALF + m * 16) * NPROJ + col0;
#pragma unroll
                for (int bj = 0; bj < 2; ++bj) { f32x4 v0 = acc[ai][bj][m][0], v1 = acc[ai][bj][m][1];
                    if (isg) { v0 = v0 + bv[bj][0]; v1 = v1 + bv[bj][1];
#pragma unroll
                        for (int e = 0; e < 4; ++e) { v0[e] = sigmoidf_fast(v0[e]); v1[e] = sigmoidf_fast(v1[e]); } }
                    else { v0 = v0 * sc; v1 = v1 * sc; }
                    if (isn) { float ss = (v0[0] * v0[0] + v0[1] * v0[1]) + (v0[2] * v0[2] + v0[3] * v0[3]) + (v1[0] * v1[0] + v1[1] * v1[1]) + (v1[2] * v1[2] + v1[3] * v1[3]);
                        ss += __shfl_xor(ss, 16); ss += __shfl_xor(ss, 32); nmx[bj] = fmaxf(nmx[bj], ss); }
                    u32x4 w; w.x = cvt_pk_bf16(v0[0], v0[1]); w.y = cvt_pk_bf16(v0[2], v0[3]); w.z = cvt_pk_bf16(v1[0], v1[1]); w.w = cvt_pk_bf16(v1[2], v1[3]);
                    *(u32x4*)(rowp + bj * HALF) = w; } }
        if (isn) {
#pragma unroll
            for (int bj = 0; bj < 2; ++bj) { float v = nmx[bj]; v = fmaxf(v, __shfl_xor(v, 1)); v = fmaxf(v, __shfl_xor(v, 2)); v = fmaxf(v, __shfl_xor(v, 4)); v = fmaxf(v, __shfl_xor(v, 8));
                if (fr == 0 && fq == 0) atomicMax(nrm + ((((u.pn >> 1) * 2 + (u.pm * BM) / SEQ) * 8 + 4 * (u.pn & 1) + 2 * bj + (wc >> 1)) * 2 + (wc & 1)), __float_as_uint(v)); } }
    }
};
template <int MODE> struct EpiBranch {
    static constexpr bool PERM = true, AFTER_DRAIN = false;
    const bf16_t* PROJ; const bf16_t* T1in; bf16_t* O;
    __device__ __forceinline__ void operator()(const f32x4 (&acc)[2][2][4][2], const Unit& u, int wr, int wc, int fr, int fq) const {
        const int row0 = u.pm * BM + wr * 64 + fr, col0 = u.pn * BM + wc * 32 + 8 * fq;
#pragma unroll
        for (int ai = 0; ai < 2; ++ai) { u32x4 gg[4][2], tt[4][2];
#pragma unroll
            for (int m = 0; m < 4; ++m)
#pragma unroll
                for (int bj = 0; bj < 2; ++bj) { const size_t row = (size_t)(row0 + ai * HALF + m * 16); const int col = col0 + bj * HALF;
                    gg[m][bj] = *(const u32x4*)(PROJ + row * NPROJ + PC_G + MODE * 1024 + col); if (MODE == 1) tt[m][bj] = *(const u32x4*)(T1in + row * DM + col); }
            asm volatile("" ::: "memory");
#pragma unroll
            for (int m = 0; m < 4; ++m)
#pragma unroll
                for (int bj = 0; bj < 2; ++bj) { const size_t row = (size_t)(row0 + ai * HALF + m * 16); const int col = col0 + bj * HALF; const u32x4 g = gg[m][bj];
                    f32x4 v0 = acc[ai][bj][m][0], v1 = acc[ai][bj][m][1];
                    v0[0] *= bflo(g.x); v0[1] *= bfhi(g.x); v0[2] *= bflo(g.y); v0[3] *= bfhi(g.y); v1[0] *= bflo(g.z); v1[1] *= bfhi(g.z); v1[2] *= bflo(g.w); v1[3] *= bfhi(g.w);
                    if (MODE == 1) { const u32x4 t = tt[m][bj];
                        v0[0] += bflo(t.x); v0[1] += bfhi(t.x); v0[2] += bflo(t.y); v0[3] += bfhi(t.y); v1[0] += bflo(t.z); v1[1] += bfhi(t.z); v1[2] += bflo(t.w); v1[3] += bfhi(t.w); }
                    u32x4 w; w.x = cvt_pk_bf16(v0[0], v0[1]); w.y = cvt_pk_bf16(v0[2], v0[3]); w.z = cvt_pk_bf16(v1[0], v1[1]); w.w = cvt_pk_bf16(v1[2], v1[3]);
                    *(u32x4*)(O + row * DM + col) = w; }
            asm volatile("" ::: "memory"); }
    }
};
struct EpiWo {
    static constexpr bool PERM = true, AFTER_DRAIN = false;
    const float* x; const float* mod; bf16_t* X1;
    __device__ __forceinline__ void operator()(const f32x4 (&acc)[2][2][4][2], const Unit& u, int wr, int wc, int fr, int fq) const {
        const int row0 = u.pm * BM + wr * 64 + fr, col0 = u.pn * BM + wc * 32 + 8 * fq;
        const float* g1 = mod + (size_t)((u.pm * BM) / SEQ) * (6 * DM) + 2 * DM;
        f32x4 gv[2][2];
#pragma unroll
        for (int bj = 0; bj < 2; ++bj)
#pragma unroll
            for (int n = 0; n < 2; ++n) gv[bj][n] = *(const f32x4*)(g1 + col0 + bj * HALF + n * 4);
#pragma unroll
        for (int ai = 0; ai < 2; ++ai)
#pragma unroll
          for (int mh = 0; mh < 2; ++mh) { f32x4 xv[2][2][2];
#pragma unroll
            for (int m2 = 0; m2 < 2; ++m2)
#pragma unroll
                for (int bj = 0; bj < 2; ++bj)
#pragma unroll
                    for (int n = 0; n < 2; ++n) xv[m2][bj][n] = *(const f32x4*)(x + (size_t)(row0 + ai * HALF + (2 * mh + m2) * 16) * DM + col0 + bj * HALF + n * 4);
            asm volatile("" ::: "memory");
#pragma unroll
            for (int m2 = 0; m2 < 2; ++m2)
#pragma unroll
                for (int bj = 0; bj < 2; ++bj) { const f32x4 v0 = xv[m2][bj][0] + gv[bj][0] * acc[ai][bj][2 * mh + m2][0], v1 = xv[m2][bj][1] + gv[bj][1] * acc[ai][bj][2 * mh + m2][1];
                    u32x4 w; w.x = cvt_pk_bf16(v0[0], v0[1]); w.y = cvt_pk_bf16(v0[2], v0[3]); w.z = cvt_pk_bf16(v1[0], v1[1]); w.w = cvt_pk_bf16(v1[2], v1[3]);
                    *(u32x4*)(X1 + (size_t)(row0 + ai * HALF + (2 * mh + m2) * 16) * DM + col0 + bj * HALF) = w; }
            asm volatile("" ::: "memory"); }
    }
};
struct EpiUp {
    static constexpr bool PERM = true, AFTER_DRAIN = false;
    const float* bup; unsigned char* ACT;
    __device__ __forceinline__ float act1(float a, float b) const {
        const float glu = fminf(a, 7.0f), lin = fminf(fmaxf(b, -7.0f), 7.0f);
        return glu * sigmoidf_fast(1.702f * glu) * (lin + 1.0f);
    }
    __device__ __forceinline__ void operator()(const f32x4 (&acc)[2][2][4][2], const Unit& u, int wr, int wc, int fr, int fq) const {
        const int row0 = u.pm * BM + wr * 64 + fr, col0 = u.pn * BM + wc * 32 + 8 * fq;
        const float* bb = bup + (size_t)u.e * NUP;
        f32x4 bv[2][2];
#pragma unroll
        for (int bj = 0; bj < 2; ++bj)
#pragma unroll
            for (int n = 0; n < 2; ++n) bv[bj][n] = *(const f32x4*)(bb + col0 + bj * HALF + 4 * n);
#pragma unroll
        for (int ai = 0; ai < 2; ++ai)
#pragma unroll
            for (int m = 0; m < 4; ++m) { unsigned char* rowp = ACT + (size_t)(row0 + ai * HALF + m * 16) * DFF + (col0 >> 1);
#pragma unroll
                for (int bj = 0; bj < 2; ++bj) { const f32x4 v0 = acc[ai][bj][m][0] + bv[bj][0], v1 = acc[ai][bj][m][1] + bv[bj][1];
                    int w = 0; w = __builtin_amdgcn_cvt_pk_fp8_f32(act1(v0[0], v0[1]), act1(v0[2], v0[3]), w, false); w = __builtin_amdgcn_cvt_pk_fp8_f32(act1(v1[0], v1[1]), act1(v1[2], v1[3]), w, true);
                    *(unsigned*)(rowp + bj * (HALF / 2)) = (unsigned)w; } }
    }
};
struct EpiDown {
    static constexpr bool PERM = true, AFTER_DRAIN = false;
    const float* bdn; const float* sgate; bf16_t* YP;
    __device__ __forceinline__ void operator()(const f32x4 (&acc)[2][2][4][2], const Unit& u, int wr, int wc, int fr, int fq) const {
        const int row0 = u.pm * BM + wr * 64 + fr, col0 = u.pn * BM + wc * 32 + 8 * fq;
        const float* bb = bdn + (size_t)u.e * DM;
        f32x4 bv[2][2]; float gts[2][4];
#pragma unroll
        for (int bj = 0; bj < 2; ++bj)
#pragma unroll
            for (int n = 0; n < 2; ++n) bv[bj][n] = *(const f32x4*)(bb + col0 + bj * HALF + 4 * n);
#pragma unroll
        for (int ai = 0; ai < 2; ++ai)
#pragma unroll
            for (int m = 0; m < 4; ++m) gts[ai][m] = sgate[(size_t)u.ar + (wr * 64 + fr + ai * HALF + m * 16)];
#pragma unroll
        for (int ai = 0; ai < 2; ++ai)
#pragma unroll
            for (int m = 0; m < 4; ++m) { const size_t row = (size_t)(row0 + ai * HALF + m * 16); const float gt = gts[ai][m]; bf16_t* rowp = YP + row * DM + col0;
#pragma unroll
                for (int bj = 0; bj < 2; ++bj) { const f32x4 v0 = (acc[ai][bj][m][0] + bv[bj][0]) * gt, v1 = (acc[ai][bj][m][1] + bv[bj][1]) * gt;
                    u32x4 w; w.x = cvt_pk_bf16(v0[0], v0[1]); w.y = cvt_pk_bf16(v0[2], v0[3]); w.z = cvt_pk_bf16(v1[0], v1[1]); w.w = cvt_pk_bf16(v1[2], v1[3]);
                    *(u32x4*)(rowp + bj * HALF) = w; } }
    }
};
struct ListOrder {
    const PG8_LAS int* lst; int n;
    __device__ __forceinline__ bool next(int i, Unit& u) const { if (i >= n) return false; u.pm = __builtin_amdgcn_readfirstlane(lst[6 * i]); u.pn = __builtin_amdgcn_readfirstlane(lst[6 * i + 1]); u.pb = __builtin_amdgcn_readfirstlane(lst[6 * i + 2]); u.e = __builtin_amdgcn_readfirstlane(lst[6 * i + 3]);
        u.ar = __builtin_amdgcn_readfirstlane(lst[6 * i + 4]); u.nr = __builtin_amdgcn_readfirstlane(lst[6 * i + 5]); u.md = 0; return true; }
    __device__ __forceinline__ void a_ready(const Unit&) const {}
    __device__ __forceinline__ void done(const Unit&) const {}
};
}
constexpr size_t MiB = 1u << 20;
constexpr int ECAP = 16384;
constexpr size_t WS_CTL = 0, CTL_ZERO_BYTES = 1 * MiB;
constexpr size_t WS_MOD = 1 * MiB;
constexpr size_t WS_SCAL = WS_MOD + 64 * 1024;
constexpr size_t WS_LUT = WS_MOD + 128 * 1024;
constexpr size_t WS_BT = WS_MOD + 256 * 1024;
constexpr size_t WS_FLOC = 2 * MiB;
constexpr size_t WS_F2 = 3 * MiB;
constexpr size_t WS_TOPE = 4 * MiB, WS_RANK = WS_TOPE + 256 * 1024, WS_GATE = WS_RANK + 256 * 1024, WS_SLOT = WS_GATE + 256 * 1024;
constexpr size_t WS_SGATE = 5 * MiB;
constexpr size_t WS_WIN = 6 * MiB;
constexpr size_t WS_WBF = 16 * MiB, WS_WBD = 17 * MiB, WS_WO = 18 * MiB;
constexpr size_t WS_WUP = 20 * MiB;
constexpr size_t WS_WDN = 148 * MiB;
constexpr size_t WS_XN = 212 * MiB;
constexpr size_t WS_PROJ = 244 * MiB;
constexpr size_t WS_XG = WS_PROJ;
constexpr size_t WS_YFOX = 404 * MiB;
constexpr size_t WS_OD = 420 * MiB;
constexpr size_t WS_YD = 452 * MiB;
constexpr size_t WS_T1 = 468 * MiB;
constexpr size_t WS_MRG = 500 * MiB;
constexpr size_t WS_ACT = WS_PROJ;
constexpr size_t WS_YP = WS_YFOX;
constexpr size_t WS_X1B = 548 * MiB;
constexpr size_t WS_KA = 820 * MiB;
constexpr size_t WS_IDX = 822 * MiB;
constexpr size_t WS_GX = 824 * MiB;
constexpr size_t WS_END = 826 * MiB;
static_assert(WS_PROJ + (size_t)M * NPROJ * 2 <= WS_YFOX && WS_ACT + (size_t)PMAX * DM * 2 <= WS_YFOX && WS_MRG + (size_t)M * DM * 2 <= WS_YP + (size_t)PMAX * DM * 2 && WS_YP + (size_t)PMAX * DM * 2 <= WS_KA, "d_ws map");
constexpr int CW_TMO = 0;
constexpr int CW_CNT = 1024;
constexpr int CW_NRM = 3200;
constexpr int CW_BAR = 4096;
constexpr int CW_PAN = 16384;
constexpr int CW_Q = 8192;

constexpr int RING_OFF = 0, RING_BYTES = 131072;
constexpr int LDSCTL_OFF = RING_BYTES, MISC_OFF = LDSCTL_OFF + 320;
constexpr int TAB_OFF = LDSCTL_OFF + 1024;
constexpr int LDS_BYTES = 147456;
constexpr int NWAVES = 8;
#define GAS __attribute__((address_space(1)))
#define LAS __attribute__((address_space(3)))
typedef unsigned short bf16;
typedef unsigned v4u __attribute__((ext_vector_type(4)));
typedef float f32x4 __attribute__((ext_vector_type(4)));
typedef short bf16x8 __attribute__((ext_vector_type(8)));
typedef GAS unsigned gu32;
typedef GAS unsigned long long gu64;
#define RLX_AGENT __ATOMIC_RELAXED, __HIP_MEMORY_SCOPE_AGENT
#define LDS_WAIT() asm volatile("s_waitcnt lgkmcnt(0)" ::: "memory")
#define VM_WAIT() asm volatile("s_waitcnt vmcnt(0)" ::: "memory")
__device__ __forceinline__ unsigned long long rt() { return __builtin_amdgcn_s_memrealtime(); }
__device__ __forceinline__ unsigned f2bf(float f) { unsigned u = __builtin_bit_cast(unsigned, f); return (u + 0x7fffu + ((u >> 16) & 1u)) >> 16; }
__device__ __forceinline__ unsigned pk2(float lo, float hi) { return f2bf(lo) | (f2bf(hi) << 16); }

#define XB_TMO      128
#define XB_XCNT(j)  (256  + 64 * (j))
#define XB_XSUB(j)  (1280 + 64 * (j))
#define XB_XGEN(j)  (2304 + 64 * (j))
#define XB_TOP      3328
#define XB_TOPGEN   3392
#define XCD_BAR_WORDS 3456
#define XB_SPIN_CAP (1u << 18)

__device__ __forceinline__ unsigned xb_ld(unsigned* p)              { return __hip_atomic_load(p, __ATOMIC_RELAXED, __HIP_MEMORY_SCOPE_AGENT); }
__device__ __forceinline__ unsigned xb_add(unsigned* p, unsigned v) { return __hip_atomic_fetch_add(p, v, __ATOMIC_RELAXED, __HIP_MEMORY_SCOPE_AGENT); }
__device__ __forceinline__ unsigned xb_xcc_id() { return (unsigned)__builtin_amdgcn_s_getreg((3 << 11) | 20) & 0xFu; }
#define XB_SPIN(cond, bar) do { unsigned _sp = 0; while (cond) { __builtin_amdgcn_s_sleep(1); \
    if ((++_sp & 255u) == 0u) { if (xb_ld(&(bar)[XB_TMO])) break; if (_sp > XB_SPIN_CAP) { atomicAdd(&(bar)[XB_TMO], 1u); break; } } } } while (0)

struct XcdBarrier {
    unsigned* bar; unsigned x;
    volatile LAS unsigned* st;
};

__device__ __forceinline__ XcdBarrier xcd_barrier_post(unsigned* bar, volatile LAS unsigned* st) {
    XcdBarrier b; b.bar = bar; b.x = xb_xcc_id(); b.st = st;
    if (threadIdx.x == 0) (void)xb_add(&bar[XB_XCNT(b.x)], 1u);
    return b;
}
__device__ __forceinline__ void xcd_barrier_complete(unsigned* bar, unsigned x, unsigned& nloc, unsigned& nx) {
    const unsigned G = gridDim.x * gridDim.y * gridDim.z;
    unsigned sum, cnt, mine, sp = 0u;
    for (;;) {
        sum = 0u; cnt = 0u; mine = 0u;
#pragma unroll
        for (unsigned j = 0; j < 16; ++j) { const unsigned c = xb_ld(&bar[XB_XCNT(j)]); sum += c; cnt += (c > 0u) ? 1u : 0u; mine = (j == x) ? c : mine; }
        if (sum == G) break;
        __builtin_amdgcn_s_sleep(1);
        if ((++sp & 255u) == 0u) { if (xb_ld(&bar[XB_TMO])) break; if (sp > XB_SPIN_CAP) { atomicAdd(&bar[XB_TMO], 1u); break; } }
    }
    nloc = mine > 0u ? mine : 1u; nx = cnt > 0u ? cnt : 1u;
}

__device__ __forceinline__ void xcd_barrier(const XcdBarrier& b) {
    asm volatile("s_waitcnt vmcnt(0)" ::: "memory");
    __syncthreads();
    if (threadIdx.x == 0) {
        unsigned* bar = b.bar;
        __builtin_amdgcn_s_waitcnt(0);
        unsigned nloc = b.st[0], nx = b.st[1];
        if (nloc == 0u) { xcd_barrier_complete(bar, b.x, nloc, nx); b.st[0] = nloc; b.st[1] = nx; }
        const unsigned old = xb_add(&bar[XB_XSUB(b.x)], 1u);
        const unsigned gen = old / nloc;
        if (old + 1u == (gen + 1u) * nloc) {
            __builtin_amdgcn_fence(__ATOMIC_RELEASE, "agent");
            asm volatile("s_waitcnt vmcnt(0)" ::: "memory");
            const unsigned og = xb_add(&bar[XB_TOP], 1u);
            const unsigned tg = og / nx;
            if (og + 1u == (tg + 1u) * nx) xb_add(&bar[XB_TOPGEN], 1u);
            else XB_SPIN(xb_ld(&bar[XB_TOPGEN]) == tg, bar);
            __builtin_amdgcn_fence(__ATOMIC_ACQUIRE, "agent");
            xb_add(&bar[XB_XGEN(b.x)], 1u);
            asm volatile("s_waitcnt vmcnt(0)" ::: "memory");
        } else {
            XB_SPIN(xb_ld(&bar[XB_XGEN(b.x)]) == gen, bar);
            __builtin_amdgcn_fence(__ATOMIC_ACQUIRE, "agent");
            asm volatile("s_waitcnt vmcnt(0)" ::: "memory");
        }
    }
    __syncthreads();
}
#include <hip/hip_bf16.h>
#include <cmath>
namespace attn_body {
using bf16=__hip_bfloat16;
using bf16x8=__attribute__((ext_vector_type(8)))short;
using s16x4=__attribute__((ext_vector_type(4)))short;
using f32x16=__attribute__((ext_vector_type(16)))float;
using u32x4=__attribute__((ext_vector_type(4)))unsigned;
using f32x4_t=__attribute__((ext_vector_type(4)))float;
constexpr int D=64,PITCH=NPROJ;
constexpr int NW=8,QBLK=32,QB=QBLK*NW,KVBLK=64,NQB=SEQ/QB;
constexpr int ATTN_UNIT_ROWS=QB;
__device__ __forceinline__ int crow(int r,int hi){return (r&3)+8*(r>>2)+4*hi;}
#define SBAR() __builtin_amdgcn_sched_barrier(0)
__device__ __forceinline__ void cmask(f32x16&p0,f32x16&p1,int jb,int qrel,int hi){
  const float NEG=-INFINITY; int kb=64*jb+4*hi;
  #pragma unroll
  for(int r=0;r<16;++r){int kv=kb+(r&3)+8*(r>>2); if(kv>qrel)p0[r]=NEG; if(kv+32>qrel)p1[r]=NEG;}
}

constexpr int NSLOT=3, SLOTB=9216;
constexpr int LDS_K=0, LDS_V=NSLOT*SLOTB, LDS_WS=2*NSLOT*SLOTB, LDS_OST=LDS_WS+NW*64*4, LDS_BYTES=LDS_OST+NW*4096;
constexpr int LDS_LUT=106496, LUTN=644, LDS_TOTAL=LDS_LUT+4*LUTN*4;
static_assert(LDS_TOTAL<=131072 && LDS_LUT%16==0 && LDS_LUT>=LDS_BYTES, "attention LDS map");
constexpr float C2=0.125f*1.4426950408889634f;
__device__ __forceinline__ void glds16(const void*gsrc,unsigned lds_dst){unsigned keep;
  asm volatile("s_mov_b32 %0, m0\n\ts_mov_b32 m0, %2\n\ts_nop 0\n\tglobal_load_lds_dwordx4 %1, off\n\ts_mov_b32 m0, %0":"=&s"(keep):"v"(gsrc),"s"(lds_dst):"memory");}
__device__ __forceinline__ float max3f(float a,float b,float c){float r;asm("v_max3_f32 %0, %1, %2, %3":"=v"(r):"v"(a),"v"(b),"v"(c));return r;}
__device__ __forceinline__ float max2f(float a,float b){float r;asm("v_max_f32_e32 %0, %1, %2":"=v"(r):"v"(a),"v"(b));return r;}
__device__ __forceinline__ float fadd_s(float a,float b){float r;asm("v_add_f32_e32 %0, %1, %2":"=v"(r):"v"(a),"v"(b));return r;}
__device__ __forceinline__ float fsub_s(float a,float b){float r;asm("v_sub_f32_e32 %0, %1, %2":"=v"(r):"v"(a),"v"(b));return r;}
typedef float f32x2_t __attribute__((ext_vector_type(2))); typedef __bf16 bf16x2_t __attribute__((ext_vector_type(2)));
__device__ __forceinline__ unsigned cvtpk_s(float lo,float hi){f32x2_t v={lo,hi};bf16x2_t b=__builtin_convertvector(v,bf16x2_t);return __builtin_bit_cast(unsigned,b);}
#define WAIT_BAR(N) asm volatile("s_waitcnt vmcnt(" #N ") lgkmcnt(0)\n\ts_barrier":::"memory")

__device__ __forceinline__ void qkt(f32x16&p0,f32x16&p1,const char*Kslot,const bf16x8*qr,const f32x16&c0,const f32x16&c1,int r32,int hi){
  const char*kb=Kslot+hi*1024+r32*16;
  #pragma unroll
  for(int d0=0;d0<4;++d0){
    const bf16x8 b0=*reinterpret_cast<const bf16x8*>(kb+d0*2048);
    const bf16x8 b1=*reinterpret_cast<const bf16x8*>(kb+d0*2048+512);
    if(d0==0){p0=__builtin_amdgcn_mfma_f32_32x32x16_bf16(b0,qr[0],c0,0,0,0);p1=__builtin_amdgcn_mfma_f32_32x32x16_bf16(b1,qr[0],c1,0,0,0);}
    else{p0=__builtin_amdgcn_mfma_f32_32x32x16_bf16(b0,qr[d0],p0,0,0,0);p1=__builtin_amdgcn_mfma_f32_32x32x16_bf16(b1,qr[d0],p1,0,0,0);}}
}
__device__ __forceinline__ bf16x8 make_qaug(float v,int hi){
  const unsigned h=cvtpk_s(v,0.f)&0xffffu; const float r1=v-__uint_as_float(h<<16);
  const unsigned m=cvtpk_s(r1,0.f)&0xffffu; const float r2=r1-__uint_as_float(m<<16);
  const unsigned l=cvtpk_s(r2,0.f)&0xffffu;
  u32x4 w; w.x=0x3F803F80u; w.y=0x3F80u|(h<<16); w.z=m|(l<<16); w.w=0u; if(hi){w.x=0u;w.y=0u;w.z=0u;}
  return __builtin_bit_cast(bf16x8,w);
}
typedef __attribute__((address_space(3))) const char* lds_cptr;
typedef short v4i16_t __attribute__((ext_vector_type(4)));
__device__ __forceinline__ void kload8(bf16x8*kf,lds_cptr kp){
  kf[0]=*(const __attribute__((address_space(3))) bf16x8*)(kp);      kf[1]=*(const __attribute__((address_space(3))) bf16x8*)(kp+512);
  kf[2]=*(const __attribute__((address_space(3))) bf16x8*)(kp+2048); kf[3]=*(const __attribute__((address_space(3))) bf16x8*)(kp+2560);
  kf[4]=*(const __attribute__((address_space(3))) bf16x8*)(kp+4096); kf[5]=*(const __attribute__((address_space(3))) bf16x8*)(kp+4608);
  kf[6]=*(const __attribute__((address_space(3))) bf16x8*)(kp+6144); kf[7]=*(const __attribute__((address_space(3))) bf16x8*)(kp+6656);
}
__device__ __forceinline__ void kload2(bf16x8*kf,lds_cptr kp,int j){ kf[2*j]=*(const __attribute__((address_space(3))) bf16x8*)(kp+j*2048); kf[2*j+1]=*(const __attribute__((address_space(3))) bf16x8*)(kp+j*2048+512); }
__device__ __forceinline__ s16x4 vtr(lds_cptr p){ return __builtin_bit_cast(s16x4,__builtin_amdgcn_ds_read_tr16_b64_v4i16((__attribute__((address_space(3))) v4i16_t*)p)); }
__device__ __forceinline__ float rowmax(const f32x16&p0,const f32x16&p1){
  float a=max3f(p0[0],p0[1],p1[0]),b=max3f(p0[2],p0[3],p1[1]);a=max3f(a,p1[2],p1[3]);
  #pragma unroll
  for(int r=4;r<16;r+=4){a=max3f(a,p0[r],p0[r+1]);b=max3f(b,p0[r+2],p0[r+3]);a=max3f(a,p1[r],p1[r+1]);b=max3f(b,p1[r+2],p1[r+3]);}
  const float m=max2f(a,b);
  auto rr=__builtin_amdgcn_permlane32_swap(__float_as_uint(m),__float_as_uint(m),false,false);
  return max2f(__uint_as_float(rr[0]),__uint_as_float(rr[1]));
}
__device__ __forceinline__ void pv(f32x16*o,int vb,bf16x8 pa0,bf16x8 pa1,bf16x8 pa2,bf16x8 pa3){
  #pragma unroll
  for(int d0=0;d0<2;++d0){s16x4 lo[4],hi[4];
    #pragma unroll
    for(int ks=0;ks<4;++ks){
      asm volatile("ds_read_b64_tr_b16 %0,%1 offset:%c2":"=&v"(lo[ks]):"v"(vb),"i"(d0*4096+ks*1024):"memory");
      asm volatile("ds_read_b64_tr_b16 %0,%1 offset:%c2":"=&v"(hi[ks]):"v"(vb),"i"(d0*4096+ks*1024+512):"memory");}
    asm volatile("s_waitcnt lgkmcnt(0)":::"memory");SBAR();
    #define PK(k) (bf16x8){lo[k][0],lo[k][1],lo[k][2],lo[k][3],hi[k][0],hi[k][1],hi[k][2],hi[k][3]}
    o[d0]=__builtin_amdgcn_mfma_f32_32x32x16_bf16(pa0,PK(0),o[d0],0,0,0);
    o[d0]=__builtin_amdgcn_mfma_f32_32x32x16_bf16(pa1,PK(1),o[d0],0,0,0);
    o[d0]=__builtin_amdgcn_mfma_f32_32x32x16_bf16(pa2,PK(2),o[d0],0,0,0);
    o[d0]=__builtin_amdgcn_mfma_f32_32x32x16_bf16(pa3,PK(3),o[d0],0,0,0);
    #undef PK
  }
}

#ifndef ATTN_STORE16
#define ATTN_STORE16(p,v) (*(u32x4*)(p)=(v))
#endif
template<int MODE,int THRL> __device__ __forceinline__ void attn_unit(int qb,const bf16*Qj,const bf16*__restrict__ Kj,const bf16*__restrict__ Vj,bf16*Oj,int opitch,const float*__restrict__ F2h,const bf16*__restrict__ KAh0,float twoB,int dhead,char*shm){
  int tid_=threadIdx.x; asm volatile("":"+v"(tid_));
  const int tid=tid_,lane=tid&63,r32=lane&31,hi=lane>>5; const int wid=__builtin_amdgcn_readfirstlane(tid>>6);
  const int q0=qb*QB;
  const bf16*Qw=Qj+(long)(q0+wid*QBLK)*PITCH;
  int t0=0;
  if(MODE==0){ const int NT0=(q0+QB)/KVBLK; const float fq0=F2h[q0]; const int j0=lane,j1=lane+64;
    const bool s0=(j0<NT0-4)&&(twoB+fq0-F2h[64*j0+63]<-60.f), s1=(j1<NT0-4)&&(twoB+fq0-F2h[64*j1+63]<-60.f);
    t0=(__builtin_popcountll(__ballot(s0))+__builtin_popcountll(__ballot(s1)))&~1; t0=__builtin_amdgcn_readfirstlane(t0); }
  const bf16*Kh=Kj+(long)t0*KVBLK*PITCH,*Vh=Vj+(long)t0*KVBLK*PITCH; const bf16*KAh=KAh0+(long)t0*KVBLK*8;
  const unsigned lds0=(unsigned)(uintptr_t)shm;
  float*wsf=(float*)(shm+LDS_WS)+wid*64;
  const bf16*ksrc=Kh+(long)lane*PITCH+wid*8;
  const bf16*vsrc=Vh+(long)(16*(wid&3)+(lane>>2))*PITCH+(wid>>2)*32+(lane&3)*8;
  const unsigned kdst=lds0+LDS_K+wid*1024, vdst=lds0+LDS_V+wid*1024;
  const bf16*kasrc=KAh+(long)lane*8; const unsigned kadst=lds0+LDS_K+8192;
  #define DMA_K(t,slot) do{ glds16(ksrc+(long)(t)*KVBLK*PITCH,(unsigned)__builtin_amdgcn_readfirstlane(kdst+(slot))); \
    if(MODE==0&&wid==0) glds16(kasrc+(long)(t)*KVBLK*8,(unsigned)__builtin_amdgcn_readfirstlane(kadst+(slot))); }while(0)
  #define WAITK(N0,N1) do{ if(MODE==0&&wid==0){WAIT_BAR(N1);}else{WAIT_BAR(N0);} }while(0)
  #define DMA_V(t,slot) glds16(vsrc+(long)(t)*KVBLK*PITCH,(unsigned)__builtin_amdgcn_readfirstlane(vdst+(slot)))
  const int vb0=(int)(lds0+LDS_V)+((lane>>4)&1)*32+(lane&3)*8+(4*hi+((lane&15)>>2))*64;
  const char*Kbase=shm+LDS_K; bf16x8 kf[8];
  const lds_cptr shm3=(lds_cptr)shm; const lds_cptr kp0=shm3+LDS_K+hi*1024+r32*16; const lds_cptr vp0=shm3+LDS_V+((lane>>4)&1)*32+(lane&3)*8+(4*hi+((lane&15)>>2))*64;
  const int NT=(q0+QB)/KVBLK-t0;
  const int qrel=wid*QBLK+r32;
  float qoff=0.f, mhat=0.f; bf16x8 qaug=bf16x8{}, ka0=bf16x8{}, ka1=bf16x8{};
  if(MODE==0){ qoff=F2h[q0+qrel];
    const bf16*kd=Kj+(long)(q0+qrel)*PITCH+hi*8; const bf16*qd=Qw+(long)r32*PITCH+hi*8; float dsum=0.f;
    _Pragma("unroll") for(int d0=0;d0<4;++d0){ const u32x4 kw=*reinterpret_cast<const u32x4*>(kd+d0*16), qw=*reinterpret_cast<const u32x4*>(qd+d0*16);
      _Pragma("unroll") for(int e=0;e<4;++e){ dsum+=__uint_as_float(kw[e]<<16)*__uint_as_float(qw[e]<<16)+__uint_as_float(kw[e]&0xffff0000u)*__uint_as_float(qw[e]&0xffff0000u); } }
    dsum+=__shfl_xor(dsum,32); mhat=dsum; qaug=make_qaug(qoff-mhat,hi); }
  const __attribute__((address_space(3))) float* lutr=(const __attribute__((address_space(3))) float*)(shm3+LDS_LUT)+dhead*LUTN;
  DMA_K(0,0);DMA_V(0,0);DMA_K(1,SLOTB);
  bf16x8 qr[4];
  #pragma unroll
  for(int d0=0;d0<4;++d0)qr[d0]=*reinterpret_cast<const bf16x8*>(&Qw[(long)r32*PITCH+d0*16+hi*8]);
  float l_reg=0.f;f32x16 o[2];o[0]=f32x16{};o[1]=f32x16{};f32x16 negm;
  _Pragma("unroll") for(int r=0;r<16;++r)negm[r]=0.f; asm volatile("":"+v"(negm));
  #define BIAS_(P0,P1,t,NEAR_) do{ if(MODE==0){} \
    else if(NEAR_ && (t)>=NT-6){ const __attribute__((address_space(3))) float* lp_=lutr+(383-(q0-64*(t)+qrel-4*hi)); \
      _Pragma("unroll") for(int r_=0;r_<16;++r_){ P0[r_]+=lp_[(r_&3)+8*(r_>>2)]; P1[r_]+=lp_[32+(r_&3)+8*(r_>>2)]; if((r_&3)==3)SBAR(); } } }while(0)
  #define BIAS(P0,P1,t) BIAS_(P0,P1,t,true)
  #define CMASK(P0,P1,t) do{int jb_=(t)-(NT-4); if(jb_>=0)cmask(P0,P1,jb_,qrel,hi);}while(0)
  bool resc=false;
  #define START(P0,P1) do{ const float rm=rowmax(P0,P1); resc=false; \
    { const float dl=rm; mhat=fadd_s(mhat,dl); \
      _Pragma("unroll") for(int r=0;r<16;++r){P0[r]=fsub_s(P0[r],dl);P1[r]=fsub_s(P1[r],dl);} \
      _Pragma("unroll") for(int r=0;r<16;++r)negm[r]=-mhat; asm volatile("":"+v"(negm)); } \
    _Pragma("unroll") for(int r=0;r<16;++r)P0[r]=__builtin_amdgcn_exp2f(P0[r]); }while(0)
  #define RESC() do{ if(resc){ asm volatile("s_waitcnt lgkmcnt(0)":::"memory"); \
      _Pragma("unroll") for(int d_=0;d_<2;++d_) _Pragma("unroll") for(int r=0;r<16;++r)o[d_][r]*=wsf[crow(r,hi)]; } }while(0)
  f32x16 pA0,pA1,pB0,pB1;
  #define MX3_(a,b,c) __builtin_fmaxf(__builtin_fmaxf((a),(b)),(c))
  int sl_prev=0,sl_cur=0,sl_next=SLOTB;
  #define ROT() do{sl_prev=sl_cur;sl_cur=sl_next;sl_next=(sl_next==(NSLOT-1)*SLOTB)?0:sl_next+SLOTB;}while(0)
  DMA_K(2,2*SLOTB);
  WAITK(3,5);
  const lds_cptr kap0=shm3+LDS_K+8192+r32*16;
  #define KALD(sl) do{ ka0=*(const __attribute__((address_space(3))) bf16x8*)(kap0+(sl)); ka1=*(const __attribute__((address_space(3))) bf16x8*)(kap0+(sl)+512); }while(0)
  if(MODE==0){ KALD(0); const f32x16 z16=f32x16{};
    const f32x16 a0=__builtin_amdgcn_mfma_f32_32x32x16_bf16(ka0,qaug,z16,0,0,0), a1=__builtin_amdgcn_mfma_f32_32x32x16_bf16(ka1,qaug,z16,0,0,0);
    qkt(pA0,pA1,Kbase,qr,a0,a1,r32,hi); CMASK(pA0,pA1,0);
    { float a=MX3_(pA0[0],pA0[1],pA1[0]),b=MX3_(pA0[2],pA0[3],pA1[1]); a=MX3_(a,pA1[2],pA1[3]);
      _Pragma("unroll") for(int r=4;r<16;r+=4){a=MX3_(a,pA0[r],pA0[r+1]);b=MX3_(b,pA0[r+2],pA0[r+3]);a=MX3_(a,pA1[r],pA1[r+1]);b=MX3_(b,pA1[r+2],pA1[r+3]);}
      float rm=__builtin_fmaxf(a,b); { auto rr=__builtin_amdgcn_permlane32_swap(__float_as_uint(rm),__float_as_uint(rm),false,false); rm=__builtin_fmaxf(__uint_as_float(rr[0]),__uint_as_float(rr[1])); }
      if(__any(rm>(float)THRL)){ const float dl=__builtin_fmaxf(rm,0.f); mhat+=dl; _Pragma("unroll") for(int r=0;r<16;++r){pA0[r]-=dl;pA1[r]-=dl;} qaug=make_qaug(qoff-mhat,hi); } }
    _Pragma("unroll") for(int r=0;r<16;++r)pA0[r]=__builtin_amdgcn_exp2f(pA0[r]);
  } else {
  qkt(pA0,pA1,Kbase,qr,negm,negm,r32,hi);asm volatile("s_nop 15\n\ts_nop 7":"+v"(pA0),"+v"(pA1));BIAS(pA0,pA1,0);CMASK(pA0,pA1,0);
  START(pA0,pA1);
  }
  _Pragma("unroll") for(int r=0;r<16;++r)pA1[r]=__builtin_amdgcn_exp2f(pA1[r]);
  WAIT_BAR(0);
  DMA_K(3,0);DMA_V(1,SLOTB);
  ROT();
  kload8(kf,kp0+sl_cur); if(MODE==0)KALD(sl_cur);
  WAITK(2,3);
  s16x4 vlo[8],vhi[8]; u32x4 pw0,pw1,pw2,pw3;
  #define PKW(P,B) cvtpk_s(P[B],P[B+1])
  #define PAF(k) __builtin_bit_cast(bf16x8,pw##k)
  #define VFR(i) (bf16x8){vlo[i][0],vlo[i][1],vlo[i][2],vlo[i][3],vhi[i][0],vhi[i][1],vhi[i][2],vhi[i][3]}
  #define PIN(x) asm volatile("":"+v"(x))
  #define MX3(a,b,c) __builtin_fmaxf(__builtin_fmaxf((a),(b)),(c))
  #define GAPA(MF,A0,A1,A2,A3,W0,W1,PW) do{ MF; sacc+=A0; sacc+=A1; sacc+=A2; sacc+=A3; PIN(sacc); W0; W1; PIN(PW); SBAR(); }while(0)
  #define EX(v) __builtin_amdgcn_exp2f(v)
  #define GAPB(MF,X,B) do{ MF; X[B]=EX(X[B]); X[B+1]=EX(X[B+1]); X[B+2]=EX(X[B+2]); X[B+3]=EX(X[B+3]); PIN(X); SBAR(); }while(0)
  #define VRD(i) do{ vlo[i]=vtr(vp_+(((i)>>2)*4096+((i)&3)*1024)); vhi[i]=vtr(vp_+(((i)>>2)*4096+((i)&3)*1024+512)); }while(0)
  #define KRD(G,j) do{ if(G){ kload2(kf,kp0+sl_next,j); if(MODE==0&&(j)==0)KALD(sl_next); SBAR(); } }while(0)
  #define STEP(C0,C1,P0,P1,t,GK,GV,GL) do{ SBAR(); \
    if(MODE==0){ const f32x16 z16_=f32x16{}; C0=__builtin_amdgcn_mfma_f32_32x32x16_bf16(ka0,qaug,z16_,0,0,0); C1=__builtin_amdgcn_mfma_f32_32x32x16_bf16(ka1,qaug,z16_,0,0,0); SBAR(); } \
    const lds_cptr vp_=vp0+sl_prev; \
    VRD(0); SBAR(); float sacc=(P0[0]+P0[1]); \
    GAPA(C0=__builtin_amdgcn_mfma_f32_32x32x16_bf16(kf[0],qr[0],(MODE==0?C0:negm),0,0,0), P0[2],P0[3],P0[4],P0[5],     pw0[0]=PKW(P0,0), pw0[1]=PKW(P0,2), pw0); \
    VRD(4); SBAR(); GAPA(C1=__builtin_amdgcn_mfma_f32_32x32x16_bf16(kf[1],qr[0],(MODE==0?C1:negm),0,0,0), P0[6],P0[7],P0[8],P0[9],     pw0[2]=PKW(P0,4), pw0[3]=PKW(P0,6), pw0); \
    VRD(1); SBAR(); GAPA(C0=__builtin_amdgcn_mfma_f32_32x32x16_bf16(kf[2],qr[1],C0,0,0,0),   P0[10],P0[11],P0[12],P0[13], pw1[0]=PKW(P0,8), pw1[1]=PKW(P0,10), pw1); \
    VRD(5); SBAR(); GAPA(C1=__builtin_amdgcn_mfma_f32_32x32x16_bf16(kf[3],qr[1],C1,0,0,0),   P0[14],P0[15],P1[0],P1[1],   pw1[2]=PKW(P0,12),pw1[3]=PKW(P0,14), pw1); \
    VRD(2); SBAR(); GAPA(C0=__builtin_amdgcn_mfma_f32_32x32x16_bf16(kf[4],qr[2],C0,0,0,0),   P1[2],P1[3],P1[4],P1[5],     pw2[0]=PKW(P1,0), pw2[1]=PKW(P1,2), pw2); \
    VRD(6); SBAR(); GAPA(C1=__builtin_amdgcn_mfma_f32_32x32x16_bf16(kf[5],qr[2],C1,0,0,0),   P1[6],P1[7],P1[8],P1[9],     pw2[2]=PKW(P1,4), pw2[3]=PKW(P1,6), pw2); \
    VRD(3); SBAR(); GAPA(C0=__builtin_amdgcn_mfma_f32_32x32x16_bf16(kf[6],qr[3],C0,0,0,0),   P1[10],P1[11],P1[12],P1[13], pw3[0]=PKW(P1,8), pw3[1]=PKW(P1,10), pw3); \
    VRD(7); SBAR(); GAPA(C1=__builtin_amdgcn_mfma_f32_32x32x16_bf16(kf[7],qr[3],C1,0,0,0),   P1[14],P1[15],0.f,0.f,       pw3[2]=PKW(P1,12),pw3[3]=PKW(P1,14), pw3); \
    l_reg+=sacc; \
    if(GK){DMA_K((t)+3,sl_cur);} if(GV){DMA_V((t)+1,sl_next);} \
    BIAS(C0,C1,t); CMASK(C0,C1,t); \
    { float a=MX3(C0[0],C0[1],C1[0]),b=MX3(C0[2],C0[3],C1[1]); a=MX3(a,C1[2],C1[3]); \
      _Pragma("unroll") for(int r=4;r<16;r+=4){a=MX3(a,C0[r],C0[r+1]);b=MX3(b,C0[r+2],C0[r+3]);a=MX3(a,C1[r],C1[r+1]);b=MX3(b,C1[r+2],C1[r+3]);} \
      float rm=__builtin_fmaxf(a,b); { auto rr=__builtin_amdgcn_permlane32_swap(__float_as_uint(rm),__float_as_uint(rm),false,false); rm=__builtin_fmaxf(__uint_as_float(rr[0]),__uint_as_float(rr[1])); } \
      resc=false; \
      if(__builtin_expect(__any(rm>(float)THRL),0)){ const float dl=__builtin_fmaxf(rm,0.f); mhat+=dl; \
        _Pragma("unroll") for(int r=0;r<16;++r){C0[r]-=dl;C1[r]-=dl;} \
        if(MODE==0){ qaug=make_qaug(qoff-mhat,hi); } else { _Pragma("unroll") for(int r=0;r<16;++r)negm[r]=-mhat; asm volatile("":"+v"(negm)); } \
        const float f=__builtin_amdgcn_exp2f(-dl); l_reg*=f; if(hi==0)wsf[r32]=f; resc=true; } } \
    SBAR(); \
    GAPB(o[0]=__builtin_amdgcn_mfma_f32_32x32x16_bf16(PAF(0),VFR(0),o[0],0,0,0), C0,0); \
    GAPB(o[1]=__builtin_amdgcn_mfma_f32_32x32x16_bf16(PAF(0),VFR(4),o[1],0,0,0), C0,4); \
    KRD(GL,0); GAPB(o[0]=__builtin_amdgcn_mfma_f32_32x32x16_bf16(PAF(1),VFR(1),o[0],0,0,0), C0,8); \
    KRD(GL,1); GAPB(o[1]=__builtin_amdgcn_mfma_f32_32x32x16_bf16(PAF(1),VFR(5),o[1],0,0,0), C0,12); \
    KRD(GL,2); GAPB(o[0]=__builtin_amdgcn_mfma_f32_32x32x16_bf16(PAF(2),VFR(2),o[0],0,0,0), C1,0); \
    KRD(GL,3); GAPB(o[1]=__builtin_amdgcn_mfma_f32_32x32x16_bf16(PAF(2),VFR(6),o[1],0,0,0), C1,4); \
    GAPB(o[0]=__builtin_amdgcn_mfma_f32_32x32x16_bf16(PAF(3),VFR(3),o[0],0,0,0), C1,8); \
    GAPB(o[1]=__builtin_amdgcn_mfma_f32_32x32x16_bf16(PAF(3),VFR(7),o[1],0,0,0), C1,12); \
    }while(0)
  int t=1;
  #undef CMASK
  #define CMASK(P0,P1,t) do{}while(0)
  #undef BIAS
  #define BIAS(P0,P1,t) BIAS_(P0,P1,t,false)
  for(;t+7<NT;t+=2){
    STEP(pB0,pB1,pA0,pA1,t,true,true,true);     WAITK(2,3); RESC(); ROT();
    STEP(pA0,pA1,pB0,pB1,t+1,true,true,true);   WAITK(2,3); RESC(); ROT();
  }
  #undef CMASK
  #define CMASK(P0,P1,t) do{int jb_=(t)-(NT-4); if(jb_>=0)cmask(P0,P1,jb_,qrel,hi);}while(0)
  #undef BIAS
  #define BIAS(P0,P1,t) BIAS_(P0,P1,t,true)
  #define ENDW(tt) do{ if((tt)+3<NT){WAITK(2,3);} else if((tt)+2<NT){WAIT_BAR(1);} else {WAIT_BAR(0);} }while(0)
  for(;t+1<NT;t+=2){
    STEP(pB0,pB1,pA0,pA1,t,(t+3<NT),(t+1<NT),(t+1<NT));       ENDW(t);   RESC(); ROT();
    STEP(pA0,pA1,pB0,pB1,t+1,(t+4<NT),(t+2<NT),(t+2<NT));     ENDW(t+1); RESC(); ROT();
  }
  STEP(pB0,pB1,pA0,pA1,NT-1,false,false,false); RESC();
  { float sacc=pB0[0]+pB0[1]; _Pragma("unroll") for(int r=2;r<16;++r)sacc+=pB0[r]; _Pragma("unroll") for(int r=0;r<16;++r)sacc+=pB1[r]; l_reg+=sacc;
    pw0=(u32x4){PKW(pB0,0),PKW(pB0,2),PKW(pB0,4),PKW(pB0,6)};pw1=(u32x4){PKW(pB0,8),PKW(pB0,10),PKW(pB0,12),PKW(pB0,14)};pw2=(u32x4){PKW(pB1,0),PKW(pB1,2),PKW(pB1,4),PKW(pB1,6)};pw3=(u32x4){PKW(pB1,8),PKW(pB1,10),PKW(pB1,12),PKW(pB1,14)};
    SBAR(); pv(o,vb0+sl_cur,PAF(0),PAF(1),PAF(2),PAF(3)); }
  #undef PKW
  #undef PAF
  #undef VFR
  #undef PIN
  #undef MX3
  #undef GAPA
  #undef GAPB
  #undef EX
  #undef VRD
  #undef KRD
  #undef STEP
  #undef ENDW
  {auto rr=__builtin_amdgcn_permlane32_swap(__float_as_uint(l_reg),__float_as_uint(l_reg),false,false);l_reg=__uint_as_float(rr[0])+__uint_as_float(rr[1]);}
  if(hi==0)wsf[32+r32]=l_reg;asm volatile("s_waitcnt lgkmcnt(0)":::"memory");
  float rli[16];
  #pragma unroll
  for(int r=0;r<16;++r)rli[r]=__builtin_amdgcn_rcpf(wsf[32+crow(r,hi)]);
  bf16*Ow=Oj+(long)(q0+wid*QBLK)*opitch;
  { bf16*stg=(bf16*)(shm+LDS_OST)+wid*2048;
    #pragma unroll
    for(int r=0;r<16;++r){const int orow=crow(r,hi);
      #pragma unroll
      for(int d0=0;d0<2;++d0)stg[orow*64+d0*32+r32]=__float2bfloat16(o[d0][r]*rli[r]);}
    asm volatile("s_waitcnt lgkmcnt(0)":::"memory");
    #pragma unroll
    for(int i=0;i<4;++i){const int row=i*8+(lane>>3),ch=lane&7; const u32x4 v=*(const u32x4*)(stg+row*64+ch*8); ATTN_STORE16(Ow+(long)row*opitch+ch*8,v);} }
  asm volatile("s_waitcnt lgkmcnt(0)\n\ts_barrier":::"memory");
  #undef DMA_K
  #undef WAITK
  #undef KALD
  #undef MX3_
  #undef DMA_V
  #undef CMASK
  #undef BIAS
  #undef BIAS_
  #undef START
  #undef RESC
  #undef ROT
}
constexpr int ATTN_LDS_BYTES=LDS_TOTAL;

constexpr int D1_SLK=9216, D1_SLV=16384, D1_V=NSLOT*D1_SLK, D1_WS=D1_V+NSLOT*D1_SLV, D1_END=D1_WS+NW*64*4;
static_assert(D1_END<=LDS_LUT && NW*8192<=D1_WS, "d128 attention LDS map");
template<int THRL> __device__ __forceinline__ void attn_unit_d128(int qb,const bf16*Qj,const bf16*__restrict__ Kj,const bf16*__restrict__ Vj,bf16*Oj,int opitch,int dhead,char*shm){
  int tid_=threadIdx.x; asm volatile("":"+v"(tid_));
  const int tid=tid_,lane=tid&63,r32=lane&31,hi=lane>>5; const int wid=__builtin_amdgcn_readfirstlane(tid>>6);
  const int q0=qb*QB;
  const bf16*Qw=Qj+(long)(q0+wid*QBLK)*PITCH;
  const unsigned lds0=(unsigned)(uintptr_t)shm;
  float*wsf=(float*)(shm+D1_WS)+wid*64;
  const bf16*ksrc=Kj+(long)lane*PITCH+wid*8;
  const bf16*vsrc=Vj+(long)(16*(wid&3)+(lane>>2))*PITCH+(wid>>2)*32+(lane&3)*8;
  const unsigned kdst=lds0+wid*1024, vdst=lds0+D1_V+wid*1024;
  #define DMA_K(t,si) glds16(ksrc+(long)(t)*KVBLK*PITCH,(unsigned)__builtin_amdgcn_readfirstlane(kdst+(si)*D1_SLK))
  #define DMA_V(t,si) do{ glds16(vsrc+(long)(t)*KVBLK*PITCH,(unsigned)__builtin_amdgcn_readfirstlane(vdst+(si)*D1_SLV)); \
    glds16(vsrc+(long)(t)*KVBLK*PITCH+64,(unsigned)__builtin_amdgcn_readfirstlane(vdst+(si)*D1_SLV+8192)); }while(0)
  const char*Kbase=shm; bf16x8 kf[8];
  const lds_cptr shm3=(lds_cptr)shm; const lds_cptr kp0=shm3+hi*1024+r32*16; const lds_cptr vp0=shm3+D1_V+((lane>>4)&1)*32+(lane&3)*8+(4*hi+((lane&15)>>2))*64;
  const int NT=(q0+QB)/KVBLK;
  const int qrel=wid*QBLK+r32;
  const __attribute__((address_space(3))) float* lutr=(const __attribute__((address_space(3))) float*)(shm3+LDS_LUT)+dhead*LUTN;
  DMA_K(0,0);DMA_V(0,0);DMA_K(1,1);
  bf16x8 qr[4];
  #pragma unroll
  for(int d0=0;d0<4;++d0)qr[d0]=*reinterpret_cast<const bf16x8*>(&Qw[(long)r32*PITCH+d0*16+hi*8]);
  float mhat=0.f,l_reg=0.f;f32x16 o[4];o[0]=f32x16{};o[1]=f32x16{};o[2]=f32x16{};o[3]=f32x16{};f32x16 negm;
  _Pragma("unroll") for(int r=0;r<16;++r)negm[r]=0.f; asm volatile("":"+v"(negm));
  #define BIAS_(P0,P1,t,NEAR_) do{ if(NEAR_ && (t)>=NT-6){ const __attribute__((address_space(3))) float* lp_=lutr+(383-(q0-64*(t)+qrel-4*hi)); \
      _Pragma("unroll") for(int r_=0;r_<16;++r_){ P0[r_]+=lp_[(r_&3)+8*(r_>>2)]; P1[r_]+=lp_[32+(r_&3)+8*(r_>>2)]; if((r_&3)==3)SBAR(); } } }while(0)
  #define BIAS(P0,P1,t) BIAS_(P0,P1,t,true)
  #define CMASK(P0,P1,t) do{int jb_=(t)-(NT-4); if(jb_>=0)cmask(P0,P1,jb_,qrel,hi);}while(0)
  bool resc=false;
  #define START(P0,P1) do{ const float rm=rowmax(P0,P1); resc=false; \
    { const float dl=rm; mhat=fadd_s(mhat,dl); \
      _Pragma("unroll") for(int r=0;r<16;++r){P0[r]=fsub_s(P0[r],dl);P1[r]=fsub_s(P1[r],dl);} \
      _Pragma("unroll") for(int r=0;r<16;++r)negm[r]=-mhat; asm volatile("":"+v"(negm)); } \
    _Pragma("unroll") for(int r=0;r<16;++r)P0[r]=__builtin_amdgcn_exp2f(P0[r]); }while(0)
  #define RESC() do{ if(resc){ asm volatile("s_waitcnt lgkmcnt(0)":::"memory"); \
      _Pragma("unroll") for(int d_=0;d_<4;++d_) _Pragma("unroll") for(int r=0;r<16;++r)o[d_][r]*=wsf[crow(r,hi)]; } }while(0)
  f32x16 pA0,pA1,pB0,pB1;
  int i_prev=0,i_cur=0,i_next=1;
  #define ROT() do{i_prev=i_cur;i_cur=i_next;i_next=(i_next==NSLOT-1)?0:i_next+1;}while(0)
  DMA_K(2,2);
  WAIT_BAR(4);
  qkt(pA0,pA1,Kbase,qr,negm,negm,r32,hi);asm volatile("s_nop 15\n\ts_nop 7":"+v"(pA0),"+v"(pA1));BIAS(pA0,pA1,0);CMASK(pA0,pA1,0);
  START(pA0,pA1);
  _Pragma("unroll") for(int r=0;r<16;++r)pA1[r]=__builtin_amdgcn_exp2f(pA1[r]);
  WAIT_BAR(0);
  DMA_K(3,0);DMA_V(1,1);
  ROT();
  kload8(kf,kp0+i_cur*D1_SLK);
  WAIT_BAR(3);
  s16x4 vl[16],vh[16]; u32x4 pw0,pw1,pw2,pw3;
  #define PKW(P,B) cvtpk_s(P[B],P[B+1])
  #define PAF(k) __builtin_bit_cast(bf16x8,pw##k)
  #define VFR(f) (bf16x8){vl[f][0],vl[f][1],vl[f][2],vl[f][3],vh[f][0],vh[f][1],vh[f][2],vh[f][3]}
  #define PIN(x) asm volatile("":"+v"(x))
  #define MX3(a,b,c) __builtin_fmaxf(__builtin_fmaxf((a),(b)),(c))
  #define GAPA(MF,A0,A1,A2,A3,W0,W1,PW) do{ MF; sacc+=A0; sacc+=A1; sacc+=A2; sacc+=A3; PIN(sacc); W0; W1; PIN(PW); SBAR(); }while(0)
  #define EX(v) __builtin_amdgcn_exp2f(v)
  #define VRD(f) do{ vl[f]=vtr(vp_+(f)*1024); vh[f]=vtr(vp_+(f)*1024+512); }while(0)
  #define KRD(G,j) do{ if(G){ kload2(kf,kp0+i_next*D1_SLK,j); } }while(0)
  #define GAPB(n,X,B,GL) do{ o[(n)&3]=__builtin_amdgcn_mfma_f32_32x32x16_bf16(PAFN(n),VFR(4*((n)&3)+((n)>>2)),o[(n)&3],0,0,0); \
    X[B]=EX(X[B]); X[B+1]=EX(X[B+1]); PIN(X); if((n)+3<16){ VRD(4*(((n)+3)&3)+(((n)+3)>>2)); } \
    if((n)==2)KRD(GL,0); if((n)==4)KRD(GL,1); if((n)==6)KRD(GL,2); if((n)==8)KRD(GL,3); SBAR(); }while(0)
  #define PAFN(n) (((n)>>2)==0?PAF(0):((n)>>2)==1?PAF(1):((n)>>2)==2?PAF(2):PAF(3))
  #define STEP(C0,C1,P0,P1,t,GK,GV,GL) do{ SBAR(); \
    const lds_cptr vp_=vp0+i_prev*D1_SLV; \
    VRD(0); SBAR(); float sacc=(P0[0]+P0[1]); \
    GAPA(C0=__builtin_amdgcn_mfma_f32_32x32x16_bf16(kf[0],qr[0],negm,0,0,0), P0[2],P0[3],P0[4],P0[5],     pw0[0]=PKW(P0,0), pw0[1]=PKW(P0,2), pw0); \
    VRD(4); SBAR(); GAPA(C1=__builtin_amdgcn_mfma_f32_32x32x16_bf16(kf[1],qr[0],negm,0,0,0), P0[6],P0[7],P0[8],P0[9],     pw0[2]=PKW(P0,4), pw0[3]=PKW(P0,6), pw0); \
    VRD(8); SBAR(); GAPA(C0=__builtin_amdgcn_mfma_f32_32x32x16_bf16(kf[2],qr[1],C0,0,0,0),   P0[10],P0[11],P0[12],P0[13], pw1[0]=PKW(P0,8), pw1[1]=PKW(P0,10), pw1); \
    GAPA(C1=__builtin_amdgcn_mfma_f32_32x32x16_bf16(kf[3],qr[1],C1,0,0,0),   P0[14],P0[15],P1[0],P1[1],   pw1[2]=PKW(P0,12),pw1[3]=PKW(P0,14), pw1); \
    GAPA(C0=__builtin_amdgcn_mfma_f32_32x32x16_bf16(kf[4],qr[2],C0,0,0,0),   P1[2],P1[3],P1[4],P1[5],     pw2[0]=PKW(P1,0), pw2[1]=PKW(P1,2), pw2); \
    GAPA(C1=__builtin_amdgcn_mfma_f32_32x32x16_bf16(kf[5],qr[2],C1,0,0,0),   P1[6],P1[7],P1[8],P1[9],     pw2[2]=PKW(P1,4), pw2[3]=PKW(P1,6), pw2); \
    GAPA(C0=__builtin_amdgcn_mfma_f32_32x32x16_bf16(kf[6],qr[3],C0,0,0,0),   P1[10],P1[11],P1[12],P1[13], pw3[0]=PKW(P1,8), pw3[1]=PKW(P1,10), pw3); \
    GAPA(C1=__builtin_amdgcn_mfma_f32_32x32x16_bf16(kf[7],qr[3],C1,0,0,0),   P1[14],P1[15],0.f,0.f,       pw3[2]=PKW(P1,12),pw3[3]=PKW(P1,14), pw3); \
    l_reg+=sacc; \
    if(GK){DMA_K((t)+3,i_cur);} if(GV){DMA_V((t)+1,i_next);} \
    BIAS(C0,C1,t); CMASK(C0,C1,t); \
    { float a=MX3(C0[0],C0[1],C1[0]),b=MX3(C0[2],C0[3],C1[1]); a=MX3(a,C1[2],C1[3]); \
      _Pragma("unroll") for(int r=4;r<16;r+=4){a=MX3(a,C0[r],C0[r+1]);b=MX3(b,C0[r+2],C0[r+3]);a=MX3(a,C1[r],C1[r+1]);b=MX3(b,C1[r+2],C1[r+3]);} \
      float rm=__builtin_fmaxf(a,b); { auto rr=__builtin_amdgcn_permlane32_swap(__float_as_uint(rm),__float_as_uint(rm),false,false); rm=__builtin_fmaxf(__uint_as_float(rr[0]),__uint_as_float(rr[1])); } \
      resc=false; \
      if(__builtin_expect(__any(rm>(float)THRL),0)){ const float dl=__builtin_fmaxf(rm,0.f); mhat+=dl; \
        _Pragma("unroll") for(int r=0;r<16;++r){C0[r]-=dl;C1[r]-=dl;} \
        _Pragma("unroll") for(int r=0;r<16;++r)negm[r]=-mhat; asm volatile("":"+v"(negm)); \
        const float f=__builtin_amdgcn_exp2f(-dl); l_reg*=f; if(hi==0)wsf[r32]=f; resc=true; } } \
    SBAR(); \
    GAPB(0,C0,0,GL); GAPB(1,C0,2,GL); GAPB(2,C0,4,GL); GAPB(3,C0,6,GL); GAPB(4,C0,8,GL); GAPB(5,C0,10,GL); GAPB(6,C0,12,GL); GAPB(7,C0,14,GL); \
    GAPB(8,C1,0,GL); GAPB(9,C1,2,GL); GAPB(10,C1,4,GL); GAPB(11,C1,6,GL); GAPB(12,C1,8,GL); GAPB(13,C1,10,GL); GAPB(14,C1,12,GL); GAPB(15,C1,14,GL); \
    }while(0)
  int t=1;
  #undef CMASK
  #define CMASK(P0,P1,t) do{}while(0)
  #undef BIAS
  #define BIAS(P0,P1,t) BIAS_(P0,P1,t,false)
  for(;t+7<NT;t+=2){
    STEP(pB0,pB1,pA0,pA1,t,true,true,true);     WAIT_BAR(3); RESC(); ROT();
    STEP(pA0,pA1,pB0,pB1,t+1,true,true,true);   WAIT_BAR(3); RESC(); ROT();
  }
  #undef CMASK
  #define CMASK(P0,P1,t) do{int jb_=(t)-(NT-4); if(jb_>=0)cmask(P0,P1,jb_,qrel,hi);}while(0)
  #undef BIAS
  #define BIAS(P0,P1,t) BIAS_(P0,P1,t,true)
  #define ENDW(tt) do{ if((tt)+3<NT){WAIT_BAR(3);} else if((tt)+2<NT){WAIT_BAR(2);} else {WAIT_BAR(0);} }while(0)
  for(;t+1<NT;t+=2){
    STEP(pB0,pB1,pA0,pA1,t,(t+3<NT),(t+1<NT),(t+1<NT));       ENDW(t);   RESC(); ROT();
    STEP(pA0,pA1,pB0,pB1,t+1,(t+4<NT),(t+2<NT),(t+2<NT));     ENDW(t+1); RESC(); ROT();
  }
  STEP(pB0,pB1,pA0,pA1,NT-1,false,false,false); RESC();
  { float sacc=pB0[0]+pB0[1]; _Pragma("unroll") for(int r=2;r<16;++r)sacc+=pB0[r]; _Pragma("unroll") for(int r=0;r<16;++r)sacc+=pB1[r]; l_reg+=sacc;
    pw0=(u32x4){PKW(pB0,0),PKW(pB0,2),PKW(pB0,4),PKW(pB0,6)};pw1=(u32x4){PKW(pB0,8),PKW(pB0,10),PKW(pB0,12),PKW(pB0,14)};pw2=(u32x4){PKW(pB1,0),PKW(pB1,2),PKW(pB1,4),PKW(pB1,6)};pw3=(u32x4){PKW(pB1,8),PKW(pB1,10),PKW(pB1,12),PKW(pB1,14)};
    SBAR(); const lds_cptr vp_=vp0+i_cur*D1_SLV;
    #pragma unroll
    for(int dq=0;dq<4;++dq){ s16x4 lo[4],hh[4];
      #pragma unroll
      for(int ks=0;ks<4;++ks){ lo[ks]=vtr(vp_+(4*dq+ks)*1024); hh[ks]=vtr(vp_+(4*dq+ks)*1024+512); }
      #define PK_(k) (bf16x8){lo[k][0],lo[k][1],lo[k][2],lo[k][3],hh[k][0],hh[k][1],hh[k][2],hh[k][3]}
      o[dq]=__builtin_amdgcn_mfma_f32_32x32x16_bf16(PAF(0),PK_(0),o[dq],0,0,0); o[dq]=__builtin_amdgcn_mfma_f32_32x32x16_bf16(PAF(1),PK_(1),o[dq],0,0,0);
      o[dq]=__builtin_amdgcn_mfma_f32_32x32x16_bf16(PAF(2),PK_(2),o[dq],0,0,0); o[dq]=__builtin_amdgcn_mfma_f32_32x32x16_bf16(PAF(3),PK_(3),o[dq],0,0,0);
      #undef PK_
    } }
  #undef PKW
  #undef PAF
  #undef PAFN
  #undef VFR
  #undef PIN
  #undef MX3
  #undef GAPA
  #undef GAPB
  #undef EX
  #undef VRD
  #undef KRD
  #undef STEP
  #undef ENDW
  {auto rr=__builtin_amdgcn_permlane32_swap(__float_as_uint(l_reg),__float_as_uint(l_reg),false,false);l_reg=__uint_as_float(rr[0])+__uint_as_float(rr[1]);}
  if(hi==0)wsf[32+r32]=l_reg;
  asm volatile("s_waitcnt lgkmcnt(0)\n\ts_barrier":::"memory");
  float rli[16];
  #pragma unroll
  for(int r=0;r<16;++r)rli[r]=__builtin_amdgcn_rcpf(wsf[32+crow(r,hi)]);
  bf16*Ow=Oj+(long)(q0+wid*QBLK)*opitch;
  { bf16*stg=(bf16*)(shm)+wid*4096;
    #pragma unroll
    for(int r=0;r<16;++r){const int orow=crow(r,hi);
      #pragma unroll
      for(int dq=0;dq<4;++dq)stg[orow*128+dq*32+r32]=__float2bfloat16(o[dq][r]*rli[r]);}
    asm volatile("s_waitcnt lgkmcnt(0)":::"memory");
    #pragma unroll
    for(int i=0;i<8;++i){const int row=i*4+(lane>>4),ch=lane&15; const u32x4 v=*(const u32x4*)(stg+row*128+ch*8); ATTN_STORE16(Ow+(long)row*opitch+ch*8,v);} }
  asm volatile("s_waitcnt lgkmcnt(0)\n\ts_barrier":::"memory");
  #undef DMA_K
  #undef DMA_V
  #undef CMASK
  #undef BIAS
  #undef BIAS_
  #undef START
  #undef RESC
  #undef ROT
}

constexpr int D2_K1=NSLOT*D1_SLK, D2_V=2*NSLOT*D1_SLK, D2_WS=D2_V+NSLOT*D1_SLV, D2_END=D2_WS+NW*64*4;
static_assert(D2_END<=LDS_LUT && NW*8192<=D2_WS, "dual-softmax attention LDS map");
template<int THRL> __device__ __forceinline__ void attn_unit_dd(int qb,const bf16*Qj,const bf16*__restrict__ Kj,const bf16*__restrict__ Vj,bf16*YDh,int dhead,char*shm,const float*lamp,const float*gn){
  int tid_=threadIdx.x; asm volatile("":"+v"(tid_));
  const int tid=tid_,lane=tid&63,r32=lane&31,hi=lane>>5; const int wid=__builtin_amdgcn_readfirstlane(tid>>6);
  const int q0=qb*128, wsel=wid>>2, wq=wid&3;
  const bf16*Qw=Qj+wsel*64+(long)(q0+wq*QBLK)*PITCH;
  const unsigned lds0=(unsigned)(uintptr_t)shm;
  float*wsf=(float*)(shm+D2_WS)+wid*64;
  const bf16*ksrc=Kj+(long)lane*PITCH+wid*8;
  const bf16*vsrc=Vj+(long)(16*(wid&3)+(lane>>2))*PITCH+(wid>>2)*32+(lane&3)*8;
  const unsigned kdst=lds0+wid*1024, vdst=lds0+D2_V+wid*1024;
  #define DMA_K(t,si) do{ glds16(ksrc+(long)(t)*KVBLK*PITCH,(unsigned)__builtin_amdgcn_readfirstlane(kdst+(si)*D1_SLK)); \
    glds16(ksrc+(long)(t)*KVBLK*PITCH+64,(unsigned)__builtin_amdgcn_readfirstlane(kdst+D2_K1+(si)*D1_SLK)); }while(0)
  #define DMA_V(t,si) do{ glds16(vsrc+(long)(t)*KVBLK*PITCH,(unsigned)__builtin_amdgcn_readfirstlane(vdst+(si)*D1_SLV)); \
    glds16(vsrc+(long)(t)*KVBLK*PITCH+64,(unsigned)__builtin_amdgcn_readfirstlane(vdst+(si)*D1_SLV+8192)); }while(0)
  const char*Kbase=shm+wsel*D2_K1; bf16x8 kf[8];
  const lds_cptr shm3=(lds_cptr)shm; const lds_cptr kp0=shm3+wsel*D2_K1+hi*1024+r32*16; const lds_cptr vp0=shm3+D2_V+((lane>>4)&1)*32+(lane&3)*8+(4*hi+((lane&15)>>2))*64;
  const int NT=(q0+128)/KVBLK;
  const int qrel=wq*QBLK+r32;
  const __attribute__((address_space(3))) float* lutr=(const __attribute__((address_space(3))) float*)(shm3+LDS_LUT)+dhead*LUTN;
  DMA_K(0,0);DMA_V(0,0);DMA_K(1,1);
  bf16x8 qr[4];
  #pragma unroll
  for(int d0=0;d0<4;++d0)qr[d0]=*reinterpret_cast<const bf16x8*>(&Qw[(long)r32*PITCH+d0*16+hi*8]);
  float mhat=0.f,l_reg=0.f;f32x16 o[4];o[0]=f32x16{};o[1]=f32x16{};o[2]=f32x16{};o[3]=f32x16{};f32x16 negm;
  _Pragma("unroll") for(int r=0;r<16;++r)negm[r]=0.f; asm volatile("":"+v"(negm));
  #define BIAS_(P0,P1,t,NEAR_) do{ if(NEAR_ && (t)>=NT-4){ const __attribute__((address_space(3))) float* lp_=lutr+(383-(q0-64*(t)+qrel-4*hi)); \
      _Pragma("unroll") for(int r_=0;r_<16;++r_){ P0[r_]+=lp_[(r_&3)+8*(r_>>2)]; P1[r_]+=lp_[32+(r_&3)+8*(r_>>2)]; if((r_&3)==3)SBAR(); } } }while(0)
  #define BIAS(P0,P1,t) BIAS_(P0,P1,t,true)
  #define CMASK(P0,P1,t) do{int jb_=(t)-(NT-2); if(jb_>=0)cmask(P0,P1,jb_,qrel,hi);}while(0)
  bool resc=false;
  #define START(P0,P1) do{ const float rm=rowmax(P0,P1); resc=false; \
    { const float dl=rm; mhat=fadd_s(mhat,dl); \
      _Pragma("unroll") for(int r=0;r<16;++r){P0[r]=fsub_s(P0[r],dl);P1[r]=fsub_s(P1[r],dl);} \
      _Pragma("unroll") for(int r=0;r<16;++r)negm[r]=-mhat; asm volatile("":"+v"(negm)); } \
    _Pragma("unroll") for(int r=0;r<16;++r)P0[r]=__builtin_amdgcn_exp2f(P0[r]); }while(0)
  #define RESC() do{ if(resc){ asm volatile("s_waitcnt lgkmcnt(0)":::"memory"); \
      _Pragma("unroll") for(int d_=0;d_<4;++d_) _Pragma("unroll") for(int r=0;r<16;++r)o[d_][r]*=wsf[crow(r,hi)]; } }while(0)
  f32x16 pA0,pA1,pB0,pB1;
  int i_prev=0,i_cur=0,i_next=1;
  #define ROT() do{i_prev=i_cur;i_cur=i_next;i_next=(i_next==NSLOT-1)?0:i_next+1;}while(0)
  DMA_K(2,2);
  WAIT_BAR(6);
  qkt(pA0,pA1,Kbase,qr,negm,negm,r32,hi);asm volatile("s_nop 15\n\ts_nop 7":"+v"(pA0),"+v"(pA1));BIAS(pA0,pA1,0);CMASK(pA0,pA1,0);
  START(pA0,pA1);
  _Pragma("unroll") for(int r=0;r<16;++r)pA1[r]=__builtin_amdgcn_exp2f(pA1[r]);
  WAIT_BAR(0);
  DMA_K(3,0);DMA_V(1,1);
  ROT();
  kload8(kf,kp0+i_cur*D1_SLK);
  WAIT_BAR(4);
  s16x4 vl[16],vh[16]; u32x4 pw0,pw1,pw2,pw3;
  #define PKW(P,B) cvtpk_s(P[B],P[B+1])
  #define PAF(k) __builtin_bit_cast(bf16x8,pw##k)
  #define VFR(f) (bf16x8){vl[f][0],vl[f][1],vl[f][2],vl[f][3],vh[f][0],vh[f][1],vh[f][2],vh[f][3]}
  #define PIN(x) asm volatile("":"+v"(x))
  #define MX3(a,b,c) __builtin_fmaxf(__builtin_fmaxf((a),(b)),(c))
  #define GAPA(MF,A0,A1,A2,A3,W0,W1,PW) do{ MF; sacc+=A0; sacc+=A1; sacc+=A2; sacc+=A3; PIN(sacc); W0; W1; PIN(PW); SBAR(); }while(0)
  #define EX(v) __builtin_amdgcn_exp2f(v)
  #define VRD(f) do{ vl[f]=vtr(vp_+(f)*1024); vh[f]=vtr(vp_+(f)*1024+512); }while(0)
  #define KRD(G,j) do{ if(G){ kload2(kf,kp0+i_next*D1_SLK,j); } }while(0)
  #define GAPB(n,X,B,GL) do{ o[(n)&3]=__builtin_amdgcn_mfma_f32_32x32x16_bf16(PAFN(n),VFR(4*((n)&3)+((n)>>2)),o[(n)&3],0,0,0); \
    X[B]=EX(X[B]); X[B+1]=EX(X[B+1]); PIN(X); if((n)+3<16){ VRD(4*(((n)+3)&3)+(((n)+3)>>2)); } \
    if((n)==2)KRD(GL,0); if((n)==4)KRD(GL,1); if((n)==6)KRD(GL,2); if((n)==8)KRD(GL,3); SBAR(); }while(0)
  #define PAFN(n) (((n)>>2)==0?PAF(0):((n)>>2)==1?PAF(1):((n)>>2)==2?PAF(2):PAF(3))
  #define STEP(C0,C1,P0,P1,t,GK,GV,GL) do{ SBAR(); \
    const lds_cptr vp_=vp0+i_prev*D1_SLV; \
    VRD(0); SBAR(); float sacc=(P0[0]+P0[1]); \
    GAPA(C0=__builtin_amdgcn_mfma_f32_32x32x16_bf16(kf[0],qr[0],negm,0,0,0), P0[2],P0[3],P0[4],P0[5],     pw0[0]=PKW(P0,0), pw0[1]=PKW(P0,2), pw0); \
    VRD(4); SBAR(); GAPA(C1=__builtin_amdgcn_mfma_f32_32x32x16_bf16(kf[1],qr[0],negm,0,0,0), P0[6],P0[7],P0[8],P0[9],     pw0[2]=PKW(P0,4), pw0[3]=PKW(P0,6), pw0); \
    VRD(8); SBAR(); GAPA(C0=__builtin_amdgcn_mfma_f32_32x32x16_bf16(kf[2],qr[1],C0,0,0,0),   P0[10],P0[11],P0[12],P0[13], pw1[0]=PKW(P0,8), pw1[1]=PKW(P0,10), pw1); \
    GAPA(C1=__builtin_amdgcn_mfma_f32_32x32x16_bf16(kf[3],qr[1],C1,0,0,0),   P0[14],P0[15],P1[0],P1[1],   pw1[2]=PKW(P0,12),pw1[3]=PKW(P0,14), pw1); \
    GAPA(C0=__builtin_amdgcn_mfma_f32_32x32x16_bf16(kf[4],qr[2],C0,0,0,0),   P1[2],P1[3],P1[4],P1[5],     pw2[0]=PKW(P1,0), pw2[1]=PKW(P1,2), pw2); \
    GAPA(C1=__builtin_amdgcn_mfma_f32_32x32x16_bf16(kf[5],qr[2],C1,0,0,0),   P1[6],P1[7],P1[8],P1[9],     pw2[2]=PKW(P1,4), pw2[3]=PKW(P1,6), pw2); \
    GAPA(C0=__builtin_amdgcn_mfma_f32_32x32x16_bf16(kf[6],qr[3],C0,0,0,0),   P1[10],P1[11],P1[12],P1[13], pw3[0]=PKW(P1,8), pw3[1]=PKW(P1,10), pw3); \
    GAPA(C1=__builtin_amdgcn_mfma_f32_32x32x16_bf16(kf[7],qr[3],C1,0,0,0),   P1[14],P1[15],0.f,0.f,       pw3[2]=PKW(P1,12),pw3[3]=PKW(P1,14), pw3); \
    l_reg+=sacc; \
    if(GK){DMA_K((t)+3,i_cur);} if(GV){DMA_V((t)+1,i_next);} \
    BIAS(C0,C1,t); CMASK(C0,C1,t); \
    { float a=MX3(C0[0],C0[1],C1[0]),b=MX3(C0[2],C0[3],C1[1]); a=MX3(a,C1[2],C1[3]); \
      _Pragma("unroll") for(int r=4;r<16;r+=4){a=MX3(a,C0[r],C0[r+1]);b=MX3(b,C0[r+2],C0[r+3]);a=MX3(a,C1[r],C1[r+1]);b=MX3(b,C1[r+2],C1[r+3]);} \
      float rm=__builtin_fmaxf(a,b); { auto rr=__builtin_amdgcn_permlane32_swap(__float_as_uint(rm),__float_as_uint(rm),false,false); rm=__builtin_fmaxf(__uint_as_float(rr[0]),__uint_as_float(rr[1])); } \
      resc=false; \
      if(__builtin_expect(__any(rm>(float)THRL),0)){ const float dl=__builtin_fmaxf(rm,0.f); mhat+=dl; \
        _Pragma("unroll") for(int r=0;r<16;++r){C0[r]-=dl;C1[r]-=dl;} \
        _Pragma("unroll") for(int r=0;r<16;++r)negm[r]=-mhat; asm volatile("":"+v"(negm)); \
        const float f=__builtin_amdgcn_exp2f(-dl); l_reg*=f; if(hi==0)wsf[r32]=f; resc=true; } } \
    SBAR(); \
    GAPB(0,C0,0,GL); GAPB(1,C0,2,GL); GAPB(2,C0,4,GL); GAPB(3,C0,6,GL); GAPB(4,C0,8,GL); GAPB(5,C0,10,GL); GAPB(6,C0,12,GL); GAPB(7,C0,14,GL); \
    GAPB(8,C1,0,GL); GAPB(9,C1,2,GL); GAPB(10,C1,4,GL); GAPB(11,C1,6,GL); GAPB(12,C1,8,GL); GAPB(13,C1,10,GL); GAPB(14,C1,12,GL); GAPB(15,C1,14,GL); \
    }while(0)
  int t=1;
  #undef CMASK
  #define CMASK(P0,P1,t) do{}while(0)
  #undef BIAS
  #define BIAS(P0,P1,t) BIAS_(P0,P1,t,false)
  for(;t+5<NT;t+=2){
    STEP(pB0,pB1,pA0,pA1,t,true,true,true);     WAIT_BAR(4); RESC(); ROT();
    STEP(pA0,pA1,pB0,pB1,t+1,true,true,true);   WAIT_BAR(4); RESC(); ROT();
  }
  #undef CMASK
  #define CMASK(P0,P1,t) do{int jb_=(t)-(NT-2); if(jb_>=0)cmask(P0,P1,jb_,qrel,hi);}while(0)
  #undef BIAS
  #define BIAS(P0,P1,t) BIAS_(P0,P1,t,true)
  #define ENDW(tt) do{ if((tt)+3<NT){WAIT_BAR(4);} else if((tt)+2<NT){WAIT_BAR(2);} else {WAIT_BAR(0);} }while(0)
  for(;t+1<NT;t+=2){
    STEP(pB0,pB1,pA0,pA1,t,(t+3<NT),(t+1<NT),(t+1<NT));       ENDW(t);   RESC(); ROT();
    STEP(pA0,pA1,pB0,pB1,t+1,(t+4<NT),(t+2<NT),(t+2<NT));     ENDW(t+1); RESC(); ROT();
  }
  STEP(pB0,pB1,pA0,pA1,NT-1,false,false,false); RESC();
  { float sacc=pB0[0]+pB0[1]; _Pragma("unroll") for(int r=2;r<16;++r)sacc+=pB0[r]; _Pragma("unroll") for(int r=0;r<16;++r)sacc+=pB1[r]; l_reg+=sacc;
    pw0=(u32x4){PKW(pB0,0),PKW(pB0,2),PKW(pB0,4),PKW(pB0,6)};pw1=(u32x4){PKW(pB0,8),PKW(pB0,10),PKW(pB0,12),PKW(pB0,14)};pw2=(u32x4){PKW(pB1,0),PKW(pB1,2),PKW(pB1,4),PKW(pB1,6)};pw3=(u32x4){PKW(pB1,8),PKW(pB1,10),PKW(pB1,12),PKW(pB1,14)};
    SBAR(); const lds_cptr vp_=vp0+i_cur*D1_SLV;
    #pragma unroll
    for(int dq=0;dq<4;++dq){ s16x4 lo[4],hh[4];
      #pragma unroll
      for(int ks=0;ks<4;++ks){ lo[ks]=vtr(vp_+(4*dq+ks)*1024); hh[ks]=vtr(vp_+(4*dq+ks)*1024+512); }
      #define PK_(k) (bf16x8){lo[k][0],lo[k][1],lo[k][2],lo[k][3],hh[k][0],hh[k][1],hh[k][2],hh[k][3]}
      o[dq]=__builtin_amdgcn_mfma_f32_32x32x16_bf16(PAF(0),PK_(0),o[dq],0,0,0); o[dq]=__builtin_amdgcn_mfma_f32_32x32x16_bf16(PAF(1),PK_(1),o[dq],0,0,0);
      o[dq]=__builtin_amdgcn_mfma_f32_32x32x16_bf16(PAF(2),PK_(2),o[dq],0,0,0); o[dq]=__builtin_amdgcn_mfma_f32_32x32x16_bf16(PAF(3),PK_(3),o[dq],0,0,0);
      #undef PK_
    } }
  #undef PKW
  #undef PAF
  #undef PAFN
  #undef VFR
  #undef PIN
  #undef MX3
  #undef GAPA
  #undef GAPB
  #undef EX
  #undef VRD
  #undef KRD
  #undef STEP
  #undef ENDW
  {auto rr=__builtin_amdgcn_permlane32_swap(__float_as_uint(l_reg),__float_as_uint(l_reg),false,false);l_reg=__uint_as_float(rr[0])+__uint_as_float(rr[1]);}
  if(hi==0)wsf[32+r32]=l_reg;
  asm volatile("s_waitcnt lgkmcnt(0)\n\ts_barrier":::"memory");
  float rli[16];
  #pragma unroll
  for(int r=0;r<16;++r)rli[r]=__builtin_amdgcn_rcpf(wsf[32+crow(r,hi)]);
  { bf16*stg=(bf16*)(shm)+wid*4096;
    #pragma unroll
    for(int r=0;r<16;++r){const int orow=crow(r,hi);
      #pragma unroll
      for(int dq=0;dq<4;++dq)stg[orow*128+dq*32+r32]=__float2bfloat16(o[dq][r]*rli[r]);} }
  asm volatile("s_waitcnt lgkmcnt(0)\n\ts_barrier":::"memory");
  {
    const float lam=*lamp; const int e0=(lane&15)*8; float gv[8];
    #pragma unroll
    for(int e=0;e<8;++e)gv[e]=gn[e0+e]*(1.0f-LAMBDA_INIT);
    const bf16*st0=(const bf16*)(shm);
    #pragma unroll
    for(int i=0;i<4;++i){const int row=16*wid+i*4+(lane>>4),ch=lane&15;
      const u32x4 a=*(const u32x4*)(st0+(row>>5)*4096+(row&31)*128+ch*8), bq=*(const u32x4*)(st0+(4+(row>>5))*4096+(row&31)*128+ch*8);
      float y[8]; y[0]=epi::bflo(a.x)-lam*epi::bflo(bq.x); y[1]=epi::bfhi(a.x)-lam*epi::bfhi(bq.x); y[2]=epi::bflo(a.y)-lam*epi::bflo(bq.y); y[3]=epi::bfhi(a.y)-lam*epi::bfhi(bq.y);
      y[4]=epi::bflo(a.z)-lam*epi::bflo(bq.z); y[5]=epi::bfhi(a.z)-lam*epi::bfhi(bq.z); y[6]=epi::bflo(a.w)-lam*epi::bflo(bq.w); y[7]=epi::bfhi(a.w)-lam*epi::bfhi(bq.w);
      float ss=0.f;
      #pragma unroll
      for(int e=0;e<8;++e)ss+=y[e]*y[e];
      ss+=__shfl_xor(ss,1); ss+=__shfl_xor(ss,2); ss+=__shfl_xor(ss,4); ss+=__shfl_xor(ss,8);
      const float rstd=1.0f/sqrtf(ss*(1.0f/128.0f)+1e-5f);
      u32x4 w; w.x=::pk2(y[0]*rstd*gv[0],y[1]*rstd*gv[1]); w.y=::pk2(y[2]*rstd*gv[2],y[3]*rstd*gv[3]); w.z=::pk2(y[4]*rstd*gv[4],y[5]*rstd*gv[5]); w.w=::pk2(y[6]*rstd*gv[6],y[7]*rstd*gv[7]);
      *(u32x4*)(YDh+(long)(q0+row)*512+ch*8)=w; } }
  asm volatile("s_waitcnt lgkmcnt(0)\n\ts_barrier":::"memory");
  #undef DMA_K
  #undef DMA_V
  #undef CMASK
  #undef BIAS
  #undef BIAS_
  #undef START
  #undef RESC
  #undef ROT
}

struct AttnBufs { const bf16* PROJ; bf16* YFOX; bf16* YD; const float* F2; const bf16* KA; const unsigned* NRM; const float* LAM; const float* DNG; };
template<int THRL> __device__ __forceinline__ void attn_run_fox(const AttnBufs& A,int g,int qb,char*lds){
  const int b=g>>3,h=g&7; const bf16*P=A.PROJ+(long)b*SEQ*PITCH;
  const unsigned*nq=A.NRM+((0*2+b)*8+h)*2,*nk=A.NRM+((1*2+b)*8+h)*2;
  const float twoB=2.04f*sqrtf((__uint_as_float(nq[0])+__uint_as_float(nq[1]))*(__uint_as_float(nk[0])+__uint_as_float(nk[1])));
  attn_unit<0,THRL>(qb,P+PC_FQ+64*h,P+PC_FK+64*h,P+PC_FV+64*h,A.YFOX+(long)b*SEQ*512+64*h,512,A.F2+((long)b*8+h)*SEQ,A.KA+((long)b*8+h)*SEQ*8,twoB,0,lds);
}
template<int THRL> __device__ __forceinline__ void attn_run_diff(const AttnBufs& A,int g,int qb,char*lds){
  const int b=g>>2,h=g&3; const bf16*P=A.PROJ+(long)b*SEQ*PITCH;
  attn_unit_dd<THRL>(qb,P+PC_DQ+h*128,P+PC_DK+h*128,P+PC_DV+h*128,A.YD+(long)b*SEQ*512+h*128,h,lds,A.LAM,A.DNG);
}
__device__ __forceinline__ void attn_build_lut(char*lds,const float*LUTg){
  __attribute__((address_space(3))) float* R=(__attribute__((address_space(3))) float*)((__attribute__((address_space(3))) char*)lds+LDS_LUT);
  for(int u=threadIdx.x;u<4*LUTN;u+=NW*64){ const int h=u/LUTN,i=u%LUTN,dist=383-i; R[u]=(dist>=0&&dist<128)?(LUTg[h*128+dist]-LUTg[h*128+127]):0.f; }
  __syncthreads();
}
#undef SBAR
#undef WAIT_BAR
}
struct Frame {
    LAS unsigned char* lds;
    volatile LAS unsigned* MISC;
    gu32* ctl;
    int tid, lane, wave, vcu, G;
    const float* in[25]; float* out; unsigned char* ws;
};
#define WSP(T, off) ((T*)(F.ws + (off)))
enum { I_X = 0, I_C, I_WADA, I_BADA, I_LN1G, I_WIN, I_BFG, I_BMERGE, I_LQ1, I_LK1, I_LQ2, I_LK2, I_DNG, I_T5, I_WBF, I_WBD, I_WO, I_LN2G, I_WR, I_BR, I_WUP, I_BUP, I_WDN, I_BDN, I_FING };

__device__ __forceinline__ float wave_sum(float v) {
#pragma unroll
    for (int o = 1; o < 64; o <<= 1) v += __shfl_xor(v, o);
    return v;
}
__device__ __forceinline__ float bflo(unsigned w) { return __uint_as_float(w << 16); }
__device__ __forceinline__ float bfhi(unsigned w) { return __uint_as_float(w & 0xffff0000u); }

__device__ __forceinline__ unsigned cvtpk_rne(float lo, float hi) { unsigned r; asm("v_cvt_pk_bf16_f32 %0, %1, %2" : "=v"(r) : "v"(lo), "v"(hi)); return r; }
template <bool NT = false> __device__ __forceinline__ void tr_load(const float* W, int ldw, int src_col0, int kb, int nb, int lane, f32x4 (&t)[8]) {
    const int k0 = 64 * kb, n0 = 32 * nb, kr = lane >> 3, c4 = lane & 7;
#pragma unroll
    for (int i = 0; i < 8; ++i) { const f32x4* p_ = (const f32x4*)(W + (size_t)(k0 + 16 * (i >> 1) + 2 * kr + (i & 1)) * ldw + src_col0 + n0 + 4 * c4); t[i] = NT ? __builtin_nontemporal_load(p_) : *p_; }
}
__device__ __forceinline__ void tr_flush(const f32x4 (&t)[8], int K, bf16* WT, int dst_row0, LAS float* scr, int kb, int nb, int lane) {
    const int k0 = 64 * kb, n0 = 32 * nb, kr = lane >> 3, c4 = lane & 7; LAS unsigned* s32 = (LAS unsigned*)scr;
#pragma unroll
    for (int j = 0; j < 4; ++j)
#pragma unroll
        for (int e = 0; e < 4; ++e) s32[(4 * c4 + e) * 36 + 8 * j + kr] = cvtpk_rne(t[2 * j][e], t[2 * j + 1][e]);
    LDS_WAIT(); asm volatile("" ::: "memory");
    const int c = lane & 7;
#pragma unroll
    for (int jj = 0; jj < 4; ++jj) { const int n = (lane >> 3) + 8 * jj; const v4u o = *(const LAS v4u*)(s32 + n * 36 + 4 * c);
        *(GAS v4u*)(WT + (size_t)(dst_row0 + n0 + n) * K + k0 + 8 * c) = o; }
    LDS_WAIT(); asm volatile("" ::: "memory");
}
template <bool NT = false> __device__ __forceinline__ void transpose_item(const float* W, int ldw, int src_col0, int K, bf16* WT, int dst_row0, LAS float* scr, int kb, int nb, int lane) {
    f32x4 t[8]; tr_load<NT>(W, ldw, src_col0, kb, nb, lane, t); tr_flush(t, K, WT, dst_row0, scr, kb, nb, lane);
}

__device__ __forceinline__ int t5_bucket(int n) {
    if (n < 16) return n;
    int large = 16 + (int)(logf((float)n / 16.0f) / logf(8.0f) * 16.0f);
    return large < 31 ? large : 31;
}

__device__ __forceinline__ float sat_fp8(float x) { return __builtin_amdgcn_fmed3f(x, -448.0f, 448.0f); }
__device__ __forceinline__ unsigned pack4_fp8(float a, float b, float c, float d) { int w = 0; w = __builtin_amdgcn_cvt_pk_fp8_f32(sat_fp8(a), sat_fp8(b), w, false); w = __builtin_amdgcn_cvt_pk_fp8_f32(sat_fp8(c), sat_fp8(d), w, true); return (unsigned)w; }
constexpr float W8_SCALE = 32.0f;
template <bool NT = false> __device__ __forceinline__ void tr_load_f8(const float* W, int ldw, int kb, int nb, int lane, f32x4 (&t)[8], int src_col0 = 0) {
    const int k0 = 64 * kb, n0 = 32 * nb, kr = lane >> 3, c4 = lane & 7;
#pragma unroll
    for (int i = 0; i < 8; ++i) { const f32x4* p_ = (const f32x4*)(W + (size_t)(k0 + 32 * (i >> 2) + 4 * kr + (i & 3)) * ldw + src_col0 + n0 + 4 * c4); t[i] = NT ? __builtin_nontemporal_load(p_) : *p_; }
}
__device__ __forceinline__ void tr_flush_f8(const f32x4 (&t)[8], int K8, unsigned char* WT8, LAS float* scr, int kb, int nb, int lane) {
    const int k0 = 64 * kb, n0 = 32 * nb, kr = lane >> 3, c4 = lane & 7; LAS unsigned* s32 = (LAS unsigned*)scr;
#pragma unroll
    for (int g = 0; g < 2; ++g)
#pragma unroll
        for (int e = 0; e < 4; ++e) s32[(4 * c4 + e) * 20 + 8 * g + kr] = pack4_fp8(t[4 * g][e] * W8_SCALE, t[4 * g + 1][e] * W8_SCALE, t[4 * g + 2][e] * W8_SCALE, t[4 * g + 3][e] * W8_SCALE);
    LDS_WAIT(); asm volatile("" ::: "memory");
#pragma unroll
    for (int jj = 0; jj < 2; ++jj) { const int n = (lane >> 2) + 16 * jj, c = lane & 3; const v4u o = *(const LAS v4u*)(s32 + n * 20 + 4 * c);
        *(GAS v4u*)(WT8 + (size_t)(n0 + n) * K8 + k0 + 16 * c) = o; }
    LDS_WAIT(); asm volatile("" ::: "memory");
}
struct MoeItem { const float* W; unsigned char* WT; int ldw, kb, nb; };
__device__ __forceinline__ MoeItem moe_item(Frame& F, int r) {
    MoeItem d;
    if (r < 32768) { const int e = r / 1024, q = r % 1024; d.W = F.in[I_WUP] + (size_t)e * DM * NUP; d.WT = WSP(unsigned char, WS_WUP) + (size_t)e * NUP * DM; d.ldw = NUP; d.kb = q / 64; d.nb = q % 64; }
    else { r -= 32768; const int e = r / 512, q = r % 512; d.W = F.in[I_WDN] + (size_t)e * DFF * DM; d.WT = WSP(unsigned char, WS_WDN) + (size_t)e * DM * DFF; d.ldw = DM; d.kb = q / 32; d.nb = q % 32; }
    return d;
}
__device__ __forceinline__ void moe_weight_items8(Frame& F, int base, LAS float* scr) {
    f32x4 tc[8], tn[8]; MoeItem dc = moe_item(F, base), dn = dc;
    tr_load_f8<true>(dc.W, dc.ldw, dc.kb, dc.nb, F.lane, tc);
    for (int i = 0; i < 8; ++i) {
        if (i + 1 < 8) { dn = moe_item(F, base + i + 1); tr_load_f8<true>(dn.W, dn.ldw, dn.kb, dn.nb, F.lane, tn); }
        tr_flush_f8(tc, 1024, dc.WT, scr, dc.kb, dc.nb, F.lane);
        dc = dn;
#pragma unroll
        for (int k = 0; k < 8; ++k) tc[k] = tn[k];
    }
}
__device__ __forceinline__ void p0_prologue(Frame& F) {
    float* MOD = WSP(float, WS_MOD);
    {
        LAS float* red = (LAS float*)(F.lds + RING_OFF);
        const float* c = F.in[I_C]; const float* wa = F.in[I_WADA]; const float* ba = F.in[I_BADA];
        for (int it = F.vcu; it < 192; it += F.G) {
            const int col = F.lane & 31, j = it * 32 + col, kb = F.wave * 128 + (F.lane >> 5) * 64; float a0 = 0.f, a1 = 0.f;
#pragma unroll 16
            for (int k = kb; k < kb + 64; ++k) { const float wv = wa[(size_t)k * (6 * DM) + j]; const float c0 = c[k], c1 = c[DM + k];
                const float s0 = c0 / (1.0f + __expf(-c0)), s1 = c1 / (1.0f + __expf(-c1)); a0 += s0 * wv; a1 += s1 * wv; }
            a0 += __shfl_xor(a0, 32); a1 += __shfl_xor(a1, 32);
            if (F.lane < 32) { red[(F.wave * 2 + 0) * 32 + col] = a0; red[(F.wave * 2 + 1) * 32 + col] = a1; }
            __syncthreads();
            if (F.tid < 64) { const int b = F.tid >> 5; float s = ba[j];
#pragma unroll
                for (int w = 0; w < 8; ++w) s += red[(w * 2 + b) * 32 + col];
                MOD[(size_t)b * (6 * DM) + j] = s; }
            __syncthreads();
        }
    }
    if (F.vcu == F.G - 1) {
        if (F.tid < 512) { const int h = F.tid >> 7, n = F.tid & 127; WSP(float, WS_LUT)[F.tid] = F.in[I_T5][t5_bucket(n) * 4 + h] * LOG2E; }
        if (F.tid == 0) { float s1 = 0.f, s2 = 0.f;
            for (int i = 0; i < 64; ++i) { s1 += F.in[I_LQ1][i] * F.in[I_LK1][i]; s2 += F.in[I_LQ2][i] * F.in[I_LK2][i]; }
            WSP(float, WS_SCAL)[0] = expf(s1) - expf(s2) + LAMBDA_INIT; }
    }
    __syncthreads();
    {
        LAS float* scr = (LAS float*)(F.lds + RING_OFF + F.wave * 16384);
        const int gw = F.vcu * NWAVES + F.wave, NGW = F.G * NWAVES;
        constexpr int I_IN = 16 * 160, I_BF = 8 * 32, I_BD = 8 * 32, I_OO = 16 * 32, I_UP = 32 * 16 * 64, I_DN = 32 * 16 * 32;
        const int NITEMS = I_IN + I_BF + I_BD + I_OO;
        for (int it = gw; it < NITEMS; it += NGW) {
            int r = it;
            if (r < I_IN) { const int kb = r / 160, nb = r % 160; f32x4 t8[8]; tr_load_f8(F.in[I_WIN], INCOLS, kb, nb, F.lane, t8, (nb >= 48) ? 8 : 0); tr_flush_f8(t8, DM, WSP(unsigned char, WS_WIN), scr, kb, nb, F.lane); continue; } r -= I_IN;
            if (r < I_BF) { transpose_item(F.in[I_WBF], DM, 0, 512, WSP(bf16, WS_WBF), 0, scr, r / 32, r % 32, F.lane); continue; } r -= I_BF;
            if (r < I_BD) { transpose_item(F.in[I_WBD], DM, 0, 512, WSP(bf16, WS_WBD), 0, scr, r / 32, r % 32, F.lane); continue; } r -= I_BD;
            if (r < I_OO) { transpose_item(F.in[I_WO], DM, 0, DM, WSP(bf16, WS_WO), 0, scr, r / 32, r % 32, F.lane); continue; } r -= I_OO;
        }
    }
}

__device__ __forceinline__ void norm_mod_row(const float* xrow, const float* g, const float* shift, const float* scale, int lane, f32x4 (&v)[4]) {
    const GAS f32x4* xr = (const GAS f32x4*)xrow + lane; float s = 0.f;
#pragma unroll
    for (int j = 0; j < 4; ++j) { v[j] = xr[64 * j]; s += (v[j].x * v[j].x + v[j].y * v[j].y) + (v[j].z * v[j].z + v[j].w * v[j].w); }
    const float rstd = 1.0f / sqrtf(wave_sum(s) * (1.0f / DM) + 1e-6f);
#pragma unroll
    for (int j = 0; j < 4; ++j) { const f32x4 gg = ((const GAS f32x4*)g)[64 * j + lane], sh = ((const GAS f32x4*)shift)[64 * j + lane], sc = ((const GAS f32x4*)scale)[64 * j + lane];
        v[j] = v[j] * rstd * gg * (sc + 1.0f) + sh; }
}
__device__ __forceinline__ void norm_mod_row_bf16(const bf16* xrow, const float* g, const float* shift, const float* scale, int lane, f32x4 (&v)[4]) {
    const GAS unsigned long long* xr = (const GAS unsigned long long*)xrow + lane; float s = 0.f;
#pragma unroll
    for (int j = 0; j < 4; ++j) { const unsigned long long w = xr[64 * j]; const unsigned lo = (unsigned)w, hi = (unsigned)(w >> 32); v[j] = (f32x4){bflo(lo), bfhi(lo), bflo(hi), bfhi(hi)};
        s += (v[j].x * v[j].x + v[j].y * v[j].y) + (v[j].z * v[j].z + v[j].w * v[j].w); }
    const float rstd = 1.0f / sqrtf(wave_sum(s) * (1.0f / DM) + 1e-6f);
#pragma unroll
    for (int j = 0; j < 4; ++j) { const f32x4 gg = ((const GAS f32x4*)g)[64 * j + lane], sh = ((const GAS f32x4*)shift)[64 * j + lane], sc = ((const GAS f32x4*)scale)[64 * j + lane];
        v[j] = v[j] * rstd * gg * (sc + 1.0f) + sh; }
}
__device__ __forceinline__ void store_row_bf16(bf16* orow, int lane, const f32x4 (&v)[4]) {
    GAS unsigned long long* o8 = (GAS unsigned long long*)orow + lane;
#pragma unroll
    for (int j = 0; j < 4; ++j) o8[64 * j] = (unsigned long long)pk2(v[j].x, v[j].y) | ((unsigned long long)pk2(v[j].z, v[j].w) << 32);
}

__device__ __forceinline__ void p1_norm_fgate(Frame& F) {
    LAS float* wfl = (LAS float*)(F.lds + RING_OFF);
    LAS float* lfs = (LAS float*)(F.lds + RING_OFF + 40960);
    const float* win = F.in[I_WIN]; const float* MOD = WSP(float, WS_MOD);
    for (int u = F.tid; u < 8192; u += NWAVES * 64) { const int k = u >> 3; wfl[((k >> 8) * 64 + ((k >> 2) & 63)) * 36 + (k & 3) * 8 + (u & 7)] = win[(size_t)k * INCOLS + 1536 + (u & 7)]; }
    __syncthreads();
    for (int g = F.vcu; g < M / 64; g += F.G) {
        for (int i = 0; i < 8; ++i) {
            const int rl = F.wave * 8 + i, row = g * 64 + rl, b = row / SEQ;
            f32x4 v[4]; norm_mod_row(F.in[I_X] + (size_t)row * DM, F.in[I_LN1G], MOD + (size_t)b * 6 * DM, MOD + (size_t)b * 6 * DM + DM, F.lane, v);
            { GAS unsigned* o4 = (GAS unsigned*)(WSP(unsigned char, WS_XN) + (size_t)row * DM) + F.lane;
#pragma unroll
              for (int j = 0; j < 4; ++j) o4[64 * j] = pack4_fp8(v[j].x, v[j].y, v[j].z, v[j].w); }
            float a[8];
#pragma unroll
            for (int hh = 0; hh < 8; ++hh) a[hh] = 0.f;
#pragma unroll
            for (int j = 0; j < 4; ++j)
#pragma unroll
                for (int e = 0; e < 4; ++e) { const LAS float* wp_ = wfl + (j * 64 + F.lane) * 36 + e * 8; const f32x4 w0 = *(const LAS f32x4*)(wp_), w1 = *(const LAS f32x4*)(wp_ + 4); const float hv = v[j][e];
                    a[0] += hv * w0.x; a[1] += hv * w0.y; a[2] += hv * w0.z; a[3] += hv * w0.w; a[4] += hv * w1.x; a[5] += hv * w1.y; a[6] += hv * w1.z; a[7] += hv * w1.w; }
            float mine = 0.f;
#pragma unroll
            for (int hh = 0; hh < 8; ++hh) { const float s = wave_sum(a[hh]); if (F.lane == hh) mine = s; }
            if (F.lane < 8) { const float z = mine + F.in[I_BFG][F.lane]; lfs[rl * 8 + F.lane] = fminf(z, 0.f) - log1pf(expf(-fabsf(z))); }
        }
        __syncthreads();
        if (F.tid < 8) { float run = 0.f; float* floc = WSP(float, WS_FLOC);
            for (int r = 0; r < 64; ++r) { run += lfs[r * 8 + F.tid]; floc[(size_t)(g * 64 + r) * 8 + F.tid] = run; }
            WSP(float, WS_BT)[g * 8 + F.tid] = run; }
        __syncthreads();
    }
}
__device__ __forceinline__ void p2_finish_f(Frame& F) {
    LAS float* base = (LAS float*)(F.lds + RING_OFF);
    const float* BT = WSP(float, WS_BT); const float* floc = WSP(float, WS_FLOC); float* F2 = WSP(float, WS_F2);
    for (int g = F.vcu; g < M / 64; g += F.G) {
        const int g0 = (g / 128) * 128;
        { const int l0 = g0 + F.lane, l1 = g0 + 64 + F.lane; float s = (l0 < g ? BT[l0 * 8 + F.wave] : 0.f) + (l1 < g ? BT[l1 * 8 + F.wave] : 0.f); s = wave_sum(s); if (F.lane == 0) base[F.wave] = s; }
        __syncthreads();
        { const int r = F.tid >> 3, hh = F.tid & 7, row = g * 64 + r, b = row / SEQ, s = row % SEQ;
          const float f2 = (floc[(size_t)row * 8 + hh] + base[hh]) * LOG2E; F2[((size_t)b * 8 + hh) * SEQ + s] = f2;
          const float x0 = -f2; const unsigned h0 = f2bf(x0); const float r1 = x0 - __uint_as_float(h0 << 16); const unsigned h1 = f2bf(r1); const float r2 = r1 - __uint_as_float(h1 << 16); const unsigned h2 = f2bf(r2);
          v4u w; w.x = h0 | (h1 << 16); w.y = h2 | (0x3F80u << 16); w.z = 0x3F803F80u; w.w = 0u; WSP(v4u, WS_KA)[((size_t)b * 8 + hh) * SEQ + s] = w; }
        __syncthreads();
    }
}

__device__ __forceinline__ void p4_diff_post(Frame& F) {
    const bf16* OD = WSP(bf16, WS_OD); bf16* YD = WSP(bf16, WS_YD); const float lam = WSP(float, WS_SCAL)[0]; const float* gn = F.in[I_DNG];
    const int gw = F.vcu * NWAVES + F.wave, NGW = F.G * NWAVES; const int e0 = (F.lane & 15) * 8;
    float gv[8];
#pragma unroll
    for (int e = 0; e < 8; ++e) gv[e] = gn[e0 + e] * (1.0f - LAMBDA_INIT);
    for (int row = gw; row < M; row += NGW) {
        const v4u a = *(const v4u*)(OD + (size_t)row * 1024 + F.lane * 8), bq = *(const v4u*)(OD + (size_t)row * 1024 + 512 + F.lane * 8);
        float y[8]; y[0] = bflo(a.x) - lam * bflo(bq.x); y[1] = bfhi(a.x) - lam * bfhi(bq.x); y[2] = bflo(a.y) - lam * bflo(bq.y); y[3] = bfhi(a.y) - lam * bfhi(bq.y);
        y[4] = bflo(a.z) - lam * bflo(bq.z); y[5] = bfhi(a.z) - lam * bfhi(bq.z); y[6] = bflo(a.w) - lam * bflo(bq.w); y[7] = bfhi(a.w) - lam * bfhi(bq.w);
        float ss = 0.f;
#pragma unroll
        for (int e = 0; e < 8; ++e) ss += y[e] * y[e];
        ss += __shfl_xor(ss, 1); ss += __shfl_xor(ss, 2); ss += __shfl_xor(ss, 4); ss += __shfl_xor(ss, 8);
        const float rstd = 1.0f / sqrtf(ss * (1.0f / 128.0f) + 1e-5f);
        v4u w; w.x = pk2(y[0] * rstd * gv[0], y[1] * rstd * gv[1]); w.y = pk2(y[2] * rstd * gv[2], y[3] * rstd * gv[3]); w.z = pk2(y[4] * rstd * gv[4], y[5] * rstd * gv[5]); w.w = pk2(y[6] * rstd * gv[6], y[7] * rstd * gv[7]);
        *(v4u*)(YD + (size_t)row * 512 + F.lane * 8) = w;
    }
}

__device__ __forceinline__ void p7_route(Frame& F) {
    typedef float f32x16_t __attribute__((ext_vector_type(16)));
    LAS float* HS = (LAS float*)(F.lds + RING_OFF);
    LAS float* PL = (LAS float*)(F.lds + RING_OFF + 36864);
    LAS unsigned* lcnt = (LAS unsigned*)(F.lds + TAB_OFF);
    LAS int* prs = (LAS int*)(F.lds + TAB_OFF + 512);
    const bf16* X1 = WSP(bf16, WS_X1B); const float* MOD = WSP(float, WS_MOD); const float* wr = F.in[I_WR]; const float* br = F.in[I_BR];
    int* TOPE = WSP(int, WS_TOPE); int* RANK = WSP(int, WS_RANK);
    const int e = F.lane & 31, hh = F.lane >> 5, rt = F.wave & 1, kp = F.wave >> 1;
    const float bre = br[e];
    for (int grp = F.vcu; grp < M / 64; grp += F.G) {
        if (F.tid < 32) lcnt[F.tid] = 0u;
        const int row0 = grp * 64 + F.wave * 8, b = row0 / SEQ;
        f32x4 v[8][4];
#pragma unroll
        for (int r = 0; r < 8; ++r) { norm_mod_row_bf16(X1 + (size_t)(row0 + r) * DM, F.in[I_LN2G], MOD + (size_t)b * 6 * DM + 3 * DM, MOD + (size_t)b * 6 * DM + 4 * DM, F.lane, v[r]);
            { GAS unsigned* o4 = (GAS unsigned*)(WSP(unsigned char, WS_XN) + (size_t)(row0 + r) * DM) + F.lane;
#pragma unroll
              for (int j = 0; j < 4; ++j) o4[64 * j] = pack4_fp8(v[r][j].x, v[r][j].y, v[r][j].z, v[r][j].w); } }
        f32x16_t acc = f32x16_t{};
#pragma unroll
        for (int q = 0; q < 8; ++q) {
            __syncthreads();
            if (hh == (q & 1)) {
#pragma unroll
                for (int r = 0; r < 8; ++r) { LAS float* d_ = HS + (F.wave * 8 + r) * 129 + 4 * e; const f32x4 t_ = v[r][q >> 1]; d_[0] = t_.x; d_[1] = t_.y; d_[2] = t_.z; d_[3] = t_.w; } }
            __syncthreads();
            const LAS float* ap = HS + (rt * 32 + e) * 129 + 32 * kp + hh; const float* bp = wr + (size_t)(128 * q + 32 * kp + hh) * NE + e;
#pragma unroll
            for (int s2 = 0; s2 < 16; ++s2) acc = __builtin_amdgcn_mfma_f32_32x32x2f32(ap[2 * s2], bp[(size_t)(2 * s2) * NE], acc, 0, 0, 0);
        }
#pragma unroll
        for (int r = 0; r < 16; ++r) PL[(kp * 64 + rt * 32 + (r & 3) + 8 * (r >> 2) + 4 * hh) * 32 + e] = acc[r];
        __syncthreads();
#pragma unroll
        for (int it = 0; it < 4; ++it) {
            const int rl = F.wave * 8 + 2 * it + hh;
            float val = ((PL[(0 * 64 + rl) * 32 + e] + PL[(1 * 64 + rl) * 32 + e]) + (PL[(2 * 64 + rl) * 32 + e] + PL[(3 * 64 + rl) * 32 + e])) + bre;
            float tv[4]; int te[4];
#pragma unroll
            for (int kk = 0; kk < 4; ++kk) { float best = val; int bi = e;
#pragma unroll
                for (int o = 1; o < 32; o <<= 1) { const float ov = __shfl_xor(best, o); const int oi = __shfl_xor(bi, o); if (ov > best || (ov == best && oi < bi)) { best = ov; bi = oi; } }
                tv[kk] = best; te[kk] = bi; if (e == bi) val = -INFINITY; }
            const float p1 = __expf(tv[1] - tv[0]), p2 = __expf(tv[2] - tv[0]), p3 = __expf(tv[3] - tv[0]); const float inv = 1.0f / (1.0f + p1 + p2 + p3);
            if (e < 4) { const int me = e == 0 ? te[0] : e == 1 ? te[1] : e == 2 ? te[2] : te[3]; const float mg = (e == 0 ? 1.0f : e == 1 ? p1 : e == 2 ? p2 : p3) * inv;
                const int rk = (int)__hip_atomic_fetch_add(lcnt + me, 1u, __ATOMIC_RELAXED, __HIP_MEMORY_SCOPE_WORKGROUP);
                const int li = rl * 4 + e; prs[3 * li] = me; prs[3 * li + 1] = rk; prs[3 * li + 2] = (int)__float_as_uint(mg);
                TOPE[(size_t)(grp * 64 + rl) * 4 + e] = me; }
        }
        __syncthreads();
        if (F.tid < 32) lcnt[32 + F.tid] = __hip_atomic_fetch_add(F.ctl + CW_CNT + 64 * F.tid, lcnt[F.tid], __ATOMIC_RELAXED, __HIP_MEMORY_SCOPE_AGENT);
        __syncthreads();
        if (F.tid < 256) { const int me = prs[3 * F.tid], rk = (int)lcnt[32 + me] + prs[3 * F.tid + 1]; RANK[(size_t)grp * 256 + F.tid] = rk;
            WSP(int, WS_IDX)[(size_t)me * ECAP + rk] = grp * 64 + (F.tid >> 2); WSP(float, WS_GX)[(size_t)me * ECAP + rk] = __uint_as_float((unsigned)prs[3 * F.tid + 2]); }
        __syncthreads();
    }
}
__device__ __forceinline__ void load_expert_tables(Frame& F) {
    LAS int* tab = (LAS int*)(F.lds + TAB_OFF);
    if (F.tid < 32) tab[F.tid] = (int)__hip_atomic_load(F.ctl + CW_CNT + 64 * F.tid, __ATOMIC_RELAXED, __HIP_MEMORY_SCOPE_AGENT);
    __syncthreads();
    if (F.tid == 0) { int run = 0; for (int e = 0; e < 32; ++e) { const int mt = (tab[e] + 255) >> 8; tab[32 + e] = run; tab[65 + e] = mt; run += mt * 256; } tab[64] = run; }
    __syncthreads();
}
__device__ __forceinline__ int build_units(Frame& F, int NT) {
    load_expert_tables(F);
    LAS int* tab = (LAS int*)(F.lds + TAB_OFF); LAS int* lst = (LAS int*)(F.lds + TAB_OFF + 1024);
    if (F.tid == 0) { int n = 0; int total = 0; for (int e = 0; e < 32; ++e) total += tab[65 + e] * NT;
        for (int i = 0;; ++i) { const int L = i * F.G + F.vcu; if (L >= total || n >= 256) break;
            int e = 0, r = L; while (r >= tab[65 + e] * NT) { r -= tab[65 + e] * NT; ++e; }
            const int pn = r % NT, pml = r / NT;
            const int nr = tab[e] - 256 * pml;
            lst[6 * n] = (tab[32 + e] >> 8) + pml; lst[6 * n + 1] = pn; lst[6 * n + 2] = e * NT + pn; lst[6 * n + 3] = e; lst[6 * n + 4] = e * ECAP + 256 * pml; lst[6 * n + 5] = nr < 256 ? nr : 256; ++n; }
        tab[128] = n; }
    __syncthreads();
    return tab[128];
}
__device__ __forceinline__ void p11_final(Frame& F) {
    load_expert_tables(F); const LAS int* tab = (const LAS int*)(F.lds + TAB_OFF);
    const float* MOD = WSP(float, WS_MOD); const int* TOPE = WSP(int, WS_TOPE); const int* RANK = WSP(int, WS_RANK); const bf16* YP = WSP(bf16, WS_YP); const float* fg = F.in[I_FING];
    const int gw = F.vcu * NWAVES + F.wave, NGW = F.G * NWAVES;
    for (int rb = gw; rb < M; rb += 8 * NGW) {
    int myslot = 0; { const int prow = rb + (F.lane >> 2) * NGW; if (F.lane < 32 && prow < M) { const size_t pi = (size_t)prow * 4 + (F.lane & 3); myslot = tab[32 + TOPE[pi]] + RANK[pi]; } }
#pragma unroll 4
    for (int ri = 0; ri < 8; ++ri) { const int row = rb + ri * NGW; if (row >= M) break;
        const int b = row / SEQ; const float* g2 = MOD + (size_t)b * 6 * DM + 5 * DM;
        GAS f32x4* xr = (GAS f32x4*)(F.out + (size_t)row * DM) + F.lane; const GAS unsigned long long* x1r = (const GAS unsigned long long*)(WSP(bf16, WS_X1B) + (size_t)row * DM) + F.lane;
        int sl[4];
#pragma unroll
        for (int k = 0; k < 4; ++k) sl[k] = __shfl(myslot, ri * 4 + k);
        f32x4 v[4]; float s = 0.f;
#pragma unroll
        for (int j = 0; j < 4; ++j) { f32x4 y = (f32x4){0.f, 0.f, 0.f, 0.f};
#pragma unroll
            for (int k = 0; k < 4; ++k) { const unsigned long long w = *(const unsigned long long*)(YP + (size_t)sl[k] * DM + 256 * j + 4 * F.lane); const unsigned lo = (unsigned)w, hi = (unsigned)(w >> 32);
                y.x += bflo(lo); y.y += bfhi(lo); y.z += bflo(hi); y.w += bfhi(hi); }
            const f32x4 gg = ((const GAS f32x4*)g2)[64 * j + F.lane];
            { const unsigned long long w1 = x1r[64 * j]; const unsigned l1 = (unsigned)w1, h1 = (unsigned)(w1 >> 32); v[j] = (f32x4){bflo(l1), bfhi(l1), bflo(h1), bfhi(h1)} + gg * y; } s += (v[j].x * v[j].x + v[j].y * v[j].y) + (v[j].z * v[j].z + v[j].w * v[j].w); }
        const float rstd = 1.0f / sqrtf(wave_sum(s) * (1.0f / DM) + 1e-6f);
#pragma unroll
        for (int j = 0; j < 4; ++j) { const f32x4 gg = ((const GAS f32x4*)fg)[64 * j + F.lane]; xr[64 * j] = v[j] * rstd * gg; }
    }
    }
}

#ifndef MK_PER_PHASE
#define MK_PER_PHASE 0
#endif
#ifndef MK_REP_MASK
#define MK_REP_MASK 0
#endif
#ifndef MK_LAUNCH_SEQ
#define MK_LAUNCH_SEQ {0, N_PHASES}
#endif
constexpr int N_PHASES = 11;
struct Args { const float* in[25]; float* out; unsigned char* ws; int ph_lo, ph_hi; };
__global__ void __launch_bounds__(NWAVES * 64, 2) skel_fwd(Args args) {
    extern __shared__ __attribute__((aligned(16))) unsigned char lds[];
    Frame F;
    F.lds = (LAS unsigned char*)lds;
    F.MISC = (volatile LAS unsigned*)(F.lds + MISC_OFF);
    F.tid = threadIdx.x; F.lane = F.tid & 63; F.wave = __builtin_amdgcn_readfirstlane(F.tid >> 6);
    F.G = gridDim.x; { const int bx = blockIdx.x; F.vcu = (F.G % 8 == 0) ? (bx % 8) * (F.G / 8) + bx / 8 : bx; }
    F.ws = args.ws; F.out = args.out; F.ctl = (gu32*)(args.ws + WS_CTL);
#pragma unroll
    for (int i = 0; i < 25; ++i) F.in[i] = args.in[i];
    for (int u = F.tid; u < (LDS_BYTES - LDSCTL_OFF) / 4; u += NWAVES * 64) ((LAS unsigned*)(F.lds + LDSCTL_OFF))[u] = 0u;
    __syncthreads();
    XcdBarrier bar; bar.bar = (unsigned*)(F.ctl + CW_BAR); bar.x = 0; bar.st = nullptr;
    const int lo = args.ph_lo, hi = args.ph_hi;
    if (hi - lo > 1) bar = xcd_barrier_post((unsigned*)(F.ctl + CW_BAR), F.MISC + 8);
#define IN(k) (lo <= (k) && (k) < hi)
#define SEAM(k) do { if (IN(k) && IN((k) + 1)) xcd_barrier(bar); } while (0)
#define REFRESH_TID() do { int t_ = threadIdx.x; asm volatile("" : "+v"(t_)); F.tid = t_; F.lane = t_ & 63; } while (0)

    if (IN(0)) for (int rep_ = 0; rep_ <= ((MK_REP_MASK >> 0) & 1); ++rep_) { REFRESH_TID(); p0_prologue(F); } SEAM(0);
    if (IN(1)) for (int rep_ = 0; rep_ <= ((MK_REP_MASK >> 1) & 1); ++rep_) { REFRESH_TID(); p1_norm_fgate(F); } SEAM(1);
    if (IN(2)) for (int rep_ = 0; rep_ <= ((MK_REP_MASK >> 2) & 1); ++rep_) { REFRESH_TID();
        p2_finish_f(F); __syncthreads();
        pg8::Gemm g{WSP(pg8::bf16_t, WS_XN), WSP(pg8::bf16_t, WS_WIN), M, NPROJ, DM / 2, nullptr, 0u}; pg8::StaticOrder S; S.init(M, NPROJ, F.G, (int)blockIdx.x);
        epi::EpiProj E{WSP(pg8::bf16_t, WS_PROJ), F.in[I_BMERGE], (unsigned*)(F.ctl + CW_NRM)};
        pg8::gemm_phase<epi::EpiProj, pg8::StaticOrder, true, true, false, true>(F.lds + RING_OFF, g, S, E);
    } SEAM(2);
    if (IN(3)) for (int rep_ = 0; rep_ <= ((MK_REP_MASK >> 3) & 1); ++rep_) { REFRESH_TID();
        const attn_body::AttnBufs A{(const attn_body::bf16*)WSP(bf16, WS_PROJ), (attn_body::bf16*)WSP(bf16, WS_YFOX), (attn_body::bf16*)WSP(bf16, WS_YD), WSP(float, WS_F2), (const attn_body::bf16*)WSP(bf16, WS_KA), (const unsigned*)(F.ctl + CW_NRM), WSP(float, WS_SCAL), F.in[I_DNG]};
        {
            const int x = (int)blockIdx.x & 7; const bool conv_first = (((int)blockIdx.x >> 3) % 3) == 2;
            gu32* qa = F.ctl + CW_Q + 64 * (2 * x), * qc = F.ctl + CW_Q + 64 * (2 * x + 1);
            volatile LAS int* qs = (volatile LAS int*)(F.lds + TAB_OFF);
#define FETCH_(q) ({ if (F.tid == 0) qs[0] = (int)__hip_atomic_fetch_add(q, 1u, __ATOMIC_RELAXED, __HIP_MEMORY_SCOPE_AGENT); __syncthreads(); const int v_ = __builtin_amdgcn_readfirstlane(qs[0]); __syncthreads(); v_; })
#define CONV_LOOP_() do { for (;;) { REFRESH_TID(); const int v = FETCH_(qc); if (v >= 96) break; LAS float* scr = (LAS float*)(F.lds + RING_OFF + F.wave * 16384); const int base = (v * 8 + x) * 64 + F.wave * 8; \
                moe_weight_items8(F, base, scr); __syncthreads(); } } while (0)
            if (conv_first) CONV_LOOP_();
            attn_body::attn_build_lut((char*)lds + RING_OFF, WSP(float, WS_LUT));
            for (;;) { REFRESH_TID(); const int v = FETCH_(qa); if (v >= 128) break;
                if (v < 64) attn_body::attn_run_diff<8>(A, x, 63 - v, (char*)lds + RING_OFF);
                else { const int j = 2 * x + (v & 1), qb = 31 - ((v & 63) >> 1); attn_body::attn_run_fox<8>(A, j, qb, (char*)lds + RING_OFF); } }
            if (!conv_first) CONV_LOOP_();
#undef FETCH_
#undef CONV_LOOP_
        }
    } SEAM(3);
    if (IN(5)) for (int rep_ = 0; rep_ <= ((MK_REP_MASK >> 5) & 1); ++rep_) { REFRESH_TID();
        { pg8::Gemm g{WSP(pg8::bf16_t, WS_YFOX), WSP(pg8::bf16_t, WS_WBF), M, DM, 512, nullptr, 0u}; pg8::StaticOrder S; S.init(M, DM, F.G, (int)blockIdx.x);
          epi::EpiBranch<0> E{WSP(pg8::bf16_t, WS_PROJ), nullptr, WSP(pg8::bf16_t, WS_T1)};
          pg8::gemm_phase<epi::EpiBranch<0>, pg8::StaticOrder, false, true>(F.lds + RING_OFF, g, S, E); }
        VM_WAIT(); __syncthreads();
        { pg8::Gemm g{WSP(pg8::bf16_t, WS_YD), WSP(pg8::bf16_t, WS_WBD), M, DM, 512, nullptr, 0u}; pg8::StaticOrder S; S.init(M, DM, F.G, (int)blockIdx.x);
          epi::EpiBranch<1> E{WSP(pg8::bf16_t, WS_PROJ), WSP(pg8::bf16_t, WS_T1), WSP(pg8::bf16_t, WS_MRG)};
          pg8::gemm_phase<epi::EpiBranch<1>, pg8::StaticOrder, false, true>(F.lds + RING_OFF, g, S, E); }
    } SEAM(5);
    if (IN(6)) for (int rep_ = 0; rep_ <= ((MK_REP_MASK >> 6) & 1); ++rep_) { REFRESH_TID();
        pg8::Gemm g{WSP(pg8::bf16_t, WS_MRG), WSP(pg8::bf16_t, WS_WO), M, DM, DM, nullptr, 0u}; pg8::StaticOrder S; S.init(M, DM, F.G, (int)blockIdx.x);
        epi::EpiWo E{F.in[I_X], WSP(float, WS_MOD), WSP(pg8::bf16_t, WS_X1B)};
        pg8::gemm_phase<epi::EpiWo, pg8::StaticOrder, false, true>(F.lds + RING_OFF, g, S, E);
    } SEAM(6);
    if (IN(7)) for (int rep_ = 0; rep_ <= ((MK_REP_MASK >> 7) & 1); ++rep_) { REFRESH_TID(); p7_route(F); } SEAM(7);
    if (IN(8)) for (int rep_ = 0; rep_ <= ((MK_REP_MASK >> 8) & 1); ++rep_) { REFRESH_TID();
        const int n = build_units(F, NUP / 256);
        pg8::Gemm g{WSP(pg8::bf16_t, WS_XN), WSP(pg8::bf16_t, WS_WUP), PMAX, NUP, DM / 2, WSP(int, WS_IDX), 0u}; epi::ListOrder S{(const PG8_LAS int*)(F.lds + TAB_OFF + 1024), n};
        epi::EpiUp E{F.in[I_BUP], WSP(unsigned char, WS_ACT)};
        pg8::gemm_phase<epi::EpiUp, epi::ListOrder, true, true, true, true>(F.lds + RING_OFF, g, S, E);
    } SEAM(8);
    if (IN(9)) for (int rep_ = 0; rep_ <= ((MK_REP_MASK >> 9) & 1); ++rep_) { REFRESH_TID();
        const int n = build_units(F, DM / 256);
        pg8::Gemm g{WSP(pg8::bf16_t, WS_ACT), WSP(pg8::bf16_t, WS_WDN), PMAX, DM, DFF / 2, nullptr, 0u}; epi::ListOrder S{(const PG8_LAS int*)(F.lds + TAB_OFF + 1024), n};
        epi::EpiDown E{F.in[I_BDN], WSP(float, WS_GX), WSP(pg8::bf16_t, WS_YP)};
        pg8::gemm_phase<epi::EpiDown, epi::ListOrder, true, true, false, true>(F.lds + RING_OFF, g, S, E);
    } SEAM(9);
    if (IN(10)) for (int rep_ = 0; rep_ <= ((MK_REP_MASK >> 10) & 1); ++rep_) { REFRESH_TID(); p11_final(F); }
#ifdef MK_PROBE_P2N
    if (IN(11)) { REFRESH_TID();
        pg8::Gemm g{WSP(pg8::bf16_t, WS_XN), WSP(pg8::bf16_t, WS_WIN), M, MK_PROBE_P2N, DM, nullptr, 0u}; pg8::StaticOrder S; S.init(M, MK_PROBE_P2N, F.G, (int)blockIdx.x);
        epi::EpiProj E{WSP(pg8::bf16_t, WS_PROJ), F.in[I_BMERGE], (unsigned*)(F.ctl + CW_NRM)};
        pg8::gemm_phase<epi::EpiProj, pg8::StaticOrder, true, true>(F.lds + RING_OFF, g, S, E); }
#endif
#undef IN
#undef SEAM
}

extern "C" void kernel_launch(void* const* d_in, const int* in_sizes, int n_in, void* d_out, int out_size, void* d_ws, size_t ws_size, hipStream_t stream) {
    static int grid = 0;
    if (grid == 0) {
        if (n_in != 25 || in_sizes[0] != M * DM || out_size != M * DM || ws_size < WS_END) { fprintf(stderr, "kernel_launch: unexpected problem (n_in %d, in0 %d, out %d, ws %zu, need %zu); nothing launched\n", n_in, n_in > 0 ? in_sizes[0] : -1, out_size, ws_size, (size_t)WS_END); grid = -1; return; }
        int dev = 0, cus = 0, per_cu = 0;
        if (hipGetDevice(&dev) != hipSuccess || hipDeviceGetAttribute(&cus, hipDeviceAttributeMultiprocessorCount, dev) != hipSuccess) { grid = -1; return; }
        if (hipFuncSetAttribute((const void*)skel_fwd, hipFuncAttributeMaxDynamicSharedMemorySize, LDS_BYTES) != hipSuccess) { fprintf(stderr, "kernel_launch: hipFuncSetAttribute failed\n"); grid = -1; return; }
        if (hipOccupancyMaxActiveBlocksPerMultiprocessor(&per_cu, (const void*)skel_fwd, NWAVES * 64, LDS_BYTES) != hipSuccess || per_cu < 1) { fprintf(stderr, "kernel_launch: occupancy query reports %d blocks per CU\n", per_cu); }
        (void)hipGetLastError();
        grid = cus;
    }
    if (grid < 0) return;
    if (hipMemsetAsync((char*)d_ws + WS_CTL, 0, CTL_ZERO_BYTES, stream) != hipSuccess) { fprintf(stderr, "kernel_launch: memset failed\n"); return; }
    Args a{};
    for (int i = 0; i < 25; ++i) a.in[i] = (const float*)d_in[i];
    a.out = (float*)d_out; a.ws = (unsigned char*)d_ws;
#if MK_PER_PHASE
    for (int p = 0; p < N_PHASES; ++p) { a.ph_lo = p; a.ph_hi = p + 1; hipLaunchKernelGGL(skel_fwd, dim3(grid), dim3(NWAVES * 64), LDS_BYTES, stream, a); }
#else
    { const int seq[] = MK_LAUNCH_SEQ; constexpr int nseq = sizeof(seq) / sizeof(int) / 2;
      for (int p = 0; p < nseq; ++p) { a.ph_lo = seq[2 * p]; a.ph_hi = seq[2 * p + 1];
          if (p > 0) (void)hipMemsetAsync((char*)d_ws + WS_CTL, 0, CTL_ZERO_BYTES, stream);
          hipLaunchKernelGGL(skel_fwd, dim3(grid), dim3(NWAVES * 64), LDS_BYTES, stream, a); } }
#endif
    const hipError_t le = hipPeekAtLastError();
    if (le != hipSuccess) fprintf(stderr, "kernel_launch: launch failed: %s\n", hipGetErrorName(le));
}
```

```cpp
#include <hip/hip_runtime.h>
#include <cstdio>
#include <cstdint>

constexpr int NB = 2, SEQ = 8192, DM = 1024, M = NB * SEQ;
constexpr int INCOLS = 5128, NPROJ = 5120;
constexpr int PC_FQ = 0, PC_FK = 512, PC_FV = 1024, PC_DQ = 1536, PC_DK = 2048, PC_DV = 2560, PC_G = 3072;
constexpr int NE = 32, TOPK = 4, NUP = 2048, DFF = 1024;
constexpr int PMAX = 73728;
constexpr float LOG2E = 1.4426950408889634f;
constexpr float QSCALE = 0.125f * LOG2E;
constexpr float LAMBDA_INIT = 0.2f;
namespace pg8 {
#define PG8_LAS __attribute__((address_space(3)))
typedef unsigned short bf16_t;
typedef short bf16x8 __attribute__((ext_vector_type(8)));
typedef float f32x4 __attribute__((ext_vector_type(4)));
typedef unsigned u32x4 __attribute__((ext_vector_type(4)));
constexpr int BM = 256, BK = 64, HALF = 128, HTB = HALF * BK * 2  , STAGE_BYTES = 8 * HTB, NXCD = 8, WGM = 4;

__host__ __device__ __forceinline__ int lds_byte(int r, int c) { const int st = (r >> 4) * 2 + (c >> 5), rr = r & 15, cc = c & 31, ob = rr * 64 + cc * 2; return st * 1024 + (ob ^ (((ob >> 9) & 1) << 5)); }
__host__ __device__ __forceinline__ void stage_rc(int b, int& R, int& C) { const int st = b / 1024, sb = b % 1024, swz = sb ^ (((sb >> 9) & 1) << 5); R = (st >> 1) * 16 + swz / 64; C = (st & 1) * 32 + (swz % 64) / 2; }
__host__ __device__ __forceinline__ int perm32(int rho) { const int n = rho >> 4, i = rho & 15; return 8 * (i >> 2) + 4 * n + (i & 3); }

struct Unit { int pm, pn, pb, e, ar, nr, md; };
struct Gemm { const bf16_t* A; const bf16_t* Bt; int M, N, K; const int* idx; unsigned aoff2; };

struct StaticOrder {
    int nM, nN, nwg, G, c;
    __host__ __device__ void init(int M, int N, int G_, int c_) { nM = M / BM; nN = N / BM; nwg = nM * nN; G = G_; c = c_; }
    __host__ __device__ bool next(int i, Unit& u) const {
        const long L = (long)i * G + c; if (L >= nwg) return false;
        int wgid = (int)L; { const int q = nwg / NXCD, r = nwg % NXCD, xcd = wgid % NXCD, off = wgid / NXCD; wgid = (xcd < r ? xcd * (q + 1) : r * (q + 1) + (xcd - r) * q) + off; }
        const int nig = WGM * nN, gid = wgid / nig, fm = gid * WGM, gsz = (nM - fm) < WGM ? (nM - fm) : WGM;
        u.pm = fm + ((wgid % nig) % gsz); u.pn = (wgid % nig) / gsz; u.pb = u.pn; u.e = 0; u.ar = 0; u.nr = 0; u.md = 0; return true;
    }
    __device__ __forceinline__ void a_ready(const Unit&) const {}
    __device__ __forceinline__ void done(const Unit&) const {}
};

__device__ __forceinline__ unsigned cvt_pk_bf16(float lo, float hi) { unsigned r; asm volatile("v_cvt_pk_bf16_f32 %0, %1, %2" : "=v"(r) : "v"(lo), "v"(hi)); return r; }
typedef float f32x2 __attribute__((ext_vector_type(2)));
template <class Epi, class Sched, bool ALIGN_EPI = false, bool SP2 = false, bool GATHER = false, bool FP8 = false>
__device__ __forceinline__ void gemm_phase(PG8_LAS unsigned char* lds, const Gemm g, const Sched& S, const Epi& E) {
    const int tid = threadIdx.x, wid = __builtin_amdgcn_readfirstlane(tid >> 6), lane = tid & 63, wr = wid >> 2, wc = wid & 3, fr = lane & 15, fq = lane >> 4;
    const int K = g.K, nt = K / BK;
    unsigned voffA[2], voffB[2];
#pragma unroll
    for (int i = 0; i < 2; ++i) { int R, C; stage_rc(tid * 16 + i * 8192, R, C); const int Rb = Epi::PERM ? ((R & ~31) + perm32(R & 31)) : R;
        voffA[i] = (unsigned)(R * K + C) * 2u; voffB[i] = (unsigned)(Rb * K + C) * 2u; }
    unsigned vgc[2][2] = {{0u, 0u}, {0u, 0u}}, vgn[2][2] = {{0u, 0u}, {0u, 0u}};
#define PG8_GOFF(dst, u) do { _Pragma("unroll") for (int h_ = 0; h_ < 2; ++h_) _Pragma("unroll") for (int i_ = 0; i_ < 2; ++i_) { int R_, C_; stage_rc(tid * 16 + i_ * 8192, R_, C_); const int r_ = R_ + 128 * h_; \
        if ((u).md == 0) { const int tok_ = (r_ < (u).nr) ? g.idx[(u).ar + r_] : 0; dst[h_][i_] = (unsigned)(tok_ * K + C_) * 2u; } \
        else { dst[h_][i_] = g.aoff2 + (unsigned)((256 * (u).pm + r_) * K + C_) * 2u; } } } while (0)
    const size_t kstep = (size_t)(BK * 2);
    const size_t hstep = (size_t)HALF * K * 2;
    const size_t tstep = 2 * hstep;
    const unsigned ldsw = (unsigned)wid * 1024u;
    const int aoff = lds_byte(wr * 64 + fr, fq * 8), boff = lds_byte(wc * 32 + fr, fq * 8);
    const int aofk0 = FP8 ? lds_byte(wr * 64 + fr, fq * 16) : aoff, bofk0 = FP8 ? lds_byte(wc * 32 + fr, fq * 16) : boff;
    constexpr int KOFF = FP8 ? 16 : 1024;
#define PG8_SA(b, h) (((b) * 2 + (h)) * HTB)
#define PG8_SB(b, h) ((4 + (b) * 2 + (h)) * HTB)
#define PG8_STAGE(bufoff, gbase, voff) do { _Pragma("unroll") for (int _i = 0; _i < 2; ++_i) \
        __builtin_amdgcn_global_load_lds((const unsigned*)((const char*)(gbase) + (voff)[_i]), (PG8_LAS unsigned*)(lds + (bufoff) + ldsw + _i * 8192), 16, 0, 0); } while (0)
#define PG8_STAGE_A(bufoff, P, h, NX) do { if constexpr (GATHER) { unsigned vo_[2]; vo_[0] = (NX) ? vgn[h][0] : vgc[h][0]; vo_[1] = (NX) ? vgn[h][1] : vgc[h][1]; PG8_STAGE(bufoff, P, vo_); } \
        else { PG8_STAGE(bufoff, (P) + (h) * hstep, voffA); } } while (0)
#define PG8_LDA(dst, b, h) do { if constexpr (FP8) { _Pragma("unroll") for (int m = 0; m < 4; ++m) { dst##8[m].lo = *(const PG8_LAS i32x4_t*)(lds + PG8_SA(b, h) + aofk0 + m * 2048); dst##8[m].hi = *(const PG8_LAS i32x4_t*)(lds + PG8_SA(b, h) + aofk0 + m * 2048 + 16); } } \
        else { _Pragma("unroll") for (int m = 0; m < 4; ++m) _Pragma("unroll") for (int k = 0; k < 2; ++k) dst[m][k] = *(const PG8_LAS bf16x8*)(lds + PG8_SA(b, h) + aofk0 + m * 2048 + k * KOFF); } } while (0)
#define PG8_LDB(dst, b, h) do { if constexpr (FP8) { _Pragma("unroll") for (int n = 0; n < 2; ++n) { dst##8[n].lo = *(const PG8_LAS i32x4_t*)(lds + PG8_SB(b, h) + bofk0 + n * 2048); dst##8[n].hi = *(const PG8_LAS i32x4_t*)(lds + PG8_SB(b, h) + bofk0 + n * 2048 + 16); } } \
        else { _Pragma("unroll") for (int n = 0; n < 2; ++n) _Pragma("unroll") for (int k = 0; k < 2; ++k) dst[n][k] = *(const PG8_LAS bf16x8*)(lds + PG8_SB(b, h) + bofk0 + n * 2048 + k * KOFF); } } while (0)
#define PG8_MMA(ai, bj, At, Bt) do { if constexpr (FP8) __builtin_amdgcn_sched_barrier(0); __builtin_amdgcn_s_setprio(1); _Pragma("unroll") for (int m = 0; m < 4; ++m) _Pragma("unroll") for (int n = 0; n < 2; ++n) { \
        if constexpr (FP8) { asm volatile("s_nop 1\n\tv_mfma_scale_f32_16x16x128_f8f6f4 %0, %1, %2, %0, %3, %4 op_sel_hi:[0,0,0]" : "+v"(acc[ai][bj][m][n]) : "v"(Bt##8[n]), "v"(At##8[m]), "v"(sc_w), "v"(sc_a)); } \
        else { _Pragma("unroll") for (int k = 0; k < 2; ++k) acc[ai][bj][m][n] = __builtin_amdgcn_mfma_f32_16x16x32_bf16(Bt[n][k], At[m][k], acc[ai][bj][m][n], 0, 0, 0); } } \
        __builtin_amdgcn_s_setprio(0); if constexpr (FP8) __builtin_amdgcn_sched_barrier(0); } while (0)
#define PG8_WAIT_V(n) asm volatile("s_waitcnt vmcnt(" #n ")" ::: "memory")
#define PG8_WAIT_L(n) asm volatile("s_waitcnt lgkmcnt(" #n ")" ::: "memory")
#define PG8_BAR __builtin_amdgcn_s_barrier()
#define PG8_SCHED __builtin_amdgcn_sched_barrier(0)
    Unit cur, nxt; int ui = 0;
    if (!S.next(0, cur)) return;
    f32x4 acc[2][2][4][2];
#pragma unroll
    for (int a = 0; a < 2; ++a)
#pragma unroll
        for (int b = 0; b < 2; ++b)
#pragma unroll
            for (int m = 0; m < 4; ++m)
#pragma unroll
                for (int n = 0; n < 2; ++n) acc[a][b][m][n] = (f32x4){0.f, 0.f, 0.f, 0.f};
    typedef int i32x4_t __attribute__((ext_vector_type(4))); typedef int i32x8_t __attribute__((ext_vector_type(8)));
    bf16x8 At[4][2], B0[2][2], B1[2][2]; i32x8_t At8[4], B08[2], B18[2];
    int sc_w = 0x7a7a7a7a, sc_a = 0x7f7f7f7f; asm volatile("" : "+v"(sc_w), "+v"(sc_a));
    const char* cA = (const char*)g.A + (GATHER ? (size_t)0 : (size_t)cur.pm * tstep); const char* cB = (const char*)g.Bt + (size_t)cur.pb * tstep;
    if constexpr (GATHER) PG8_GOFF(vgc, cur);
    S.a_ready(cur);
    if constexpr (SP2) {
        PG8_STAGE(PG8_SB(0, 0), cB, voffB); PG8_STAGE(PG8_SB(0, 1), cB + hstep, voffB); PG8_STAGE_A(PG8_SA(0, 0), cA, 0, false); PG8_STAGE_A(PG8_SA(0, 1), cA, 1, false);
        if (wr == 1) PG8_BAR;
        PG8_WAIT_V(2); PG8_BAR;
        PG8_STAGE(PG8_SB(1, 0), cB + kstep, voffB); PG8_STAGE_A(PG8_SA(1, 0), cA + kstep, 0, false); PG8_STAGE(PG8_SB(1, 1), cB + hstep + kstep, voffB);
        PG8_WAIT_V(6); PG8_BAR;
    } else {
        PG8_STAGE(PG8_SB(0, 0), cB, voffB); PG8_STAGE_A(PG8_SA(0, 0), cA, 0, false); PG8_STAGE(PG8_SB(0, 1), cB + hstep, voffB); PG8_STAGE_A(PG8_SA(0, 1), cA, 1, false);
        if (wr == 1) PG8_BAR;
        PG8_WAIT_V(4); PG8_BAR;
        PG8_STAGE(PG8_SB(1, 0), cB + kstep, voffB); PG8_STAGE_A(PG8_SA(1, 0), cA + kstep, 0, false); PG8_STAGE(PG8_SB(1, 1), cB + hstep + kstep, voffB);
        PG8_WAIT_V(6); PG8_BAR;
    }
    for (;;) {
        const bool has_next = S.next(ui + 1, nxt);
        if constexpr (GATHER) { if (has_next) { PG8_GOFF(vgn, nxt); } else { _Pragma("unroll") for (int h_ = 0; h_ < 2; ++h_) _Pragma("unroll") for (int i_ = 0; i_ < 2; ++i_) vgn[h_][i_] = vgc[h_][i_]; } }
        const char* nA = (has_next && !GATHER) ? (const char*)g.A + (size_t)nxt.pm * tstep : cA; const char* nB = has_next ? (const char*)g.Bt + (size_t)nxt.pb * tstep : cB;
#pragma nounroll
        for (int t = 0; t < nt; t += 2) {
            const bool last = (t == nt - 2);
            const char* a1 = cA + (size_t)(t + 1) * kstep;
            const char* a2 = last ? nA : cA + (size_t)(t + 2) * kstep; const char* b2 = last ? nB : cB + (size_t)(t + 2) * kstep;
            const char* a3 = a2 + kstep; const char* b3 = b2 + kstep;
            if (last && has_next) S.a_ready(nxt);
            if constexpr (SP2) {
            PG8_LDB(B0, 0, 0); PG8_LDB(B1, 0, 1); PG8_SCHED; PG8_LDA(At, 0, 0); PG8_STAGE_A(PG8_SA(1, 1), a1, 1, false);
            PG8_WAIT_V(8); PG8_WAIT_L(0); PG8_BAR; PG8_MMA(0, 0, At, B0); PG8_MMA(0, 1, At, B1); PG8_BAR; PG8_SCHED;
            PG8_LDA(At, 0, 1); PG8_STAGE(PG8_SB(0, 0), b2, voffB); PG8_STAGE(PG8_SB(0, 1), b2 + hstep, voffB); PG8_STAGE_A(PG8_SA(0, 0), a2, 0, last);
            PG8_WAIT_V(8); PG8_WAIT_L(0); PG8_BAR; PG8_MMA(1, 0, At, B0); PG8_MMA(1, 1, At, B1); PG8_BAR; PG8_SCHED;
            PG8_LDB(B0, 1, 0); PG8_LDB(B1, 1, 1); PG8_SCHED; PG8_LDA(At, 1, 0); PG8_STAGE_A(PG8_SA(0, 1), a2, 1, last);
            PG8_WAIT_V(8); PG8_WAIT_L(0); PG8_BAR; PG8_MMA(0, 0, At, B0); PG8_MMA(0, 1, At, B1); PG8_BAR; PG8_SCHED;
            PG8_LDA(At, 1, 1); PG8_STAGE(PG8_SB(1, 0), b3, voffB); PG8_STAGE(PG8_SB(1, 1), b3 + hstep, voffB); PG8_STAGE_A(PG8_SA(1, 0), a3, 0, last);
            PG8_WAIT_V(8); PG8_WAIT_L(0); PG8_BAR; PG8_MMA(1, 0, At, B0); PG8_MMA(1, 1, At, B1); PG8_BAR; PG8_SCHED;
            } else {
            PG8_LDB(B0, 0, 0); PG8_SCHED; PG8_LDA(At, 0, 0); PG8_STAGE_A(PG8_SA(1, 1), a1, 1, false);
            PG8_WAIT_L(8); PG8_BAR; PG8_WAIT_L(0); PG8_MMA(0, 0, At, B0); PG8_BAR; PG8_SCHED;
            PG8_LDB(B1, 0, 1); PG8_STAGE(PG8_SB(0, 0), b2, voffB);
            PG8_BAR; PG8_WAIT_L(0); PG8_MMA(0, 1, At, B1); PG8_BAR;
            PG8_LDA(At, 0, 1); PG8_STAGE_A(PG8_SA(0, 0), a2, 0, last);
            PG8_BAR; PG8_WAIT_L(0); PG8_MMA(1, 0, At, B0); PG8_BAR; PG8_SCHED;
            PG8_STAGE(PG8_SB(0, 1), b2 + hstep, voffB);
            PG8_WAIT_V(6); PG8_BAR; PG8_MMA(1, 1, At, B1); PG8_BAR;
            PG8_LDB(B0, 1, 0); PG8_SCHED; PG8_LDA(At, 1, 0); PG8_STAGE_A(PG8_SA(0, 1), a2, 1, last);
            PG8_WAIT_L(8); PG8_BAR; PG8_WAIT_L(0); PG8_MMA(0, 0, At, B0); PG8_BAR; PG8_SCHED;
            PG8_LDB(B1, 1, 1); PG8_STAGE(PG8_SB(1, 0), b3, voffB);
            PG8_BAR; PG8_WAIT_L(0); PG8_MMA(0, 1, At, B1); PG8_BAR;
            PG8_LDA(At, 1, 1); PG8_STAGE_A(PG8_SA(1, 0), a3, 0, last);
            PG8_BAR; PG8_WAIT_L(0); PG8_MMA(1, 0, At, B0); PG8_BAR; PG8_SCHED;
            PG8_STAGE(PG8_SB(1, 1), b3 + hstep, voffB);
            PG8_WAIT_V(6); PG8_BAR; PG8_MMA(1, 1, At, B1); PG8_BAR;
            }
        }
        if constexpr (ALIGN_EPI) { if (wr == 0) PG8_BAR; }
        if constexpr (FP8) asm volatile("s_nop 15\n\ts_nop 15" ::: "memory");
        if constexpr (!Epi::AFTER_DRAIN) { int fr_ = fr, fq_ = fq; asm volatile("" : "+v"(fr_), "+v"(fq_));
            E(acc, cur, wr, wc, fr_, fq_); S.done(cur); }
        if (!has_next) break;
#pragma unroll
        for (int a = 0; a < 2; ++a)
#pragma unroll
            for (int b = 0; b < 2; ++b)
#pragma unroll
                for (int m = 0; m < 4; ++m)
#pragma unroll
                    for (int n = 0; n < 2; ++n) acc[a][b][m][n] = (f32x4){0.f, 0.f, 0.f, 0.f};
        cur = nxt; cA = nA; cB = nB; ++ui;
        if constexpr (GATHER) { _Pragma("unroll") for (int h_ = 0; h_ < 2; ++h_) _Pragma("unroll") for (int i_ = 0; i_ < 2; ++i_) vgc[h_][i_] = vgn[h_][i_]; }
        if constexpr (ALIGN_EPI) { if (wr == 1) PG8_BAR; }
    }
    PG8_WAIT_V(0);
    if constexpr (!ALIGN_EPI) { if (wr == 0) PG8_BAR; }
    PG8_BAR;
    if constexpr (Epi::AFTER_DRAIN) { E.fused(acc, cur, wr, wc, fr, fq, lds, wid, lane); S.done(cur); }
#undef PG8_SA
#undef PG8_SB
#undef PG8_STAGE
#undef PG8_STAGE_A
#undef PG8_GOFF
#undef PG8_LDA
#undef PG8_LDB
#undef PG8_MMA
#undef PG8_WAIT_V
#undef PG8_WAIT_L
#undef PG8_BAR
#undef PG8_SCHED
}
}
namespace epi {
using pg8::f32x4; using pg8::u32x4; using pg8::Unit; using pg8::bf16_t; using pg8::BM; using pg8::HALF; using pg8::cvt_pk_bf16;
typedef unsigned u32x2 __attribute__((ext_vector_type(2)));
__device__ __forceinline__ float bflo(unsigned w) { return __uint_as_float(w << 16); }
__device__ __forceinline__ float bfhi(unsigned w) { return __uint_as_float(w & 0xffff0000u); }
__device__ __forceinline__ float sigmoidf_fast(float z) { return __builtin_amdgcn_rcpf(1.0f + __builtin_amdgcn_exp2f(-z * LOG2E)); }

struct EpiProj {
    static constexpr bool PERM = true, AFTER_DRAIN = false;
    bf16_t* O; const float* bmerge; unsigned* nrm;
    __device__ __forceinline__ void operator()(const f32x4 (&acc)[2][2][4][2], const Unit& u, int wr, int wc, int fr, int fq) const {
        const int row0 = u.pm * BM + wr * 64 + fr, col0 = u.pn * BM + wc * 32 + 8 * fq;
        const bool isq = (u.pn < 2) || (u.pn == 6) || (u.pn == 7), isg = (u.pn >= 12);
        const float sc = isq ? QSCALE : 1.0f; const bool isn = (u.pn < 4); float nmx[2] = {0.f, 0.f};
        f32x4 bv[2][2];
#pragma unroll
        for (int bj = 0; bj < 2; ++bj)
#pragma unroll
            for (int n = 0; n < 2; ++n) bv[bj][n] = isg ? *(const f32x4*)(bmerge + (col0 - PC_G) + bj * HALF + 4 * n) : (f32x4){0.f, 0.f, 0.f, 0.f};
#pragma unroll
        for (int ai = 0; ai < 2; ++ai)
#pragma unroll
            for (int m = 0; m < 4; ++m) { bf16_t* rowp = O + (size_t)(row0 + ai * HALF + m * 16) * NPROJ + col0;
#pragma unroll
                for (int bj = 0; bj < 2; ++bj) { f32x4 v0 = acc[ai][bj][m][0], v1 = acc[ai][bj][m][1];
                    if (isg) { v0 = v0 + bv[bj][0]; v1 = v1 + bv[bj][1];
#pragma unroll
                        for (int e = 0; e < 4; ++e) { v0[e] = sigmoidf_fast(v0[e]); v1[e] = sigmoidf_fast(v1[e]); } }
                    else { v0 = v0 * sc; v1 = v1 * sc; }
                    if (isn) { float ss = (v0[0] * v0[0] + v0[1] * v0[1]) + (v0[2] * v0[2] + v0[3] * v0[3]) + (v1[0] * v1[0] + v1[1] * v1[1]) + (v1[2] * v1[2] + v1[3] * v1[3]);
                        ss += __shfl_xor(ss, 16); ss += __shfl_xor(ss, 32); nmx[bj] = fmaxf(nmx[bj], ss); }
                    u32x4 w; w.x = cvt_pk_bf16(v0[0], v0[1]); w.y = cvt_pk_bf16(v0[2], v0[3]); w.z = cvt_pk_bf16(v1[0], v1[1]); w.w = cvt_pk_bf16(v1[2], v1[3]);
                    *(u32x4*)(rowp + bj * HALF) = w; } }
        if (isn) {
#pragma unroll
            for (int bj = 0; bj < 2; ++bj) { float v = nmx[bj]; v = fmaxf(v, __shfl_xor(v, 1)); v = fmaxf(v, __shfl_xor(v, 2)); v = fmaxf(v, __shfl_xor(v, 4)); v = fmaxf(v, __shfl_xor(v, 8));
                if (fr == 0 && fq == 0) atomicMax(nrm + ((((u.pn >> 1) * 2 + (u.pm * BM) / SEQ) * 8 + 4 * (u.pn & 1) + 2 * bj + (wc >> 1)) * 2 + (wc & 1)), __float_as_uint(v)); } }
    }
};
template <int MODE> struct EpiBranch {
    static constexpr bool PERM = true, AFTER_DRAIN = false;
    const bf16_t* PROJ; const bf16_t* T1in; bf16_t* O;
    __device__ __forceinline__ void operator()(const f32x4 (&acc)[2][2][4][2], const Unit& u, int wr, int wc, int fr, int fq) const {
        const int row0 = u.pm * BM + wr * 64 + fr, col0 = u.pn * BM + wc * 32 + 8 * fq;
#pragma unroll
        for (int ai = 0; ai < 2; ++ai) { u32x4 gg[4][2], tt[4][2];
#pragma unroll
            for (int m = 0; m < 4; ++m)
#pragma unroll
                for (int bj = 0; bj < 2; ++bj) { const size_t row = (size_t)(row0 + ai * HALF + m * 16); const int col = col0 + bj * HALF;
                    gg[m][bj] = *(const u32x4*)(PROJ + row * NPROJ + PC_G + MODE * 1024 + col); if (MODE == 1) tt[m][bj] = *(const u32x4*)(T1in + row * DM + col); }
            asm volatile("" ::: "memory");
#pragma unroll
            for (int m = 0; m < 4; ++m)
#pragma unroll
                for (int bj = 0; bj < 2; ++bj) { const size_t row = (size_t)(row0 + ai * HALF + m * 16); const int col = col0 + bj * HALF; const u32x4 g = gg[m][bj];
                    f32x4 v0 = acc[ai][bj][m][0], v1 = acc[ai][bj][m][1];
                    v0[0] *= bflo(g.x); v0[1] *= bfhi(g.x); v0[2] *= bflo(g.y); v0[3] *= bfhi(g.y); v1[0] *= bflo(g.z); v1[1] *= bfhi(g.z); v1[2] *= bflo(g.w); v1[3] *= bfhi(g.w);
                    if (MODE == 1) { const u32x4 t = tt[m][bj];
                        v0[0] += bflo(t.x); v0[1] += bfhi(t.x); v0[2] += bflo(t.y); v0[3] += bfhi(t.y); v1[0] += bflo(t.z); v1[1] += bfhi(t.z); v1[2] += bflo(t.w); v1[3] += bfhi(t.w); }
                    u32x4 w; w.x = cvt_pk_bf16(v0[0], v0[1]); w.y = cvt_pk_bf16(v0[2], v0[3]); w.z = cvt_pk_bf16(v1[0], v1[1]); w.w = cvt_pk_bf16(v1[2], v1[3]);
                    *(u32x4*)(O + row * DM + col) = w; }
            asm volatile("" ::: "memory"); }
    }
};
struct EpiWo {
    static constexpr bool PERM = true, AFTER_DRAIN = false;
    const float* x; const float* mod; bf16_t* X1;
    __device__ __forceinline__ void operator()(const f32x4 (&acc)[2][2][4][2], const Unit& u, int wr, int wc, int fr, int fq) const {
        const int row0 = u.pm * BM + wr * 64 + fr, col0 = u.pn * BM + wc * 32 + 8 * fq;
        const float* g1 = mod + (size_t)((u.pm * BM) / SEQ) * (6 * DM) + 2 * DM;
        f32x4 gv[2][2];
#pragma unroll
        for (int bj = 0; bj < 2; ++bj)
#pragma unroll
            for (int n = 0; n < 2; ++n) gv[bj][n] = *(const f32x4*)(g1 + col0 + bj * HALF + n * 4);
#pragma unroll
        for (int ai = 0; ai < 2; ++ai)
#pragma unroll
          for (int mh = 0; mh < 2; ++mh) { f32x4 xv[2][2][2];
#pragma unroll
            for (int m2 = 0; m2 < 2; ++m2)
#pragma unroll
                for (int bj = 0; bj < 2; ++bj)
#pragma unroll
                    for (int n = 0; n < 2; ++n) xv[m2][bj][n] = *(const f32x4*)(x + (size_t)(row0 + ai * HALF + (2 * mh + m2) * 16) * DM + col0 + bj * HALF + n * 4);
            asm volatile("" ::: "memory");
#pragma unroll
            for (int m2 = 0; m2 < 2; ++m2)
#pragma unroll
                for (int bj = 0; bj < 2; ++bj) { const f32x4 v0 = xv[m2][bj][0] + gv[bj][0] * acc[ai][bj][2 * mh + m2][0], v1 = xv[m2][bj][1] + gv[bj][1] * acc[ai][bj][2 * mh + m2][1];
                    u32x4 w; w.x = cvt_pk_bf16(v0[0], v0[1]); w.y = cvt_pk_bf16(v0[2], v0[3]); w.z = cvt_pk_bf16(v1[0], v1[1]); w.w = cvt_pk_bf16(v1[2], v1[3]);
                    *(u32x4*)(X1 + (size_t)(row0 + ai * HALF + (2 * mh + m2) * 16) * DM + col0 + bj * HALF) = w; }
            asm volatile("" ::: "memory"); }
    }
};
struct EpiUp {
    static constexpr bool PERM = true, AFTER_DRAIN = false;
    const float* bup; unsigned char* ACT;
    __device__ __forceinline__ float act1(float a, float b) const {
        const float glu = fminf(a, 7.0f), lin = fminf(fmaxf(b, -7.0f), 7.0f);
        return glu * sigmoidf_fast(1.702f * glu) * (lin + 1.0f);
    }
    __device__ __forceinline__ void operator()(const f32x4 (&acc)[2][2][4][2], const Unit& u, int wr, int wc, int fr, int fq) const {
        const int row0 = u.pm * BM + wr * 64 + fr, col0 = u.pn * BM + wc * 32 + 8 * fq;
        const float* bb = bup + (size_t)u.e * NUP;
        f32x4 bv[2][2];
#pragma unroll
        for (int bj = 0; bj < 2; ++bj)
#pragma unroll
            for (int n = 0; n < 2; ++n) bv[bj][n] = *(const f32x4*)(bb + col0 + bj * HALF + 4 * n);
#pragma unroll
        for (int ai = 0; ai < 2; ++ai)
#pragma unroll
            for (int m = 0; m < 4; ++m) { unsigned char* rowp = ACT + (size_t)(row0 + ai * HALF + m * 16) * DFF + (col0 >> 1);
#pragma unroll
                for (int bj = 0; bj < 2; ++bj) { const f32x4 v0 = acc[ai][bj][m][0] + bv[bj][0], v1 = acc[ai][bj][m][1] + bv[bj][1];
                    int w = 0; w = __builtin_amdgcn_cvt_pk_fp8_f32(act1(v0[0], v0[1]), act1(v0[2], v0[3]), w, false); w = __builtin_amdgcn_cvt_pk_fp8_f32(act1(v1[0], v1[1]), act1(v1[2], v1[3]), w, true);
                    *(unsigned*)(rowp + bj * (HALF / 2)) = (unsigned)w; } }
    }
};
struct EpiDown {
    static constexpr bool PERM = true, AFTER_DRAIN = false;
    const float* bdn; const float* sgate; bf16_t* YP;
    __device__ __forceinline__ void operator()(const f32x4 (&acc)[2][2][4][2], const Unit& u, int wr, int wc, int fr, int fq) const {
        const int row0 = u.pm * BM + wr * 64 + fr, col0 = u.pn * BM + wc * 32 + 8 * fq;
        const float* bb = bdn + (size_t)u.e * DM;
        f32x4 bv[2][2]; float gts[2][4];
#pragma unroll
        for (int bj = 0; bj < 2; ++bj)
#pragma unroll
            for (int n = 0; n < 2; ++n) bv[bj][n] = *(const f32x4*)(bb + col0 + bj * HALF + 4 * n);
#pragma unroll
        for (int ai = 0; ai < 2; ++ai)
#pragma unroll
            for (int m = 0; m < 4; ++m) gts[ai][m] = sgate[(size_t)u.ar + (wr * 64 + fr + ai * HALF + m * 16)];
#pragma unroll
        for (int ai = 0; ai < 2; ++ai)
#pragma unroll
            for (int m = 0; m < 4; ++m) { const size_t row = (size_t)(row0 + ai * HALF + m * 16); const float gt = gts[ai][m]; bf16_t* rowp = YP + row * DM + col0;
#pragma unroll
                for (int bj = 0; bj < 2; ++bj) { const f32x4 v0 = (acc[ai][bj][m][0] + bv[bj][0]) * gt, v1 = (acc[ai][bj][m][1] + bv[bj][1]) * gt;
                    u32x4 w; w.x = cvt_pk_bf16(v0[0], v0[1]); w.y = cvt_pk_bf16(v0[2], v0[3]); w.z = cvt_pk_bf16(v1[0], v1[1]); w.w = cvt_pk_bf16(v1[2], v1[3]);
                    *(u32x4*)(rowp + bj * HALF) = w; } }
    }
};
struct ListOrder {
    const PG8_LAS int* lst; int n;
    __device__ __forceinline__ bool next(int i, Unit& u) const { if (i >= n) return false; u.pm = __builtin_amdgcn_readfirstlane(lst[6 * i]); u.pn = __builtin_amdgcn_readfirstlane(lst[6 * i + 1]); u.pb = __builtin_amdgcn_readfirstlane(lst[6 * i + 2]); u.e = __builtin_amdgcn_readfirstlane(lst[6 * i + 3]);
        u.ar = __builtin_amdgcn_readfirstlane(lst[6 * i + 4]); u.nr = __builtin_amdgcn_readfirstlane(lst[6 * i + 5]); u.md = 0; return true; }
    __device__ __forceinline__ void a_ready(const Unit&) const {}
    __device__ __forceinline__ void done(const Unit&) const {}
};
}
constexpr size_t MiB = 1u << 20;
constexpr int ECAP = 16384;
constexpr size_t WS_CTL = 0, CTL_ZERO_BYTES = 1 * MiB;
constexpr size_t WS_MOD = 1 * MiB;
constexpr size_t WS_SCAL = WS_MOD + 64 * 1024;
constexpr size_t WS_LUT = WS_MOD + 128 * 1024;
constexpr size_t WS_BT = WS_MOD + 256 * 1024;
constexpr size_t WS_FLOC = 2 * MiB;
constexpr size_t WS_F2 = 3 * MiB;
constexpr size_t WS_TOPE = 4 * MiB, WS_RANK = WS_TOPE + 256 * 1024, WS_GATE = WS_RANK + 256 * 1024, WS_SLOT = WS_GATE + 256 * 1024;
constexpr size_t WS_SGATE = 5 * MiB;
constexpr size_t WS_WIN = 6 * MiB;
constexpr size_t WS_WBF = 16 * MiB, WS_WBD = 17 * MiB, WS_WO = 18 * MiB;
constexpr size_t WS_WUP = 20 * MiB;
constexpr size_t WS_WDN = 148 * MiB;
constexpr size_t WS_XN = 212 * MiB;
constexpr size_t WS_PROJ = 244 * MiB;
constexpr size_t WS_XG = WS_PROJ;
constexpr size_t WS_YFOX = 404 * MiB;
constexpr size_t WS_OD = 420 * MiB;
constexpr size_t WS_YD = 452 * MiB;
constexpr size_t WS_T1 = 468 * MiB;
constexpr size_t WS_MRG = 500 * MiB;
constexpr size_t WS_ACT = WS_PROJ;
constexpr size_t WS_YP = WS_YFOX;
constexpr size_t WS_X1B = 548 * MiB;
constexpr size_t WS_KA = 820 * MiB;
constexpr size_t WS_IDX = 822 * MiB;
constexpr size_t WS_GX = 824 * MiB;
constexpr size_t WS_END = 826 * MiB;
static_assert(WS_PROJ + (size_t)M * NPROJ * 2 <= WS_YFOX && WS_ACT + (size_t)PMAX * DM * 2 <= WS_YFOX && WS_MRG + (size_t)M * DM * 2 <= WS_YP + (size_t)PMAX * DM * 2 && WS_YP + (size_t)PMAX * DM * 2 <= WS_KA, "d_ws map");
constexpr int CW_TMO = 0;
constexpr int CW_CNT = 1024;
constexpr int CW_NRM = 3200;
constexpr int CW_BAR = 4096;
constexpr int CW_PAN = 16384;
constexpr int CW_Q = 8192;

constexpr int RING_OFF = 0, RING_BYTES = 131072;
constexpr int LDSCTL_OFF = RING_BYTES, MISC_OFF = LDSCTL_OFF + 320;
constexpr int TAB_OFF = LDSCTL_OFF + 1024;
constexpr int LDS_BYTES = 147456;
constexpr int NWAVES = 8;
#define GAS __attribute__((address_space(1)))
#define LAS __attribute__((address_space(3)))
typedef unsigned short bf16;
typedef unsigned v4u __attribute__((ext_vector_type(4)));
typedef float f32x4 __attribute__((ext_vector_type(4)));
typedef short bf16x8 __attribute__((ext_vector_type(8)));
typedef GAS unsigned gu32;
typedef GAS unsigned long long gu64;
#define RLX_AGENT __ATOMIC_RELAXED, __HIP_MEMORY_SCOPE_AGENT
#define LDS_WAIT() asm volatile("s_waitcnt lgkmcnt(0)" ::: "memory")
#define VM_WAIT() asm volatile("s_waitcnt vmcnt(0)" ::: "memory")
__device__ __forceinline__ unsigned long long rt() { return __builtin_amdgcn_s_memrealtime(); }
__device__ __forceinline__ unsigned f2bf(float f) { unsigned u = __builtin_bit_cast(unsigned, f); return (u + 0x7fffu + ((u >> 16) & 1u)) >> 16; }
__device__ __forceinline__ unsigned pk2(float lo, float hi) { return f2bf(lo) | (f2bf(hi) << 16); }

#define XB_TMO      128
#define XB_XCNT(j)  (256  + 64 * (j))
#define XB_XSUB(j)  (1280 + 64 * (j))
#define XB_XGEN(j)  (2304 + 64 * (j))
#define XB_TOP      3328
#define XB_TOPGEN   3392
#define XCD_BAR_WORDS 3456
#define XB_SPIN_CAP (1u << 18)

__device__ __forceinline__ unsigned xb_ld(unsigned* p)              { return __hip_atomic_load(p, __ATOMIC_RELAXED, __HIP_MEMORY_SCOPE_AGENT); }
__device__ __forceinline__ unsigned xb_add(unsigned* p, unsigned v) { return __hip_atomic_fetch_add(p, v, __ATOMIC_RELAXED, __HIP_MEMORY_SCOPE_AGENT); }
__device__ __forceinline__ unsigned xb_xcc_id() { return (unsigned)__builtin_amdgcn_s_getreg((3 << 11) | 20) & 0xFu; }
#define XB_SPIN(cond, bar) do { unsigned _sp = 0; while (cond) { __builtin_amdgcn_s_sleep(1); \
    if ((++_sp & 255u) == 0u) { if (xb_ld(&(bar)[XB_TMO])) break; if (_sp > XB_SPIN_CAP) { atomicAdd(&(bar)[XB_TMO], 1u); break; } } } } while (0)

struct XcdBarrier {
    unsigned* bar; unsigned x;
    volatile LAS unsigned* st;
};

__device__ __forceinline__ XcdBarrier xcd_barrier_post(unsigned* bar, volatile LAS unsigned* st) {
    XcdBarrier b; b.bar = bar; b.x = xb_xcc_id(); b.st = st;
    if (threadIdx.x == 0) (void)xb_add(&bar[XB_XCNT(b.x)], 1u);
    return b;
}
__device__ __forceinline__ void xcd_barrier_complete(unsigned* bar, unsigned x, unsigned& nloc, unsigned& nx) {
    const unsigned G = gridDim.x * gridDim.y * gridDim.z;
    unsigned sum, cnt, mine, sp = 0u;
    for (;;) {
        sum = 0u; cnt = 0u; mine = 0u;
#pragma unroll
        for (unsigned j = 0; j < 16; ++j) { const unsigned c = xb_ld(&bar[XB_XCNT(j)]); sum += c; cnt += (c > 0u) ? 1u : 0u; mine = (j == x) ? c : mine; }
        if (sum == G) break;
        __builtin_amdgcn_s_sleep(1);
        if ((++sp & 255u) == 0u) { if (xb_ld(&bar[XB_TMO])) break; if (sp > XB_SPIN_CAP) { atomicAdd(&bar[XB_TMO], 1u); break; } }
    }
    nloc = mine > 0u ? mine : 1u; nx = cnt > 0u ? cnt : 1u;
}

__device__ __forceinline__ void xcd_barrier(const XcdBarrier& b) {
    asm volatile("s_waitcnt vmcnt(0)" ::: "memory");
    __syncthreads();
    if (threadIdx.x == 0) {
        unsigned* bar = b.bar;
        __builtin_amdgcn_s_waitcnt(0);
        unsigned nloc = b.st[0], nx = b.st[1];
        if (nloc == 0u) { xcd_barrier_complete(bar, b.x, nloc, nx); b.st[0] = nloc; b.st[1] = nx; }
        const unsigned old = xb_add(&bar[XB_XSUB(b.x)], 1u);
        const unsigned gen = old / nloc;
        if (old + 1u == (gen + 1u) * nloc) {
            __builtin_amdgcn_fence(__ATOMIC_RELEASE, "agent");
            asm volatile("s_waitcnt vmcnt(0)" ::: "memory");
            const unsigned og = xb_add(&bar[XB_TOP], 1u);
            const unsigned tg = og / nx;
            if (og + 1u == (tg + 1u) * nx) xb_add(&bar[XB_TOPGEN], 1u);
            else XB_SPIN(xb_ld(&bar[XB_TOPGEN]) == tg, bar);
            __builtin_amdgcn_fence(__ATOMIC_ACQUIRE, "agent");
            xb_add(&bar[XB_XGEN(b.x)], 1u);
            asm volatile("s_waitcnt vmcnt(0)" ::: "memory");
        } else {
            XB_SPIN(xb_ld(&bar[XB_XGEN(b.x)]) == gen, bar);
            __builtin_amdgcn_fence(__ATOMIC_ACQUIRE, "agent");
            asm volatile("s_waitcnt vmcnt(0)" ::: "memory");
        }
    }
    __syncthreads();
}
#include <hip/hip_bf16.h>
#include <cmath>
namespace attn_body {
using bf16=__hip_bfloat16;
using bf16x8=__attribute__((ext_vector_type(8)))short;
using s16x4=__attribute__((ext_vector_type(4)))short;
using f32x16=__attribute__((ext_vector_type(16)))float;
using u32x4=__attribute__((ext_vector_type(4)))unsigned;
using f32x4_t=__attribute__((ext_vector_type(4)))float;
constexpr int D=64,PITCH=NPROJ;
constexpr int NW=8,QBLK=32,QB=QBLK*NW,KVBLK=64,NQB=SEQ/QB;
constexpr int ATTN_UNIT_ROWS=QB;
__device__ __forceinline__ int crow(int r,int hi){return (r&3)+8*(r>>2)+4*hi;}
#define SBAR() __builtin_amdgcn_sched_barrier(0)
__device__ __forceinline__ void cmask(f32x16&p0,f32x16&p1,int jb,int qrel,int hi){
  const float NEG=-INFINITY; int kb=64*jb+4*hi;
  #pragma unroll
  for(int r=0;r<16;++r){int kv=kb+(r&3)+8*(r>>2); if(kv>qrel)p0[r]=NEG; if(kv+32>qrel)p1[r]=NEG;}
}

constexpr int NSLOT=3, SLOTB=9216;
constexpr int LDS_K=0, LDS_V=NSLOT*SLOTB, LDS_WS=2*NSLOT*SLOTB, LDS_OST=LDS_WS+NW*64*4, LDS_BYTES=LDS_OST+NW*4096;
constexpr int LDS_LUT=104448, LUTN=644, LDS_TOTAL=LDS_LUT+4*LUTN*4;
static_assert(LDS_TOTAL<=131072 && LDS_LUT%16==0 && LDS_LUT>=LDS_BYTES, "attention LDS map");
constexpr float C2=0.125f*1.4426950408889634f;
__device__ __forceinline__ void glds16(const void*gsrc,unsigned lds_dst){unsigned keep;
  asm volatile("s_mov_b32 %0, m0\n\ts_mov_b32 m0, %2\n\ts_nop 0\n\tglobal_load_lds_dwordx4 %1, off\n\ts_mov_b32 m0, %0":"=&s"(keep):"v"(gsrc),"s"(lds_dst):"memory");}
__device__ __forceinline__ float max3f(float a,float b,float c){float r;asm("v_max3_f32 %0, %1, %2, %3":"=v"(r):"v"(a),"v"(b),"v"(c));return r;}
__device__ __forceinline__ float max2f(float a,float b){float r;asm("v_max_f32_e32 %0, %1, %2":"=v"(r):"v"(a),"v"(b));return r;}
__device__ __forceinline__ float fadd_s(float a,float b){float r;asm("v_add_f32_e32 %0, %1, %2":"=v"(r):"v"(a),"v"(b));return r;}
__device__ __forceinline__ float fsub_s(float a,float b){float r;asm("v_sub_f32_e32 %0, %1, %2":"=v"(r):"v"(a),"v"(b));return r;}
typedef float f32x2_t __attribute__((ext_vector_type(2))); typedef __bf16 bf16x2_t __attribute__((ext_vector_type(2)));
__device__ __forceinline__ unsigned cvtpk_s(float lo,float hi){f32x2_t v={lo,hi};bf16x2_t b=__builtin_convertvector(v,bf16x2_t);return __builtin_bit_cast(unsigned,b);}
#define WAIT_BAR(N) asm volatile("s_waitcnt vmcnt(" #N ") lgkmcnt(0)\n\ts_barrier":::"memory")

__device__ __forceinline__ void qkt(f32x16&p0,f32x16&p1,const char*Kslot,const bf16x8*qr,const f32x16&c0,const f32x16&c1,int r32,int hi){
  const char*kb=Kslot+hi*1024+r32*16;
  #pragma unroll
  for(int d0=0;d0<4;++d0){
    const bf16x8 b0=*reinterpret_cast<const bf16x8*>(kb+d0*2048);
    const bf16x8 b1=*reinterpret_cast<const bf16x8*>(kb+d0*2048+512);
    if(d0==0){p0=__builtin_amdgcn_mfma_f32_32x32x16_bf16(b0,qr[0],c0,0,0,0);p1=__builtin_amdgcn_mfma_f32_32x32x16_bf16(b1,qr[0],c1,0,0,0);}
    else{p0=__builtin_amdgcn_mfma_f32_32x32x16_bf16(b0,qr[d0],p0,0,0,0);p1=__builtin_amdgcn_mfma_f32_32x32x16_bf16(b1,qr[d0],p1,0,0,0);}}
}
__device__ __forceinline__ bf16x8 make_qaug(float v,int hi){
  const unsigned h=cvtpk_s(v,0.f)&0xffffu; const float r1=v-__uint_as_float(h<<16);
  const unsigned m=cvtpk_s(r1,0.f)&0xffffu; const float r2=r1-__uint_as_float(m<<16);
  const unsigned l=cvtpk_s(r2,0.f)&0xffffu;
  u32x4 w; w.x=0x3F803F80u; w.y=0x3F80u|(h<<16); w.z=m|(l<<16); w.w=0u; if(hi){w.x=0u;w.y=0u;w.z=0u;}
  return __builtin_bit_cast(bf16x8,w);
}
typedef __attribute__((address_space(3))) const char* lds_cptr;
typedef short v4i16_t __attribute__((ext_vector_type(4)));
__device__ __forceinline__ void kload8(bf16x8*kf,lds_cptr kp){
  kf[0]=*(const __attribute__((address_space(3))) bf16x8*)(kp);      kf[1]=*(const __attribute__((address_space(3))) bf16x8*)(kp+512);
  kf[2]=*(const __attribute__((address_space(3))) bf16x8*)(kp+2048); kf[3]=*(const __attribute__((address_space(3))) bf16x8*)(kp+2560);
  kf[4]=*(const __attribute__((address_space(3))) bf16x8*)(kp+4096); kf[5]=*(const __attribute__((address_space(3))) bf16x8*)(kp+4608);
  kf[6]=*(const __attribute__((address_space(3))) bf16x8*)(kp+6144); kf[7]=*(const __attribute__((address_space(3))) bf16x8*)(kp+6656);
}
__device__ __forceinline__ void kload2(bf16x8*kf,lds_cptr kp,int j){ kf[2*j]=*(const __attribute__((address_space(3))) bf16x8*)(kp+j*2048); kf[2*j+1]=*(const __attribute__((address_space(3))) bf16x8*)(kp+j*2048+512); }
__device__ __forceinline__ s16x4 vtr(lds_cptr p){ return __builtin_bit_cast(s16x4,__builtin_amdgcn_ds_read_tr16_b64_v4i16((__attribute__((address_space(3))) v4i16_t*)p)); }
__device__ __forceinline__ float rowmax(const f32x16&p0,const f32x16&p1){
  float a=max3f(p0[0],p0[1],p1[0]),b=max3f(p0[2],p0[3],p1[1]);a=max3f(a,p1[2],p1[3]);
  #pragma unroll
  for(int r=4;r<16;r+=4){a=max3f(a,p0[r],p0[r+1]);b=max3f(b,p0[r+2],p0[r+3]);a=max3f(a,p1[r],p1[r+1]);b=max3f(b,p1[r+2],p1[r+3]);}
  const float m=max2f(a,b);
  auto rr=__builtin_amdgcn_permlane32_swap(__float_as_uint(m),__float_as_uint(m),false,false);
  return max2f(__uint_as_float(rr[0]),__uint_as_float(rr[1]));
}
__device__ __forceinline__ void pv(f32x16*o,int vb,bf16x8 pa0,bf16x8 pa1,bf16x8 pa2,bf16x8 pa3){
  #pragma unroll
  for(int d0=0;d0<2;++d0){s16x4 lo[4],hi[4];
    #pragma unroll
    for(int ks=0;ks<4;++ks){
      asm volatile("ds_read_b64_tr_b16 %0,%1 offset:%c2":"=&v"(lo[ks]):"v"(vb),"i"(d0*4096+ks*1024):"memory");
      asm volatile("ds_read_b64_tr_b16 %0,%1 offset:%c2":"=&v"(hi[ks]):"v"(vb),"i"(d0*4096+ks*1024+512):"memory");}
    asm volatile("s_waitcnt lgkmcnt(0)":::"memory");SBAR();
    #define PK(k) (bf16x8){lo[k][0],lo[k][1],lo[k][2],lo[k][3],hi[k][0],hi[k][1],hi[k][2],hi[k][3]}
    o[d0]=__builtin_amdgcn_mfma_f32_32x32x16_bf16(pa0,PK(0),o[d0],0,0,0);
    o[d0]=__builtin_amdgcn_mfma_f32_32x32x16_bf16(pa1,PK(1),o[d0],0,0,0);
    o[d0]=__builtin_amdgcn_mfma_f32_32x32x16_bf16(pa2,PK(2),o[d0],0,0,0);
    o[d0]=__builtin_amdgcn_mfma_f32_32x32x16_bf16(pa3,PK(3),o[d0],0,0,0);
    #undef PK
  }
}

#ifndef ATTN_STORE16
#define ATTN_STORE16(p,v) (*(u32x4*)(p)=(v))
#endif
template<int MODE,int THRL> __device__ __forceinline__ void attn_unit(int qb,const bf16*Qj,const bf16*__restrict__ Kj,const bf16*__restrict__ Vj,bf16*Oj,int opitch,const float*__restrict__ F2h,const bf16*__restrict__ KAh0,float twoB,int dhead,char*shm){
  int tid_=threadIdx.x; asm volatile("":"+v"(tid_));
  const int tid=tid_,lane=tid&63,r32=lane&31,hi=lane>>5; const int wid=__builtin_amdgcn_readfirstlane(tid>>6);
  const int q0=qb*QB;
  const bf16*Qw=Qj+(long)(q0+wid*QBLK)*PITCH;
  int t0=0;
  if(MODE==0){ const int NT0=(q0+QB)/KVBLK; const float fq0=F2h[q0]; const int j0=lane,j1=lane+64;
    const bool s0=(j0<NT0-4)&&(twoB+fq0-F2h[64*j0+63]<-60.f), s1=(j1<NT0-4)&&(twoB+fq0-F2h[64*j1+63]<-60.f);
    t0=(__builtin_popcountll(__ballot(s0))+__builtin_popcountll(__ballot(s1)))&~1; t0=__builtin_amdgcn_readfirstlane(t0); }
  const bf16*Kh=Kj+(long)t0*KVBLK*PITCH,*Vh=Vj+(long)t0*KVBLK*PITCH; const bf16*KAh=KAh0+(long)t0*KVBLK*8;
  const unsigned lds0=(unsigned)(uintptr_t)shm;
  float*wsf=(float*)(shm+LDS_WS)+wid*64;
  const bf16*ksrc=Kh+(long)lane*PITCH+wid*8;
  const bf16*vsrc=Vh+(long)(16*(wid&3)+(lane>>2))*PITCH+(wid>>2)*32+(lane&3)*8;
  const unsigned kdst=lds0+LDS_K+wid*1024, vdst=lds0+LDS_V+wid*1024;
  const bf16*kasrc=KAh+(long)lane*8; const unsigned kadst=lds0+LDS_K+8192;
  #define DMA_K(t,slot) do{ glds16(ksrc+(long)(t)*KVBLK*PITCH,(unsigned)__builtin_amdgcn_readfirstlane(kdst+(slot))); \
    if(MODE==0&&wid==0) glds16(kasrc+(long)(t)*KVBLK*8,(unsigned)__builtin_amdgcn_readfirstlane(kadst+(slot))); }while(0)
  #define WAITK(N0,N1) do{ if(MODE==0&&wid==0){WAIT_BAR(N1);}else{WAIT_BAR(N0);} }while(0)
  #define DMA_V(t,slot) glds16(vsrc+(long)(t)*KVBLK*PITCH,(unsigned)__builtin_amdgcn_readfirstlane(vdst+(slot)))
  const int vb0=(int)(lds0+LDS_V)+((lane>>4)&1)*32+(lane&3)*8+(4*hi+((lane&15)>>2))*64;
  const char*Kbase=shm+LDS_K; bf16x8 kf[8];
  const lds_cptr shm3=(lds_cptr)shm; const lds_cptr kp0=shm3+LDS_K+hi*1024+r32*16; const lds_cptr vp0=shm3+LDS_V+((lane>>4)&1)*32+(lane&3)*8+(4*hi+((lane&15)>>2))*64;
  const int NT=(q0+QB)/KVBLK-t0;
  const int qrel=wid*QBLK+r32;
  float qoff=0.f, mhat=0.f; bf16x8 qaug=bf16x8{}, ka0=bf16x8{}, ka1=bf16x8{};
  if(MODE==0){ qoff=F2h[q0+qrel];
    const bf16*kd=Kj+(long)(q0+qrel)*PITCH+hi*8; const bf16*qd=Qw+(long)r32*PITCH+hi*8; float dsum=0.f;
    _Pragma("unroll") for(int d0=0;d0<4;++d0){ const u32x4 kw=*reinterpret_cast<const u32x4*>(kd+d0*16), qw=*reinterpret_cast<const u32x4*>(qd+d0*16);
      _Pragma("unroll") for(int e=0;e<4;++e){ dsum+=__uint_as_float(kw[e]<<16)*__uint_as_float(qw[e]<<16)+__uint_as_float(kw[e]&0xffff0000u)*__uint_as_float(qw[e]&0xffff0000u); } }
    dsum+=__shfl_xor(dsum,32); mhat=dsum; qaug=make_qaug(qoff-mhat,hi); }
  const __attribute__((address_space(3))) float* lutr=(const __attribute__((address_space(3))) float*)(shm3+LDS_LUT)+dhead*LUTN;
  DMA_K(0,0);DMA_V(0,0);DMA_K(1,SLOTB);
  bf16x8 qr[4];
  #pragma unroll
  for(int d0=0;d0<4;++d0)qr[d0]=*reinterpret_cast<const bf16x8*>(&Qw[(long)r32*PITCH+d0*16+hi*8]);
  float l_reg=0.f;f32x16 o[2];o[0]=f32x16{};o[1]=f32x16{};f32x16 negm;
  _Pragma("unroll") for(int r=0;r<16;++r)negm[r]=0.f; asm volatile("":"+v"(negm));
  #define BIAS_(P0,P1,t,NEAR_) do{ if(MODE==0){} \
    else if(NEAR_ && (t)>=NT-6){ const __attribute__((address_space(3))) float* lp_=lutr+(383-(q0-64*(t)+qrel-4*hi)); \
      _Pragma("unroll") for(int r_=0;r_<16;++r_){ P0[r_]+=lp_[(r_&3)+8*(r_>>2)]; P1[r_]+=lp_[32+(r_&3)+8*(r_>>2)]; if((r_&3)==3)SBAR(); } } }while(0)
  #define BIAS(P0,P1,t) BIAS_(P0,P1,t,true)
  #define CMASK(P0,P1,t) do{int jb_=(t)-(NT-4); if(jb_>=0)cmask(P0,P1,jb_,qrel,hi);}while(0)
  bool resc=false;
  #define START(P0,P1) do{ const float rm=rowmax(P0,P1); resc=false; \
    { const float dl=rm; mhat=fadd_s(mhat,dl); \
      _Pragma("unroll") for(int r=0;r<16;++r){P0[r]=fsub_s(P0[r],dl);P1[r]=fsub_s(P1[r],dl);} \
      _Pragma("unroll") for(int r=0;r<16;++r)negm[r]=-mhat; asm volatile("":"+v"(negm)); } \
    _Pragma("unroll") for(int r=0;r<16;++r)P0[r]=__builtin_amdgcn_exp2f(P0[r]); }while(0)
  #define RESC() do{ if(resc){ asm volatile("s_waitcnt lgkmcnt(0)":::"memory"); \
      _Pragma("unroll") for(int d_=0;d_<2;++d_) _Pragma("unroll") for(int r=0;r<16;++r)o[d_][r]*=wsf[crow(r,hi)]; } }while(0)
  f32x16 pA0,pA1,pB0,pB1;
  #define MX3_(a,b,c) __builtin_fmaxf(__builtin_fmaxf((a),(b)),(c))
  int sl_prev=0,sl_cur=0,sl_next=SLOTB;
  #define ROT() do{sl_prev=sl_cur;sl_cur=sl_next;sl_next=(sl_next==(NSLOT-1)*SLOTB)?0:sl_next+SLOTB;}while(0)
  DMA_K(2,2*SLOTB);
  WAITK(3,5);
  const lds_cptr kap0=shm3+LDS_K+8192+r32*16;
  #define KALD(sl) do{ ka0=*(const __attribute__((address_space(3))) bf16x8*)(kap0+(sl)); ka1=*(const __attribute__((address_space(3))) bf16x8*)(kap0+(sl)+512); }while(0)
  if(MODE==0){ KALD(0); const f32x16 z16=f32x16{};
    const f32x16 a0=__builtin_amdgcn_mfma_f32_32x32x16_bf16(ka0,qaug,z16,0,0,0), a1=__builtin_amdgcn_mfma_f32_32x32x16_bf16(ka1,qaug,z16,0,0,0);
    qkt(pA0,pA1,Kbase,qr,a0,a1,r32,hi); CMASK(pA0,pA1,0);
    { float a=MX3_(pA0[0],pA0[1],pA1[0]),b=MX3_(pA0[2],pA0[3],pA1[1]); a=MX3_(a,pA1[2],pA1[3]);
      _Pragma("unroll") for(int r=4;r<16;r+=4){a=MX3_(a,pA0[r],pA0[r+1]);b=MX3_(b,pA0[r+2],pA0[r+3]);a=MX3_(a,pA1[r],pA1[r+1]);b=MX3_(b,pA1[r+2],pA1[r+3]);}
      float rm=__builtin_fmaxf(a,b); { auto rr=__builtin_amdgcn_permlane32_swap(__float_as_uint(rm),__float_as_uint(rm),false,false); rm=__builtin_fmaxf(__uint_as_float(rr[0]),__uint_as_float(rr[1])); }
      if(__any(rm>(float)THRL)){ const float dl=__builtin_fmaxf(rm,0.f); mhat+=dl; _Pragma("unroll") for(int r=0;r<16;++r){pA0[r]-=dl;pA1[r]-=dl;} qaug=make_qaug(qoff-mhat,hi); } }
    _Pragma("unroll") for(int r=0;r<16;++r)pA0[r]=__builtin_amdgcn_exp2f(pA0[r]);
  } else {
  qkt(pA0,pA1,Kbase,qr,negm,negm,r32,hi);asm volatile("s_nop 15\n\ts_nop 7":"+v"(pA0),"+v"(pA1));BIAS(pA0,pA1,0);CMASK(pA0,pA1,0);
  START(pA0,pA1);
  }
  _Pragma("unroll") for(int r=0;r<16;++r)pA1[r]=__builtin_amdgcn_exp2f(pA1[r]);
  WAIT_BAR(0);
  DMA_K(3,0);DMA_V(1,SLOTB);
  ROT();
  kload8(kf,kp0+sl_cur); if(MODE==0)KALD(sl_cur);
  WAITK(2,3);
  s16x4 vlo[8],vhi[8]; u32x4 pw0,pw1,pw2,pw3;
  #define PKW(P,B) cvtpk_s(P[B],P[B+1])
  #define PAF(k) __builtin_bit_cast(bf16x8,pw##k)
  #define VFR(i) (bf16x8){vlo[i][0],vlo[i][1],vlo[i][2],vlo[i][3],vhi[i][0],vhi[i][1],vhi[i][2],vhi[i][3]}
  #define PIN(x) asm volatile("":"+v"(x))
  #define MX3(a,b,c) __builtin_fmaxf(__builtin_fmaxf((a),(b)),(c))
  #define GAPA(MF,A0,A1,A2,A3,W0,W1,PW) do{ MF; sacc+=A0; sacc+=A1; sacc+=A2; sacc+=A3; PIN(sacc); W0; W1; PIN(PW); SBAR(); }while(0)
  #define EX(v) __builtin_amdgcn_exp2f(v)
  #define GAPB(MF,X,B) do{ MF; X[B]=EX(X[B]); X[B+1]=EX(X[B+1]); X[B+2]=EX(X[B+2]); X[B+3]=EX(X[B+3]); PIN(X); SBAR(); }while(0)
  #define VRD(i) do{ vlo[i]=vtr(vp_+(((i)>>2)*4096+((i)&3)*1024)); vhi[i]=vtr(vp_+(((i)>>2)*4096+((i)&3)*1024+512)); }while(0)
  #define KRD(G,j) do{ if(G){ kload2(kf,kp0+sl_next,j); if(MODE==0&&(j)==0)KALD(sl_next); SBAR(); } }while(0)
  #define STEP(C0,C1,P0,P1,t,GK,GV,GL) do{ SBAR(); \
    if(MODE==0){ const f32x16 z16_=f32x16{}; C0=__builtin_amdgcn_mfma_f32_32x32x16_bf16(ka0,qaug,z16_,0,0,0); C1=__builtin_amdgcn_mfma_f32_32x32x16_bf16(ka1,qaug,z16_,0,0,0); SBAR(); } \
    const lds_cptr vp_=vp0+sl_prev; \
    VRD(0); SBAR(); float sacc=(P0[0]+P0[1]); \
    GAPA(C0=__builtin_amdgcn_mfma_f32_32x32x16_bf16(kf[0],qr[0],(MODE==0?C0:negm),0,0,0), P0[2],P0[3],P0[4],P0[5],     pw0[0]=PKW(P0,0), pw0[1]=PKW(P0,2), pw0); \
    VRD(4); SBAR(); GAPA(C1=__builtin_amdgcn_mfma_f32_32x32x16_bf16(kf[1],qr[0],(MODE==0?C1:negm),0,0,0), P0[6],P0[7],P0[8],P0[9],     pw0[2]=PKW(P0,4), pw0[3]=PKW(P0,6), pw0); \
    VRD(1); SBAR(); GAPA(C0=__builtin_amdgcn_mfma_f32_32x32x16_bf16(kf[2],qr[1],C0,0,0,0),   P0[10],P0[11],P0[12],P0[13], pw1[0]=PKW(P0,8), pw1[1]=PKW(P0,10), pw1); \
    VRD(5); SBAR(); GAPA(C1=__builtin_amdgcn_mfma_f32_32x32x16_bf16(kf[3],qr[1],C1,0,0,0),   P0[14],P0[15],P1[0],P1[1],   pw1[2]=PKW(P0,12),pw1[3]=PKW(P0,14), pw1); \
    VRD(2); SBAR(); GAPA(C0=__builtin_amdgcn_mfma_f32_32x32x16_bf16(kf[4],qr[2],C0,0,0,0),   P1[2],P1[3],P1[4],P1[5],     pw2[0]=PKW(P1,0), pw2[1]=PKW(P1,2), pw2); \
    VRD(6); SBAR(); GAPA(C1=__builtin_amdgcn_mfma_f32_32x32x16_bf16(kf[5],qr[2],C1,0,0,0),   P1[6],P1[7],P1[8],P1[9],     pw2[2]=PKW(P1,4), pw2[3]=PKW(P1,6), pw2); \
    VRD(3); SBAR(); GAPA(C0=__builtin_amdgcn_mfma_f32_32x32x16_bf16(kf[6],qr[3],C0,0,0,0),   P1[10],P1[11],P1[12],P1[13], pw3[0]=PKW(P1,8), pw3[1]=PKW(P1,10), pw3); \
    VRD(7); SBAR(); GAPA(C1=__builtin_amdgcn_mfma_f32_32x32x16_bf16(kf[7],qr[3],C1,0,0,0),   P1[14],P1[15],0.f,0.f,       pw3[2]=PKW(P1,12),pw3[3]=PKW(P1,14), pw3); \
    l_reg+=sacc; \
    if(GK){DMA_K((t)+3,sl_cur);} if(GV){DMA_V((t)+1,sl_next);} \
    BIAS(C0,C1,t); CMASK(C0,C1,t); \
    { float a=MX3(C0[0],C0[1],C1[0]),b=MX3(C0[2],C0[3],C1[1]); a=MX3(a,C1[2],C1[3]); \
      _Pragma("unroll") for(int r=4;r<16;r+=4){a=MX3(a,C0[r],C0[r+1]);b=MX3(b,C0[r+2],C0[r+3]);a=MX3(a,C1[r],C1[r+1]);b=MX3(b,C1[r+2],C1[r+3]);} \
      float rm=__builtin_fmaxf(a,b); { auto rr=__builtin_amdgcn_permlane32_swap(__float_as_uint(rm),__float_as_uint(rm),false,false); rm=__builtin_fmaxf(__uint_as_float(rr[0]),__uint_as_float(rr[1])); } \
      resc=false; \
      if(__builtin_expect(__any(rm>(float)THRL),0)){ const float dl=__builtin_fmaxf(rm,0.f); mhat+=dl; \
        _Pragma("unroll") for(int r=0;r<16;++r){C0[r]-=dl;C1[r]-=dl;} \
        if(MODE==0){ qaug=make_qaug(qoff-mhat,hi); } else { _Pragma("unroll") for(int r=0;r<16;++r)negm[r]=-mhat; asm volatile("":"+v"(negm)); } \
        const float f=__builtin_amdgcn_exp2f(-dl); l_reg*=f; if(hi==0)wsf[r32]=f; resc=true; } } \
    SBAR(); \
    GAPB(o[0]=__builtin_amdgcn_mfma_f32_32x32x16_bf16(PAF(0),VFR(0),o[0],0,0,0), C0,0); \
    GAPB(o[1]=__builtin_amdgcn_mfma_f32_32x32x16_bf16(PAF(0),VFR(4),o[1],0,0,0), C0,4); \
    KRD(GL,0); GAPB(o[0]=__builtin_amdgcn_mfma_f32_32x32x16_bf16(PAF(1),VFR(1),o[0],0,0,0), C0,8); \
    KRD(GL,1); GAPB(o[1]=__builtin_amdgcn_mfma_f32_32x32x16_bf16(PAF(1),VFR(5),o[1],0,0,0), C0,12); \
    KRD(GL,2); GAPB(o[0]=__builtin_amdgcn_mfma_f32_32x32x16_bf16(PAF(2),VFR(2),o[0],0,0,0), C1,0); \
    KRD(GL,3); GAPB(o[1]=__builtin_amdgcn_mfma_f32_32x32x16_bf16(PAF(2),VFR(6),o[1],0,0,0), C1,4); \
    GAPB(o[0]=__builtin_amdgcn_mfma_f32_32x32x16_bf16(PAF(3),VFR(3),o[0],0,0,0), C1,8); \
    GAPB(o[1]=__builtin_amdgcn_mfma_f32_32x32x16_bf16(PAF(3),VFR(7),o[1],0,0,0), C1,12); \
    }while(0)
  int t=1;
  #undef CMASK
  #define CMASK(P0,P1,t) do{}while(0)
  #undef BIAS
  #define BIAS(P0,P1,t) BIAS_(P0,P1,t,false)
  for(;t+7<NT;t+=2){
    STEP(pB0,pB1,pA0,pA1,t,true,true,true);     WAITK(2,3); RESC(); ROT();
    STEP(pA0,pA1,pB0,pB1,t+1,true,true,true);   WAITK(2,3); RESC(); ROT();
  }
  #undef CMASK
  #define CMASK(P0,P1,t) do{int jb_=(t)-(NT-4); if(jb_>=0)cmask(P0,P1,jb_,qrel,hi);}while(0)
  #undef BIAS
  #define BIAS(P0,P1,t) BIAS_(P0,P1,t,true)
  #define ENDW(tt) do{ if((tt)+3<NT){WAITK(2,3);} else if((tt)+2<NT){WAIT_BAR(1);} else {WAIT_BAR(0);} }while(0)
  for(;t+1<NT;t+=2){
    STEP(pB0,pB1,pA0,pA1,t,(t+3<NT),(t+1<NT),(t+1<NT));       ENDW(t);   RESC(); ROT();
    STEP(pA0,pA1,pB0,pB1,t+1,(t+4<NT),(t+2<NT),(t+2<NT));     ENDW(t+1); RESC(); ROT();
  }
  STEP(pB0,pB1,pA0,pA1,NT-1,false,false,false); RESC();
  { float sacc=pB0[0]+pB0[1]; _Pragma("unroll") for(int r=2;r<16;++r)sacc+=pB0[r]; _Pragma("unroll") for(int r=0;r<16;++r)sacc+=pB1[r]; l_reg+=sacc;
    pw0=(u32x4){PKW(pB0,0),PKW(pB0,2),PKW(pB0,4),PKW(pB0,6)};pw1=(u32x4){PKW(pB0,8),PKW(pB0,10),PKW(pB0,12),PKW(pB0,14)};pw2=(u32x4){PKW(pB1,0),PKW(pB1,2),PKW(pB1,4),PKW(pB1,6)};pw3=(u32x4){PKW(pB1,8),PKW(pB1,10),PKW(pB1,12),PKW(pB1,14)};
    SBAR(); pv(o,vb0+sl_cur,PAF(0),PAF(1),PAF(2),PAF(3)); }
  #undef PKW
  #undef PAF
  #undef VFR
  #undef PIN
  #undef MX3
  #undef GAPA
  #undef GAPB
  #undef EX
  #undef VRD
  #undef KRD
  #undef STEP
  #undef ENDW
  {auto rr=__builtin_amdgcn_permlane32_swap(__float_as_uint(l_reg),__float_as_uint(l_reg),false,false);l_reg=__uint_as_float(rr[0])+__uint_as_float(rr[1]);}
  if(hi==0)wsf[32+r32]=l_reg;asm volatile("s_waitcnt lgkmcnt(0)":::"memory");
  float rli[16];
  #pragma unroll
  for(int r=0;r<16;++r)rli[r]=__builtin_amdgcn_rcpf(wsf[32+crow(r,hi)]);
  bf16*Ow=Oj+(long)(q0+wid*QBLK)*opitch;
  { bf16*stg=(bf16*)(shm+LDS_OST)+wid*2048;
    #pragma unroll
    for(int r=0;r<16;++r){const int orow=crow(r,hi);
      #pragma unroll
      for(int d0=0;d0<2;++d0)stg[orow*64+d0*32+r32]=__float2bfloat16(o[d0][r]*rli[r]);}
    asm volatile("s_waitcnt lgkmcnt(0)":::"memory");
    #pragma unroll
    for(int i=0;i<4;++i){const int row=i*8+(lane>>3),ch=lane&7; const u32x4 v=*(const u32x4*)(stg+row*64+ch*8); ATTN_STORE16(Ow+(long)row*opitch+ch*8,v);} }
  asm volatile("s_waitcnt lgkmcnt(0)\n\ts_barrier":::"memory");
  #undef DMA_K
  #undef WAITK
  #undef KALD
  #undef MX3_
  #undef DMA_V
  #undef CMASK
  #undef BIAS
  #undef BIAS_
  #undef START
  #undef RESC
  #undef ROT
}
constexpr int ATTN_LDS_BYTES=LDS_TOTAL;

constexpr int D1_SLK=9216, D1_SLV=16384, D1_V=4*D1_SLK, D1_WS=D1_V+4*D1_SLV, D1_END=D1_WS+NW*64*4;
static_assert(D1_END<=LDS_LUT && NW*8192<=D1_WS, "d128 attention LDS map");
template<int THRL> __device__ __forceinline__ void attn_unit_d128(int qb,const bf16*Qj,const bf16*__restrict__ Kj,const bf16*__restrict__ Vj,bf16*Oj,int opitch,int dhead,char*shm){
  int tid_=threadIdx.x; asm volatile("":"+v"(tid_));
  const int tid=tid_,lane=tid&63,r32=lane&31,hi=lane>>5; const int wid=__builtin_amdgcn_readfirstlane(tid>>6);
  const int q0=qb*QB;
  const bf16*Qw=Qj+(long)(q0+wid*QBLK)*PITCH;
  const unsigned lds0=(unsigned)(uintptr_t)shm;
  float*wsf=(float*)(shm+D1_WS)+wid*64;
  const bf16*ksrc=Kj+(long)lane*PITCH+wid*8;
  const bf16*vsrc=Vj+(long)(16*(wid&3)+(lane>>2))*PITCH+(wid>>2)*32+(lane&3)*8;
  const unsigned kdst=lds0+wid*1024, vdst=lds0+D1_V+wid*1024;
  #define DMA_K(t,si) glds16(ksrc+(long)(t)*KVBLK*PITCH,(unsigned)__builtin_amdgcn_readfirstlane(kdst+(si)*D1_SLK))
  #define DMA_V(t,si) do{ glds16(vsrc+(long)(t)*KVBLK*PITCH,(unsigned)__builtin_amdgcn_readfirstlane(vdst+(si)*D1_SLV)); \
    glds16(vsrc+(long)(t)*KVBLK*PITCH+64,(unsigned)__builtin_amdgcn_readfirstlane(vdst+(si)*D1_SLV+8192)); }while(0)
  const char*Kbase=shm; bf16x8 kf[8];
  const lds_cptr shm3=(lds_cptr)shm; const lds_cptr kp0=shm3+hi*1024+r32*16; const lds_cptr vp0=shm3+D1_V+((lane>>4)&1)*32+(lane&3)*8+(4*hi+((lane&15)>>2))*64;
  const int NT=(q0+QB)/KVBLK;
  const int qrel=wid*QBLK+r32;
  const __attribute__((address_space(3))) float* lutr=(const __attribute__((address_space(3))) float*)(shm3+LDS_LUT)+dhead*LUTN;
  DMA_K(0,0);DMA_V(0,0);DMA_K(1,1);
  bf16x8 qr[4];
  #pragma unroll
  for(int d0=0;d0<4;++d0)qr[d0]=*reinterpret_cast<const bf16x8*>(&Qw[(long)r32*PITCH+d0*16+hi*8]);
  float mhat=0.f,l_reg=0.f;f32x16 o[4];o[0]=f32x16{};o[1]=f32x16{};o[2]=f32x16{};o[3]=f32x16{};f32x16 negm;
  _Pragma("unroll") for(int r=0;r<16;++r)negm[r]=0.f; asm volatile("":"+v"(negm));
  #define BIAS_(P0,P1,t,NEAR_) do{ if(NEAR_ && (t)>=NT-6){ const __attribute__((address_space(3))) float* lp_=lutr+(383-(q0-64*(t)+qrel-4*hi)); \
      _Pragma("unroll") for(int r_=0;r_<16;++r_){ P0[r_]+=lp_[(r_&3)+8*(r_>>2)]; P1[r_]+=lp_[32+(r_&3)+8*(r_>>2)]; if((r_&3)==3)SBAR(); } } }while(0)
  #define BIAS(P0,P1,t) BIAS_(P0,P1,t,true)
  #define CMASK(P0,P1,t) do{int jb_=(t)-(NT-4); if(jb_>=0)cmask(P0,P1,jb_,qrel,hi);}while(0)
  bool resc=false;
  #define START(P0,P1) do{ const float rm=rowmax(P0,P1); resc=false; \
    { const float dl=rm; mhat=fadd_s(mhat,dl); \
      _Pragma("unroll") for(int r=0;r<16;++r){P0[r]=fsub_s(P0[r],dl);P1[r]=fsub_s(P1[r],dl);} \
      _Pragma("unroll") for(int r=0;r<16;++r)negm[r]=-mhat; asm volatile("":"+v"(negm)); } \
    _Pragma("unroll") for(int r=0;r<16;++r)P0[r]=__builtin_amdgcn_exp2f(P0[r]); }while(0)
  #define RESC() do{ if(resc){ asm volatile("s_waitcnt lgkmcnt(0)":::"memory"); \
      _Pragma("unroll") for(int d_=0;d_<4;++d_) _Pragma("unroll") for(int r=0;r<16;++r)o[d_][r]*=wsf[crow(r,hi)]; } }while(0)
  f32x16 pA0,pA1,pB0,pB1;
  int i_prev=0,i_cur=0,i_next=1;
  #define ROT() do{i_prev=i_cur;i_cur=i_next;i_next=(i_next+1)&3;}while(0)
  DMA_K(2,2);
  WAIT_BAR(4);
  qkt(pA0,pA1,Kbase,qr,negm,negm,r32,hi);asm volatile("s_nop 15\n\ts_nop 7":"+v"(pA0),"+v"(pA1));BIAS(pA0,pA1,0);CMASK(pA0,pA1,0);
  START(pA0,pA1);
  _Pragma("unroll") for(int r=0;r<16;++r)pA1[r]=__builtin_amdgcn_exp2f(pA1[r]);
  WAIT_BAR(0);
  DMA_K(3,3);DMA_V(1,1); if(4<NT){DMA_K(4,0);} DMA_V(2,2);
  ROT();
  kload8(kf,kp0+i_cur*D1_SLK);
  WAIT_BAR(6);
  s16x4 vl[16],vh[16]; u32x4 pw0,pw1,pw2,pw3;
  #define PKW(P,B) cvtpk_s(P[B],P[B+1])
  #define PAF(k) __builtin_bit_cast(bf16x8,pw##k)
  #define VFR(f) (bf16x8){vl[f][0],vl[f][1],vl[f][2],vl[f][3],vh[f][0],vh[f][1],vh[f][2],vh[f][3]}
  #define PIN(x) asm volatile("":"+v"(x))
  #define MX3(a,b,c) __builtin_fmaxf(__builtin_fmaxf((a),(b)),(c))
  #define GAPA(MF,A0,A1,A2,A3,W0,W1,PW) do{ MF; sacc+=A0; sacc+=A1; sacc+=A2; sacc+=A3; PIN(sacc); W0; W1; PIN(PW); SBAR(); }while(0)
  #define EX(v) __builtin_amdgcn_exp2f(v)
  #define VRD(f) do{ vl[f]=vtr(vp_+(f)*1024); vh[f]=vtr(vp_+(f)*1024+512); }while(0)
  #define KRD(G,j) do{ if(G){ kload2(kf,kp0+i_next*D1_SLK,j); } }while(0)
  #define GAPB(n,X,B,GL) do{ o[(n)&3]=__builtin_amdgcn_mfma_f32_32x32x16_bf16(PAFN(n),VFR(4*((n)&3)+((n)>>2)),o[(n)&3],0,0,0); \
    X[B]=EX(X[B]); X[B+1]=EX(X[B+1]); PIN(X); if((n)+3<16){ VRD(4*(((n)+3)&3)+(((n)+3)>>2)); } \
    if((n)==2)KRD(GL,0); if((n)==4)KRD(GL,1); if((n)==6)KRD(GL,2); if((n)==8)KRD(GL,3); SBAR(); }while(0)
  #define PAFN(n) (((n)>>2)==0?PAF(0):((n)>>2)==1?PAF(1):((n)>>2)==2?PAF(2):PAF(3))
  #define STEP(C0,C1,P0,P1,t,GK,GV,GL) do{ SBAR(); \
    const lds_cptr vp_=vp0+i_prev*D1_SLV; \
    VRD(0); SBAR(); float sacc=(P0[0]+P0[1]); \
    GAPA(C0=__builtin_amdgcn_mfma_f32_32x32x16_bf16(kf[0],qr[0],negm,0,0,0), P0[2],P0[3],P0[4],P0[5],     pw0[0]=PKW(P0,0), pw0[1]=PKW(P0,2), pw0); \
    VRD(4); SBAR(); GAPA(C1=__builtin_amdgcn_mfma_f32_32x32x16_bf16(kf[1],qr[0],negm,0,0,0), P0[6],P0[7],P0[8],P0[9],     pw0[2]=PKW(P0,4), pw0[3]=PKW(P0,6), pw0); \
    VRD(8); SBAR(); GAPA(C0=__builtin_amdgcn_mfma_f32_32x32x16_bf16(kf[2],qr[1],C0,0,0,0),   P0[10],P0[11],P0[12],P0[13], pw1[0]=PKW(P0,8), pw1[1]=PKW(P0,10), pw1); \
    GAPA(C1=__builtin_amdgcn_mfma_f32_32x32x16_bf16(kf[3],qr[1],C1,0,0,0),   P0[14],P0[15],P1[0],P1[1],   pw1[2]=PKW(P0,12),pw1[3]=PKW(P0,14), pw1); \
    GAPA(C0=__builtin_amdgcn_mfma_f32_32x32x16_bf16(kf[4],qr[2],C0,0,0,0),   P1[2],P1[3],P1[4],P1[5],     pw2[0]=PKW(P1,0), pw2[1]=PKW(P1,2), pw2); \
    GAPA(C1=__builtin_amdgcn_mfma_f32_32x32x16_bf16(kf[5],qr[2],C1,0,0,0),   P1[6],P1[7],P1[8],P1[9],     pw2[2]=PKW(P1,4), pw2[3]=PKW(P1,6), pw2); \
    GAPA(C0=__builtin_amdgcn_mfma_f32_32x32x16_bf16(kf[6],qr[3],C0,0,0,0),   P1[10],P1[11],P1[12],P1[13], pw3[0]=PKW(P1,8), pw3[1]=PKW(P1,10), pw3); \
    GAPA(C1=__builtin_amdgcn_mfma_f32_32x32x16_bf16(kf[7],qr[3],C1,0,0,0),   P1[14],P1[15],0.f,0.f,       pw3[2]=PKW(P1,12),pw3[3]=PKW(P1,14), pw3); \
    l_reg+=sacc; \
    if(GK){DMA_K((t)+4,i_cur);} if(GV){DMA_V((t)+2,(i_next+1)&3);} \
    BIAS(C0,C1,t); CMASK(C0,C1,t); \
    { float a=MX3(C0[0],C0[1],C1[0]),b=MX3(C0[2],C0[3],C1[1]); a=MX3(a,C1[2],C1[3]); \
      _Pragma("unroll") for(int r=4;r<16;r+=4){a=MX3(a,C0[r],C0[r+1]);b=MX3(b,C0[r+2],C0[r+3]);a=MX3(a,C1[r],C1[r+1]);b=MX3(b,C1[r+2],C1[r+3]);} \
      float rm=__builtin_fmaxf(a,b); { auto rr=__builtin_amdgcn_permlane32_swap(__float_as_uint(rm),__float_as_uint(rm),false,false); rm=__builtin_fmaxf(__uint_as_float(rr[0]),__uint_as_float(rr[1])); } \
      resc=false; \
      if(__builtin_expect(__any(rm>(float)THRL),0)){ const float dl=__builtin_fmaxf(rm,0.f); mhat+=dl; \
        _Pragma("unroll") for(int r=0;r<16;++r){C0[r]-=dl;C1[r]-=dl;} \
        _Pragma("unroll") for(int r=0;r<16;++r)negm[r]=-mhat; asm volatile("":"+v"(negm)); \
        const float f=__builtin_amdgcn_exp2f(-dl); l_reg*=f; if(hi==0)wsf[r32]=f; resc=true; } } \
    SBAR(); \
    GAPB(0,C0,0,GL); GAPB(1,C0,2,GL); GAPB(2,C0,4,GL); GAPB(3,C0,6,GL); GAPB(4,C0,8,GL); GAPB(5,C0,10,GL); GAPB(6,C0,12,GL); GAPB(7,C0,14,GL); \
    GAPB(8,C1,0,GL); GAPB(9,C1,2,GL); GAPB(10,C1,4,GL); GAPB(11,C1,6,GL); GAPB(12,C1,8,GL); GAPB(13,C1,10,GL); GAPB(14,C1,12,GL); GAPB(15,C1,14,GL); \
    }while(0)
  int t=1;
  #undef CMASK
  #define CMASK(P0,P1,t) do{}while(0)
  #undef BIAS
  #define BIAS(P0,P1,t) BIAS_(P0,P1,t,false)
  for(;t+7<NT;t+=2){
    STEP(pB0,pB1,pA0,pA1,t,true,true,true);     WAIT_BAR(6); RESC(); ROT();
    STEP(pA0,pA1,pB0,pB1,t+1,true,true,true);   WAIT_BAR(6); RESC(); ROT();
  }
  #undef CMASK
  #define CMASK(P0,P1,t) do{int jb_=(t)-(NT-4); if(jb_>=0)cmask(P0,P1,jb_,qrel,hi);}while(0)
  #undef BIAS
  #define BIAS(P0,P1,t) BIAS_(P0,P1,t,true)
  #define ENDW(tt) do{ if((tt)+4<NT){WAIT_BAR(6);} else if((tt)+3<NT){WAIT_BAR(5);} else if((tt)+2<NT){WAIT_BAR(4);} else {WAIT_BAR(0);} }while(0)
  for(;t+1<NT;t+=2){
    STEP(pB0,pB1,pA0,pA1,t,(t+4<NT),(t+2<NT),(t+1<NT));       ENDW(t);   RESC(); ROT();
    STEP(pA0,pA1,pB0,pB1,t+1,(t+5<NT),(t+3<NT),(t+2<NT));     ENDW(t+1); RESC(); ROT();
  }
  STEP(pB0,pB1,pA0,pA1,NT-1,false,false,false); RESC();
  { float sacc=pB0[0]+pB0[1]; _Pragma("unroll") for(int r=2;r<16;++r)sacc+=pB0[r]; _Pragma("unroll") for(int r=0;r<16;++r)sacc+=pB1[r]; l_reg+=sacc;
    pw0=(u32x4){PKW(pB0,0),PKW(pB0,2),PKW(pB0,4),PKW(pB0,6)};pw1=(u32x4){PKW(pB0,8),PKW(pB0,10),PKW(pB0,12),PKW(pB0,14)};pw2=(u32x4){PKW(pB1,0),PKW(pB1,2),PKW(pB1,4),PKW(pB1,6)};pw3=(u32x4){PKW(pB1,8),PKW(pB1,10),PKW(pB1,12),PKW(pB1,14)};
    SBAR(); const lds_cptr vp_=vp0+i_cur*D1_SLV;
    #pragma unroll
    for(int dq=0;dq<4;++dq){ s16x4 lo[4],hh[4];
      #pragma unroll
      for(int ks=0;ks<4;++ks){ lo[ks]=vtr(vp_+(4*dq+ks)*1024); hh[ks]=vtr(vp_+(4*dq+ks)*1024+512); }
      #define PK_(k) (bf16x8){lo[k][0],lo[k][1],lo[k][2],lo[k][3],hh[k][0],hh[k][1],hh[k][2],hh[k][3]}
      o[dq]=__builtin_amdgcn_mfma_f32_32x32x16_bf16(PAF(0),PK_(0),o[dq],0,0,0); o[dq]=__builtin_amdgcn_mfma_f32_32x32x16_bf16(PAF(1),PK_(1),o[dq],0,0,0);
      o[dq]=__builtin_amdgcn_mfma_f32_32x32x16_bf16(PAF(2),PK_(2),o[dq],0,0,0); o[dq]=__builtin_amdgcn_mfma_f32_32x32x16_bf16(PAF(3),PK_(3),o[dq],0,0,0);
      #undef PK_
    } }
  #undef PKW
  #undef PAF
  #undef PAFN
  #undef VFR
  #undef PIN
  #undef MX3
  #undef GAPA
  #undef GAPB
  #undef EX
  #undef VRD
  #undef KRD
  #undef STEP
  #undef ENDW
  {auto rr=__builtin_amdgcn_permlane32_swap(__float_as_uint(l_reg),__float_as_uint(l_reg),false,false);l_reg=__uint_as_float(rr[0])+__uint_as_float(rr[1]);}
  if(hi==0)wsf[32+r32]=l_reg;
  asm volatile("s_waitcnt lgkmcnt(0)\n\ts_barrier":::"memory");
  float rli[16];
  #pragma unroll
  for(int r=0;r<16;++r)rli[r]=__builtin_amdgcn_rcpf(wsf[32+crow(r,hi)]);
  bf16*Ow=Oj+(long)(q0+wid*QBLK)*opitch;
  { bf16*stg=(bf16*)(shm)+wid*4096;
    #pragma unroll
    for(int r=0;r<16;++r){const int orow=crow(r,hi);
      #pragma unroll
      for(int dq=0;dq<4;++dq)stg[orow*128+dq*32+r32]=__float2bfloat16(o[dq][r]*rli[r]);}
    asm volatile("s_waitcnt lgkmcnt(0)":::"memory");
    #pragma unroll
    for(int i=0;i<8;++i){const int row=i*4+(lane>>4),ch=lane&15; const u32x4 v=*(const u32x4*)(stg+row*128+ch*8); ATTN_STORE16(Ow+(long)row*opitch+ch*8,v);} }
  asm volatile("s_waitcnt lgkmcnt(0)\n\ts_barrier":::"memory");
  #undef DMA_K
  #undef DMA_V
  #undef CMASK
  #undef BIAS
  #undef BIAS_
  #undef START
  #undef RESC
  #undef ROT
}

struct AttnBufs { const bf16* PROJ; bf16* YFOX; bf16* OD; const float* F2; const bf16* KA; const unsigned* NRM; };
template<int THRL> __device__ __forceinline__ void attn_run_fox(const AttnBufs& A,int g,int qb,char*lds){
  const int b=g>>3,h=g&7; const bf16*P=A.PROJ+(long)b*SEQ*PITCH;
  const unsigned*nq=A.NRM+((0*2+b)*8+h)*2,*nk=A.NRM+((1*2+b)*8+h)*2;
  const float twoB=2.04f*sqrtf((__uint_as_float(nq[0])+__uint_as_float(nq[1]))*(__uint_as_float(nk[0])+__uint_as_float(nk[1])));
  attn_unit<0,THRL>(qb,P+PC_FQ+64*h,P+PC_FK+64*h,P+PC_FV+64*h,A.YFOX+(long)b*SEQ*512+64*h,512,A.F2+((long)b*8+h)*SEQ,A.KA+((long)b*8+h)*SEQ*8,twoB,0,lds);
}
template<int THRL> __device__ __forceinline__ void attn_run_diff(const AttnBufs& A,int g,int qb,char*lds){
  const int b=g>>3,h=(g&7)>>1,i=g&1; const bf16*P=A.PROJ+(long)b*SEQ*PITCH;
  attn_unit_d128<THRL>(qb,P+PC_DQ+h*128+i*64,P+PC_DK+h*128+i*64,P+PC_DV+h*128,A.OD+(long)b*SEQ*1024+i*512+h*128,1024,h,lds);
}
__device__ __forceinline__ void attn_build_lut(char*lds,const float*LUTg){
  __attribute__((address_space(3))) float* R=(__attribute__((address_space(3))) float*)((__attribute__((address_space(3))) char*)lds+LDS_LUT);
  for(int u=threadIdx.x;u<4*LUTN;u+=NW*64){ const int h=u/LUTN,i=u%LUTN,dist=383-i; R[u]=(dist>=0&&dist<128)?(LUTg[h*128+dist]-LUTg[h*128+127]):0.f; }
  __syncthreads();
}
#undef SBAR
#undef WAIT_BAR
}
struct Frame {
    LAS unsigned char* lds;
    volatile LAS unsigned* MISC;
    gu32* ctl;
    int tid, lane, wave, vcu, G;
    const float* in[25]; float* out; unsigned char* ws;
};
#define WSP(T, off) ((T*)(F.ws + (off)))
enum { I_X = 0, I_C, I_WADA, I_BADA, I_LN1G, I_WIN, I_BFG, I_BMERGE, I_LQ1, I_LK1, I_LQ2, I_LK2, I_DNG, I_T5, I_WBF, I_WBD, I_WO, I_LN2G, I_WR, I_BR, I_WUP, I_BUP, I_WDN, I_BDN, I_FING };

__device__ __forceinline__ float wave_sum(float v) {
#pragma unroll
    for (int o = 1; o < 64; o <<= 1) v += __shfl_xor(v, o);
    return v;
}
__device__ __forceinline__ float bflo(unsigned w) { return __uint_as_float(w << 16); }
__device__ __forceinline__ float bfhi(unsigned w) { return __uint_as_float(w & 0xffff0000u); }

__device__ __forceinline__ unsigned cvtpk_rne(float lo, float hi) { unsigned r; asm("v_cvt_pk_bf16_f32 %0, %1, %2" : "=v"(r) : "v"(lo), "v"(hi)); return r; }
template <bool NT = false> __device__ __forceinline__ void tr_load(const float* W, int ldw, int src_col0, int kb, int nb, int lane, f32x4 (&t)[8]) {
    const int k0 = 64 * kb, n0 = 32 * nb, kr = lane >> 3, c4 = lane & 7;
#pragma unroll
    for (int i = 0; i < 8; ++i) { const f32x4* p_ = (const f32x4*)(W + (size_t)(k0 + 16 * (i >> 1) + 2 * kr + (i & 1)) * ldw + src_col0 + n0 + 4 * c4); t[i] = NT ? __builtin_nontemporal_load(p_) : *p_; }
}
__device__ __forceinline__ void tr_flush(const f32x4 (&t)[8], int K, bf16* WT, int dst_row0, LAS float* scr, int kb, int nb, int lane) {
    const int k0 = 64 * kb, n0 = 32 * nb, kr = lane >> 3, c4 = lane & 7; LAS unsigned* s32 = (LAS unsigned*)scr;
#pragma unroll
    for (int j = 0; j < 4; ++j)
#pragma unroll
        for (int e = 0; e < 4; ++e) s32[(4 * c4 + e) * 36 + 8 * j + kr] = cvtpk_rne(t[2 * j][e], t[2 * j + 1][e]);
    LDS_WAIT(); asm volatile("" ::: "memory");
    const int c = lane & 7;
#pragma unroll
    for (int jj = 0; jj < 4; ++jj) { const int n = (lane >> 3) + 8 * jj; const v4u o = *(const LAS v4u*)(s32 + n * 36 + 4 * c);
        *(GAS v4u*)(WT + (size_t)(dst_row0 + n0 + n) * K + k0 + 8 * c) = o; }
    LDS_WAIT(); asm volatile("" ::: "memory");
}
template <bool NT = false> __device__ __forceinline__ void transpose_item(const float* W, int ldw, int src_col0, int K, bf16* WT, int dst_row0, LAS float* scr, int kb, int nb, int lane) {
    f32x4 t[8]; tr_load<NT>(W, ldw, src_col0, kb, nb, lane, t); tr_flush(t, K, WT, dst_row0, scr, kb, nb, lane);
}

__device__ __forceinline__ int t5_bucket(int n) {
    if (n < 16) return n;
    int large = 16 + (int)(logf((float)n / 16.0f) / logf(8.0f) * 16.0f);
    return large < 31 ? large : 31;
}

__device__ __forceinline__ float sat_fp8(float x) { return __builtin_amdgcn_fmed3f(x, -448.0f, 448.0f); }
__device__ __forceinline__ unsigned pack4_fp8(float a, float b, float c, float d) { int w = 0; w = __builtin_amdgcn_cvt_pk_fp8_f32(sat_fp8(a), sat_fp8(b), w, false); w = __builtin_amdgcn_cvt_pk_fp8_f32(sat_fp8(c), sat_fp8(d), w, true); return (unsigned)w; }
constexpr float W8_SCALE = 32.0f;
template <bool NT = false> __device__ __forceinline__ void tr_load_f8(const float* W, int ldw, int kb, int nb, int lane, f32x4 (&t)[8], int src_col0 = 0) {
    const int k0 = 64 * kb, n0 = 32 * nb, kr = lane >> 3, c4 = lane & 7;
#pragma unroll
    for (int i = 0; i < 8; ++i) { const f32x4* p_ = (const f32x4*)(W + (size_t)(k0 + 32 * (i >> 2) + 4 * kr + (i & 3)) * ldw + src_col0 + n0 + 4 * c4); t[i] = NT ? __builtin_nontemporal_load(p_) : *p_; }
}
__device__ __forceinline__ void tr_flush_f8(const f32x4 (&t)[8], int K8, unsigned char* WT8, LAS float* scr, int kb, int nb, int lane) {
    const int k0 = 64 * kb, n0 = 32 * nb, kr = lane >> 3, c4 = lane & 7; LAS unsigned* s32 = (LAS unsigned*)scr;
#pragma unroll
    for (int g = 0; g < 2; ++g)
#pragma unroll
        for (int e = 0; e < 4; ++e) s32[(4 * c4 + e) * 20 + 8 * g + kr] = pack4_fp8(t[4 * g][e] * W8_SCALE, t[4 * g + 1][e] * W8_SCALE, t[4 * g + 2][e] * W8_SCALE, t[4 * g + 3][e] * W8_SCALE);
    LDS_WAIT(); asm volatile("" ::: "memory");
#pragma unroll
    for (int jj = 0; jj < 2; ++jj) { const int n = (lane >> 2) + 16 * jj, c = lane & 3; const v4u o = *(const LAS v4u*)(s32 + n * 20 + 4 * c);
        *(GAS v4u*)(WT8 + (size_t)(n0 + n) * K8 + k0 + 16 * c) = o; }
    LDS_WAIT(); asm volatile("" ::: "memory");
}
struct MoeItem { const float* W; unsigned char* WT; int ldw, kb, nb; };
__device__ __forceinline__ MoeItem moe_item(Frame& F, int r) {
    MoeItem d;
    if (r < 32768) { const int e = r / 1024, q = r % 1024; d.W = F.in[I_WUP] + (size_t)e * DM * NUP; d.WT = WSP(unsigned char, WS_WUP) + (size_t)e * NUP * DM; d.ldw = NUP; d.kb = q / 64; d.nb = q % 64; }
    else { r -= 32768; const int e = r / 512, q = r % 512; d.W = F.in[I_WDN] + (size_t)e * DFF * DM; d.WT = WSP(unsigned char, WS_WDN) + (size_t)e * DM * DFF; d.ldw = DM; d.kb = q / 32; d.nb = q % 32; }
    return d;
}
__device__ __forceinline__ void moe_weight_items8(Frame& F, int base, LAS float* scr) {
    f32x4 tc[8], tn[8]; MoeItem dc = moe_item(F, base), dn = dc;
    tr_load_f8<true>(dc.W, dc.ldw, dc.kb, dc.nb, F.lane, tc);
    for (int i = 0; i < 8; ++i) {
        if (i + 1 < 8) { dn = moe_item(F, base + i + 1); tr_load_f8<true>(dn.W, dn.ldw, dn.kb, dn.nb, F.lane, tn); }
        tr_flush_f8(tc, 1024, dc.WT, scr, dc.kb, dc.nb, F.lane);
        dc = dn;
#pragma unroll
        for (int k = 0; k < 8; ++k) tc[k] = tn[k];
    }
}
__device__ __forceinline__ void p0_prologue(Frame& F) {
    float* MOD = WSP(float, WS_MOD);
    {
        LAS float* red = (LAS float*)(F.lds + RING_OFF);
        const float* c = F.in[I_C]; const float* wa = F.in[I_WADA]; const float* ba = F.in[I_BADA];
        for (int it = F.vcu; it < 192; it += F.G) {
            const int col = F.lane & 31, j = it * 32 + col, kb = F.wave * 128 + (F.lane >> 5) * 64; float a0 = 0.f, a1 = 0.f;
#pragma unroll 16
            for (int k = kb; k < kb + 64; ++k) { const float wv = wa[(size_t)k * (6 * DM) + j]; const float c0 = c[k], c1 = c[DM + k];
                const float s0 = c0 / (1.0f + __expf(-c0)), s1 = c1 / (1.0f + __expf(-c1)); a0 += s0 * wv; a1 += s1 * wv; }
            a0 += __shfl_xor(a0, 32); a1 += __shfl_xor(a1, 32);
            if (F.lane < 32) { red[(F.wave * 2 + 0) * 32 + col] = a0; red[(F.wave * 2 + 1) * 32 + col] = a1; }
            __syncthreads();
            if (F.tid < 64) { const int b = F.tid >> 5; float s = ba[j];
#pragma unroll
                for (int w = 0; w < 8; ++w) s += red[(w * 2 + b) * 32 + col];
                MOD[(size_t)b * (6 * DM) + j] = s; }
            __syncthreads();
        }
    }
    if (F.vcu == F.G - 1) {
        if (F.tid < 512) { const int h = F.tid >> 7, n = F.tid & 127; WSP(float, WS_LUT)[F.tid] = F.in[I_T5][t5_bucket(n) * 4 + h] * LOG2E; }
        if (F.tid == 0) { float s1 = 0.f, s2 = 0.f;
            for (int i = 0; i < 64; ++i) { s1 += F.in[I_LQ1][i] * F.in[I_LK1][i]; s2 += F.in[I_LQ2][i] * F.in[I_LK2][i]; }
            WSP(float, WS_SCAL)[0] = expf(s1) - expf(s2) + LAMBDA_INIT; }
    }
    __syncthreads();
    {
        LAS float* scr = (LAS float*)(F.lds + RING_OFF + F.wave * 16384);
        const int gw = F.vcu * NWAVES + F.wave, NGW = F.G * NWAVES;
        constexpr int I_IN = 16 * 160, I_BF = 8 * 32, I_BD = 8 * 32, I_OO = 16 * 32, I_UP = 32 * 16 * 64, I_DN = 32 * 16 * 32;
        const int NITEMS = I_IN + I_BF + I_BD + I_OO;
        for (int it = gw; it < NITEMS; it += NGW) {
            int r = it;
            if (r < I_IN) { const int kb = r / 160, nb = r % 160; f32x4 t8[8]; tr_load_f8(F.in[I_WIN], INCOLS, kb, nb, F.lane, t8, (nb >= 48) ? 8 : 0); tr_flush_f8(t8, DM, WSP(unsigned char, WS_WIN), scr, kb, nb, F.lane); continue; } r -= I_IN;
            if (r < I_BF) { transpose_item(F.in[I_WBF], DM, 0, 512, WSP(bf16, WS_WBF), 0, scr, r / 32, r % 32, F.lane); continue; } r -= I_BF;
            if (r < I_BD) { transpose_item(F.in[I_WBD], DM, 0, 512, WSP(bf16, WS_WBD), 0, scr, r / 32, r % 32, F.lane); continue; } r -= I_BD;
            if (r < I_OO) { transpose_item(F.in[I_WO], DM, 0, DM, WSP(bf16, WS_WO), 0, scr, r / 32, r % 32, F.lane); continue; } r -= I_OO;
        }
    }
}

__device__ __forceinline__ void norm_mod_row(const float* xrow, const float* g, const float* shift, const float* scale, int lane, f32x4 (&v)[4]) {
    const GAS f32x4* xr = (const GAS f32x4*)xrow + lane; float s = 0.f;
#pragma unroll
    for (int j = 0; j < 4; ++j) { v[j] = xr[64 * j]; s += (v[j].x * v[j].x + v[j].y * v[j].y) + (v[j].z * v[j].z + v[j].w * v[j].w); }
    const float rstd = 1.0f / sqrtf(wave_sum(s) * (1.0f / DM) + 1e-6f);
#pragma unroll
    for (int j = 0; j < 4; ++j) { const f32x4 gg = ((const GAS f32x4*)g)[64 * j + lane], sh = ((const GAS f32x4*)shift)[64 * j + lane], sc = ((const GAS f32x4*)scale)[64 * j + lane];
        v[j] = v[j] * rstd * gg * (sc + 1.0f) + sh; }
}
__device__ __forceinline__ void norm_mod_row_bf16(const bf16* xrow, const float* g, const float* shift, const float* scale, int lane, f32x4 (&v)[4]) {
    const GAS unsigned long long* xr = (const GAS unsigned long long*)xrow + lane; float s = 0.f;
#pragma unroll
    for (int j = 0; j < 4; ++j) { const unsigned long long w = xr[64 * j]; const unsigned lo = (unsigned)w, hi = (unsigned)(w >> 32); v[j] = (f32x4){bflo(lo), bfhi(lo), bflo(hi), bfhi(hi)};
        s += (v[j].x * v[j].x + v[j].y * v[j].y) + (v[j].z * v[j].z + v[j].w * v[j].w); }
    const float rstd = 1.0f / sqrtf(wave_sum(s) * (1.0f / DM) + 1e-6f);
#pragma unroll
    for (int j = 0; j < 4; ++j) { const f32x4 gg = ((const GAS f32x4*)g)[64 * j + lane], sh = ((const GAS f32x4*)shift)[64 * j + lane], sc = ((const GAS f32x4*)scale)[64 * j + lane];
        v[j] = v[j] * rstd * gg * (sc + 1.0f) + sh; }
}
__device__ __forceinline__ void store_row_bf16(bf16* orow, int lane, const f32x4 (&v)[4]) {
    GAS unsigned long long* o8 = (GAS unsigned long long*)orow + lane;
#pragma unroll
    for (int j = 0; j < 4; ++j) o8[64 * j] = (unsigned long long)pk2(v[j].x, v[j].y) | ((unsigned long long)pk2(v[j].z, v[j].w) << 32);
}

__device__ __forceinline__ void p1_norm_fgate(Frame& F) {
    LAS float* wfl = (LAS float*)(F.lds + RING_OFF);
    LAS float* lfs = (LAS float*)(F.lds + RING_OFF + 40960);
    const float* win = F.in[I_WIN]; const float* MOD = WSP(float, WS_MOD);
    for (int u = F.tid; u < 8192; u += NWAVES * 64) { const int k = u >> 3; wfl[((k >> 8) * 64 + ((k >> 2) & 63)) * 36 + (k & 3) * 8 + (u & 7)] = win[(size_t)k * INCOLS + 1536 + (u & 7)]; }
    __syncthreads();
    for (int g = F.vcu; g < M / 64; g += F.G) {
        for (int i = 0; i < 8; ++i) {
            const int rl = F.wave * 8 + i, row = g * 64 + rl, b = row / SEQ;
            f32x4 v[4]; norm_mod_row(F.in[I_X] + (size_t)row * DM, F.in[I_LN1G], MOD + (size_t)b * 6 * DM, MOD + (size_t)b * 6 * DM + DM, F.lane, v);
            { GAS unsigned* o4 = (GAS unsigned*)(WSP(unsigned char, WS_XN) + (size_t)row * DM) + F.lane;
#pragma unroll
              for (int j = 0; j < 4; ++j) o4[64 * j] = pack4_fp8(v[j].x, v[j].y, v[j].z, v[j].w); }
            float a[8];
#pragma unroll
            for (int hh = 0; hh < 8; ++hh) a[hh] = 0.f;
#pragma unroll
            for (int j = 0; j < 4; ++j)
#pragma unroll
                for (int e = 0; e < 4; ++e) { const LAS float* wp_ = wfl + (j * 64 + F.lane) * 36 + e * 8; const f32x4 w0 = *(const LAS f32x4*)(wp_), w1 = *(const LAS f32x4*)(wp_ + 4); const float hv = v[j][e];
                    a[0] += hv * w0.x; a[1] += hv * w0.y; a[2] += hv * w0.z; a[3] += hv * w0.w; a[4] += hv * w1.x; a[5] += hv * w1.y; a[6] += hv * w1.z; a[7] += hv * w1.w; }
            float mine = 0.f;
#pragma unroll
            for (int hh = 0; hh < 8; ++hh) { const float s = wave_sum(a[hh]); if (F.lane == hh) mine = s; }
            if (F.lane < 8) { const float z = mine + F.in[I_BFG][F.lane]; lfs[rl * 8 + F.lane] = fminf(z, 0.f) - log1pf(expf(-fabsf(z))); }
        }
        __syncthreads();
        if (F.tid < 8) { float run = 0.f; float* floc = WSP(float, WS_FLOC);
            for (int r = 0; r < 64; ++r) { run += lfs[r * 8 + F.tid]; floc[(size_t)(g * 64 + r) * 8 + F.tid] = run; }
            WSP(float, WS_BT)[g * 8 + F.tid] = run; }
        __syncthreads();
    }
}
__device__ __forceinline__ void p2_finish_f(Frame& F) {
    LAS float* base = (LAS float*)(F.lds + RING_OFF);
    const float* BT = WSP(float, WS_BT); const float* floc = WSP(float, WS_FLOC); float* F2 = WSP(float, WS_F2);
    for (int g = F.vcu; g < M / 64; g += F.G) {
        const int g0 = (g / 128) * 128;
        { const int l0 = g0 + F.lane, l1 = g0 + 64 + F.lane; float s = (l0 < g ? BT[l0 * 8 + F.wave] : 0.f) + (l1 < g ? BT[l1 * 8 + F.wave] : 0.f); s = wave_sum(s); if (F.lane == 0) base[F.wave] = s; }
        __syncthreads();
        { const int r = F.tid >> 3, hh = F.tid & 7, row = g * 64 + r, b = row / SEQ, s = row % SEQ;
          const float f2 = (floc[(size_t)row * 8 + hh] + base[hh]) * LOG2E; F2[((size_t)b * 8 + hh) * SEQ + s] = f2;
          const float x0 = -f2; const unsigned h0 = f2bf(x0); const float r1 = x0 - __uint_as_float(h0 << 16); const unsigned h1 = f2bf(r1); const float r2 = r1 - __uint_as_float(h1 << 16); const unsigned h2 = f2bf(r2);
          v4u w; w.x = h0 | (h1 << 16); w.y = h2 | (0x3F80u << 16); w.z = 0x3F803F80u; w.w = 0u; WSP(v4u, WS_KA)[((size_t)b * 8 + hh) * SEQ + s] = w; }
        __syncthreads();
    }
}

__device__ __forceinline__ void p4_diff_post(Frame& F) {
    const bf16* OD = WSP(bf16, WS_OD); bf16* YD = WSP(bf16, WS_YD); const float lam = WSP(float, WS_SCAL)[0]; const float* gn = F.in[I_DNG];
    const int gw = F.vcu * NWAVES + F.wave, NGW = F.G * NWAVES; const int e0 = (F.lane & 15) * 8;
    float gv[8];
#pragma unroll
    for (int e = 0; e < 8; ++e) gv[e] = gn[e0 + e] * (1.0f - LAMBDA_INIT);
    for (int row = gw; row < M; row += NGW) {
        const v4u a = *(const v4u*)(OD + (size_t)row * 1024 + F.lane * 8), bq = *(const v4u*)(OD + (size_t)row * 1024 + 512 + F.lane * 8);
        float y[8]; y[0] = bflo(a.x) - lam * bflo(bq.x); y[1] = bfhi(a.x) - lam * bfhi(bq.x); y[2] = bflo(a.y) - lam * bflo(bq.y); y[3] = bfhi(a.y) - lam * bfhi(bq.y);
        y[4] = bflo(a.z) - lam * bflo(bq.z); y[5] = bfhi(a.z) - lam * bfhi(bq.z); y[6] = bflo(a.w) - lam * bflo(bq.w); y[7] = bfhi(a.w) - lam * bfhi(bq.w);
        float ss = 0.f;
#pragma unroll
        for (int e = 0; e < 8; ++e) ss += y[e] * y[e];
        ss += __shfl_xor(ss, 1); ss += __shfl_xor(ss, 2); ss += __shfl_xor(ss, 4); ss += __shfl_xor(ss, 8);
        const float rstd = 1.0f / sqrtf(ss * (1.0f / 128.0f) + 1e-5f);
        v4u w; w.x = pk2(y[0] * rstd * gv[0], y[1] * rstd * gv[1]); w.y = pk2(y[2] * rstd * gv[2], y[3] * rstd * gv[3]); w.z = pk2(y[4] * rstd * gv[4], y[5] * rstd * gv[5]); w.w = pk2(y[6] * rstd * gv[6], y[7] * rstd * gv[7]);
        *(v4u*)(YD + (size_t)row * 512 + F.lane * 8) = w;
    }
}

__device__ __forceinline__ void p7_route(Frame& F) {
    typedef float f32x16_t __attribute__((ext_vector_type(16)));
    LAS float* HS = (LAS float*)(F.lds + RING_OFF);
    LAS float* PL = (LAS float*)(F.lds + RING_OFF + 36864);
    LAS unsigned* lcnt = (LAS unsigned*)(F.lds + TAB_OFF);
    LAS int* prs = (LAS int*)(F.lds + TAB_OFF + 512);
    const bf16* X1 = WSP(bf16, WS_X1B); const float* MOD = WSP(float, WS_MOD); const float* wr = F.in[I_WR]; const float* br = F.in[I_BR];
    int* TOPE = WSP(int, WS_TOPE); int* RANK = WSP(int, WS_RANK);
    const int e = F.lane & 31, hh = F.lane >> 5, rt = F.wave & 1, kp = F.wave >> 1;
    const float bre = br[e];
    for (int grp = F.vcu; grp < M / 64; grp += F.G) {
        if (F.tid < 32) lcnt[F.tid] = 0u;
        const int row0 = grp * 64 + F.wave * 8, b = row0 / SEQ;
        f32x4 v[8][4];
#pragma unroll
        for (int r = 0; r < 8; ++r) { norm_mod_row_bf16(X1 + (size_t)(row0 + r) * DM, F.in[I_LN2G], MOD + (size_t)b * 6 * DM + 3 * DM, MOD + (size_t)b * 6 * DM + 4 * DM, F.lane, v[r]);
            { GAS unsigned* o4 = (GAS unsigned*)(WSP(unsigned char, WS_XN) + (size_t)(row0 + r) * DM) + F.lane;
#pragma unroll
              for (int j = 0; j < 4; ++j) o4[64 * j] = pack4_fp8(v[r][j].x, v[r][j].y, v[r][j].z, v[r][j].w); } }
        f32x16_t acc = f32x16_t{};
#pragma unroll
        for (int q = 0; q < 8; ++q) {
            __syncthreads();
            if (hh == (q & 1)) {
#pragma unroll
                for (int r = 0; r < 8; ++r) { LAS float* d_ = HS + (F.wave * 8 + r) * 129 + 4 * e; const f32x4 t_ = v[r][q >> 1]; d_[0] = t_.x; d_[1] = t_.y; d_[2] = t_.z; d_[3] = t_.w; } }
            __syncthreads();
            const LAS float* ap = HS + (rt * 32 + e) * 129 + 32 * kp + hh; const float* bp = wr + (size_t)(128 * q + 32 * kp + hh) * NE + e;
#pragma unroll
            for (int s2 = 0; s2 < 16; ++s2) acc = __builtin_amdgcn_mfma_f32_32x32x2f32(ap[2 * s2], bp[(size_t)(2 * s2) * NE], acc, 0, 0, 0);
        }
#pragma unroll
        for (int r = 0; r < 16; ++r) PL[(kp * 64 + rt * 32 + (r & 3) + 8 * (r >> 2) + 4 * hh) * 32 + e] = acc[r];
        __syncthreads();
#pragma unroll
        for (int it = 0; it < 4; ++it) {
            const int rl = F.wave * 8 + 2 * it + hh;
            float val = ((PL[(0 * 64 + rl) * 32 + e] + PL[(1 * 64 + rl) * 32 + e]) + (PL[(2 * 64 + rl) * 32 + e] + PL[(3 * 64 + rl) * 32 + e])) + bre;
            float tv[4]; int te[4];
#pragma unroll
            for (int kk = 0; kk < 4; ++kk) { float best = val; int bi = e;
#pragma unroll
                for (int o = 1; o < 32; o <<= 1) { const float ov = __shfl_xor(best, o); const int oi = __shfl_xor(bi, o); if (ov > best || (ov == best && oi < bi)) { best = ov; bi = oi; } }
                tv[kk] = best; te[kk] = bi; if (e == bi) val = -INFINITY; }
            const float p1 = __expf(tv[1] - tv[0]), p2 = __expf(tv[2] - tv[0]), p3 = __expf(tv[3] - tv[0]); const float inv = 1.0f / (1.0f + p1 + p2 + p3);
            if (e < 4) { const int me = e == 0 ? te[0] : e == 1 ? te[1] : e == 2 ? te[2] : te[3]; const float mg = (e == 0 ? 1.0f : e == 1 ? p1 : e == 2 ? p2 : p3) * inv;
                const int rk = (int)__hip_atomic_fetch_add(lcnt + me, 1u, __ATOMIC_RELAXED, __HIP_MEMORY_SCOPE_WORKGROUP);
                const int li = rl * 4 + e; prs[3 * li] = me; prs[3 * li + 1] = rk; prs[3 * li + 2] = (int)__float_as_uint(mg);
                TOPE[(size_t)(grp * 64 + rl) * 4 + e] = me; }
        }
        __syncthreads();
        if (F.tid < 32) lcnt[32 + F.tid] = __hip_atomic_fetch_add(F.ctl + CW_CNT + 64 * F.tid, lcnt[F.tid], __ATOMIC_RELAXED, __HIP_MEMORY_SCOPE_AGENT);
        __syncthreads();
        if (F.tid < 256) { const int me = prs[3 * F.tid], rk = (int)lcnt[32 + me] + prs[3 * F.tid + 1]; RANK[(size_t)grp * 256 + F.tid] = rk;
            WSP(int, WS_IDX)[(size_t)me * ECAP + rk] = grp * 64 + (F.tid >> 2); WSP(float, WS_GX)[(size_t)me * ECAP + rk] = __uint_as_float((unsigned)prs[3 * F.tid + 2]); }
        __syncthreads();
    }
}
__device__ __forceinline__ void load_expert_tables(Frame& F) {
    LAS int* tab = (LAS int*)(F.lds + TAB_OFF);
    if (F.tid < 32) tab[F.tid] = (int)__hip_atomic_load(F.ctl + CW_CNT + 64 * F.tid, __ATOMIC_RELAXED, __HIP_MEMORY_SCOPE_AGENT);
    __syncthreads();
    if (F.tid == 0) { int run = 0; for (int e = 0; e < 32; ++e) { const int mt = (tab[e] + 255) >> 8; tab[32 + e] = run; tab[65 + e] = mt; run += mt * 256; } tab[64] = run; }
    __syncthreads();
}
__device__ __forceinline__ int build_units(Frame& F, int NT) {
    load_expert_tables(F);
    LAS int* tab = (LAS int*)(F.lds + TAB_OFF); LAS int* lst = (LAS int*)(F.lds + TAB_OFF + 1024);
    if (F.tid == 0) { int n = 0; int total = 0; for (int e = 0; e < 32; ++e) total += tab[65 + e] * NT;
        for (int i = 0;; ++i) { const int L = i * F.G + F.vcu; if (L >= total || n >= 256) break;
            int e = 0, r = L; while (r >= tab[65 + e] * NT) { r -= tab[65 + e] * NT; ++e; }
            const int pn = r % NT, pml = r / NT;
            const int nr = tab[e] - 256 * pml;
            lst[6 * n] = (tab[32 + e] >> 8) + pml; lst[6 * n + 1] = pn; lst[6 * n + 2] = e * NT + pn; lst[6 * n + 3] = e; lst[6 * n + 4] = e * ECAP + 256 * pml; lst[6 * n + 5] = nr < 256 ? nr : 256; ++n; }
        tab[128] = n; }
    __syncthreads();
    return tab[128];
}
__device__ __forceinline__ void p11_final(Frame& F) {
    load_expert_tables(F); const LAS int* tab = (const LAS int*)(F.lds + TAB_OFF);
    const float* MOD = WSP(float, WS_MOD); const int* TOPE = WSP(int, WS_TOPE); const int* RANK = WSP(int, WS_RANK); const bf16* YP = WSP(bf16, WS_YP); const float* fg = F.in[I_FING];
    const int gw = F.vcu * NWAVES + F.wave, NGW = F.G * NWAVES;
    for (int rb = gw; rb < M; rb += 8 * NGW) {
    int myslot = 0; { const int prow = rb + (F.lane >> 2) * NGW; if (F.lane < 32 && prow < M) { const size_t pi = (size_t)prow * 4 + (F.lane & 3); myslot = tab[32 + TOPE[pi]] + RANK[pi]; } }
#pragma unroll 4
    for (int ri = 0; ri < 8; ++ri) { const int row = rb + ri * NGW; if (row >= M) break;
        const int b = row / SEQ; const float* g2 = MOD + (size_t)b * 6 * DM + 5 * DM;
        GAS f32x4* xr = (GAS f32x4*)(F.out + (size_t)row * DM) + F.lane; const GAS unsigned long long* x1r = (const GAS unsigned long long*)(WSP(bf16, WS_X1B) + (size_t)row * DM) + F.lane;
        int sl[4];
#pragma unroll
        for (int k = 0; k < 4; ++k) sl[k] = __shfl(myslot, ri * 4 + k);
        f32x4 v[4]; float s = 0.f;
#pragma unroll
        for (int j = 0; j < 4; ++j) { f32x4 y = (f32x4){0.f, 0.f, 0.f, 0.f};
#pragma unroll
            for (int k = 0; k < 4; ++k) { const unsigned long long w = *(const unsigned long long*)(YP + (size_t)sl[k] * DM + 256 * j + 4 * F.lane); const unsigned lo = (unsigned)w, hi = (unsigned)(w >> 32);
                y.x += bflo(lo); y.y += bfhi(lo); y.z += bflo(hi); y.w += bfhi(hi); }
            const f32x4 gg = ((const GAS f32x4*)g2)[64 * j + F.lane];
            { const unsigned long long w1 = x1r[64 * j]; const unsigned l1 = (unsigned)w1, h1 = (unsigned)(w1 >> 32); v[j] = (f32x4){bflo(l1), bfhi(l1), bflo(h1), bfhi(h1)} + gg * y; } s += (v[j].x * v[j].x + v[j].y * v[j].y) + (v[j].z * v[j].z + v[j].w * v[j].w); }
        const float rstd = 1.0f / sqrtf(wave_sum(s) * (1.0f / DM) + 1e-6f);
#pragma unroll
        for (int j = 0; j < 4; ++j) { const f32x4 gg = ((const GAS f32x4*)fg)[64 * j + F.lane]; xr[64 * j] = v[j] * rstd * gg; }
    }
    }
}

#ifndef MK_PER_PHASE
#define MK_PER_PHASE 0
#endif
#ifndef MK_REP_MASK
#define MK_REP_MASK 0
#endif
#ifndef MK_LAUNCH_SEQ
#define MK_LAUNCH_SEQ {0, N_PHASES}
#endif
constexpr int N_PHASES = 11;
struct Args { const float* in[25]; float* out; unsigned char* ws; int ph_lo, ph_hi; };
__global__ void __launch_bounds__(NWAVES * 64, 2) skel_fwd(Args args) {
    extern __shared__ __attribute__((aligned(16))) unsigned char lds[];
    Frame F;
    F.lds = (LAS unsigned char*)lds;
    F.MISC = (volatile LAS unsigned*)(F.lds + MISC_OFF);
    F.tid = threadIdx.x; F.lane = F.tid & 63; F.wave = __builtin_amdgcn_readfirstlane(F.tid >> 6);
    F.G = gridDim.x; { const int bx = blockIdx.x; F.vcu = (F.G % 8 == 0) ? (bx % 8) * (F.G / 8) + bx / 8 : bx; }
    F.ws = args.ws; F.out = args.out; F.ctl = (gu32*)(args.ws + WS_CTL);
#pragma unroll
    for (int i = 0; i < 25; ++i) F.in[i] = args.in[i];
    for (int u = F.tid; u < (LDS_BYTES - LDSCTL_OFF) / 4; u += NWAVES * 64) ((LAS unsigned*)(F.lds + LDSCTL_OFF))[u] = 0u;
    __syncthreads();
    XcdBarrier bar; bar.bar = (unsigned*)(F.ctl + CW_BAR); bar.x = 0; bar.st = nullptr;
    const int lo = args.ph_lo, hi = args.ph_hi;
    if (hi - lo > 1) bar = xcd_barrier_post((unsigned*)(F.ctl + CW_BAR), F.MISC + 8);
#define IN(k) (lo <= (k) && (k) < hi)
#define SEAM(k) do { if (IN(k) && IN((k) + 1)) xcd_barrier(bar); } while (0)
#define REFRESH_TID() do { int t_ = threadIdx.x; asm volatile("" : "+v"(t_)); F.tid = t_; F.lane = t_ & 63; } while (0)

    if (IN(0)) for (int rep_ = 0; rep_ <= ((MK_REP_MASK >> 0) & 1); ++rep_) { REFRESH_TID(); p0_prologue(F); } SEAM(0);
    if (IN(1)) for (int rep_ = 0; rep_ <= ((MK_REP_MASK >> 1) & 1); ++rep_) { REFRESH_TID(); p1_norm_fgate(F); } SEAM(1);
    if (IN(2)) for (int rep_ = 0; rep_ <= ((MK_REP_MASK >> 2) & 1); ++rep_) { REFRESH_TID();
        p2_finish_f(F); __syncthreads();
        pg8::Gemm g{WSP(pg8::bf16_t, WS_XN), WSP(pg8::bf16_t, WS_WIN), M, NPROJ, DM / 2, nullptr, 0u}; pg8::StaticOrder S; S.init(M, NPROJ, F.G, (int)blockIdx.x);
        epi::EpiProj E{WSP(pg8::bf16_t, WS_PROJ), F.in[I_BMERGE], (unsigned*)(F.ctl + CW_NRM)};
        pg8::gemm_phase<epi::EpiProj, pg8::StaticOrder, true, true, false, true>(F.lds + RING_OFF, g, S, E);
    } SEAM(2);
    if (IN(3)) for (int rep_ = 0; rep_ <= ((MK_REP_MASK >> 3) & 1); ++rep_) { REFRESH_TID();
        const attn_body::AttnBufs A{(const attn_body::bf16*)WSP(bf16, WS_PROJ), (attn_body::bf16*)WSP(bf16, WS_YFOX), (attn_body::bf16*)WSP(bf16, WS_OD), WSP(float, WS_F2), (const attn_body::bf16*)WSP(bf16, WS_KA), (const unsigned*)(F.ctl + CW_NRM)};
        {
            const int x = (int)blockIdx.x & 7; const bool conv_first = (((int)blockIdx.x >> 3) % 3) == 2;
            gu32* qa = F.ctl + CW_Q + 64 * (2 * x), * qc = F.ctl + CW_Q + 64 * (2 * x + 1);
            volatile LAS int* qs = (volatile LAS int*)(F.lds + TAB_OFF);
#define FETCH_(q) ({ if (F.tid == 0) qs[0] = (int)__hip_atomic_fetch_add(q, 1u, __ATOMIC_RELAXED, __HIP_MEMORY_SCOPE_AGENT); __syncthreads(); const int v_ = __builtin_amdgcn_readfirstlane(qs[0]); __syncthreads(); v_; })
#define CONV_LOOP_() do { for (;;) { REFRESH_TID(); const int v = FETCH_(qc); if (v >= 96) break; LAS float* scr = (LAS float*)(F.lds + RING_OFF + F.wave * 16384); const int base = (v * 8 + x) * 64 + F.wave * 8; \
                moe_weight_items8(F, base, scr); __syncthreads(); } } while (0)
            if (conv_first) CONV_LOOP_();
            attn_body::attn_build_lut((char*)lds + RING_OFF, WSP(float, WS_LUT));
            for (;;) { REFRESH_TID(); const int v = FETCH_(qa); if (v >= 128) break;
                const int j = 2 * x + (v & 1), qb = 31 - ((v & 63) >> 1);
                if (v < 64) attn_body::attn_run_diff<8>(A, j, qb, (char*)lds + RING_OFF); else attn_body::attn_run_fox<8>(A, j, qb, (char*)lds + RING_OFF); }
            if (!conv_first) CONV_LOOP_();
#undef FETCH_
#undef CONV_LOOP_
        }
    } SEAM(3);
    if (IN(4)) for (int rep_ = 0; rep_ <= ((MK_REP_MASK >> 4) & 1); ++rep_) { REFRESH_TID(); p4_diff_post(F); } SEAM(4);
    if (IN(5)) for (int rep_ = 0; rep_ <= ((MK_REP_MASK >> 5) & 1); ++rep_) { REFRESH_TID();
        { pg8::Gemm g{WSP(pg8::bf16_t, WS_YFOX), WSP(pg8::bf16_t, WS_WBF), M, DM, 512, nullptr, 0u}; pg8::StaticOrder S; S.init(M, DM, F.G, (int)blockIdx.x);
          epi::EpiBranch<0> E{WSP(pg8::bf16_t, WS_PROJ), nullptr, WSP(pg8::bf16_t, WS_T1)};
          pg8::gemm_phase<epi::EpiBranch<0>, pg8::StaticOrder, false, true>(F.lds + RING_OFF, g, S, E); }
        VM_WAIT(); __syncthreads();
        { pg8::Gemm g{WSP(pg8::bf16_t, WS_YD), WSP(pg8::bf16_t, WS_WBD), M, DM, 512, nullptr, 0u}; pg8::StaticOrder S; S.init(M, DM, F.G, (int)blockIdx.x);
          epi::EpiBranch<1> E{WSP(pg8::bf16_t, WS_PROJ), WSP(pg8::bf16_t, WS_T1), WSP(pg8::bf16_t, WS_MRG)};
          pg8::gemm_phase<epi::EpiBranch<1>, pg8::StaticOrder, false, true>(F.lds + RING_OFF, g, S, E); }
    } SEAM(5);
    if (IN(6)) for (int rep_ = 0; rep_ <= ((MK_REP_MASK >> 6) & 1); ++rep_) { REFRESH_TID();
        pg8::Gemm g{WSP(pg8::bf16_t, WS_MRG), WSP(pg8::bf16_t, WS_WO), M, DM, DM, nullptr, 0u}; pg8::StaticOrder S; S.init(M, DM, F.G, (int)blockIdx.x);
        epi::EpiWo E{F.in[I_X], WSP(float, WS_MOD), WSP(pg8::bf16_t, WS_X1B)};
        pg8::gemm_phase<epi::EpiWo, pg8::StaticOrder, false, true>(F.lds + RING_OFF, g, S, E);
    } SEAM(6);
    if (IN(7)) for (int rep_ = 0; rep_ <= ((MK_REP_MASK >> 7) & 1); ++rep_) { REFRESH_TID(); p7_route(F); } SEAM(7);
    if (IN(8)) for (int rep_ = 0; rep_ <= ((MK_REP_MASK >> 8) & 1); ++rep_) { REFRESH_TID();
        const int n = build_units(F, NUP / 256);
        pg8::Gemm g{WSP(pg8::bf16_t, WS_XN), WSP(pg8::bf16_t, WS_WUP), PMAX, NUP, DM / 2, WSP(int, WS_IDX), 0u}; epi::ListOrder S{(const PG8_LAS int*)(F.lds + TAB_OFF + 1024), n};
        epi::EpiUp E{F.in[I_BUP], WSP(unsigned char, WS_ACT)};
        pg8::gemm_phase<epi::EpiUp, epi::ListOrder, true, true, true, true>(F.lds + RING_OFF, g, S, E);
    } SEAM(8);
    if (IN(9)) for (int rep_ = 0; rep_ <= ((MK_REP_MASK >> 9) & 1); ++rep_) { REFRESH_TID();
        const int n = build_units(F, DM / 256);
        pg8::Gemm g{WSP(pg8::bf16_t, WS_ACT), WSP(pg8::bf16_t, WS_WDN), PMAX, DM, DFF / 2, nullptr, 0u}; epi::ListOrder S{(const PG8_LAS int*)(F.lds + TAB_OFF + 1024), n};
        epi::EpiDown E{F.in[I_BDN], WSP(float, WS_GX), WSP(pg8::bf16_t, WS_YP)};
        pg8::gemm_phase<epi::EpiDown, epi::ListOrder, true, true, false, true>(F.lds + RING_OFF, g, S, E);
    } SEAM(9);
    if (IN(10)) for (int rep_ = 0; rep_ <= ((MK_REP_MASK >> 10) & 1); ++rep_) { REFRESH_TID(); p11_final(F); }
#ifdef MK_PROBE_P2N
    if (IN(11)) { REFRESH_TID();
        pg8::Gemm g{WSP(pg8::bf16_t, WS_XN), WSP(pg8::bf16_t, WS_WIN), M, MK_PROBE_P2N, DM, nullptr, 0u}; pg8::StaticOrder S; S.init(M, MK_PROBE_P2N, F.G, (int)blockIdx.x);
        epi::EpiProj E{WSP(pg8::bf16_t, WS_PROJ), F.in[I_BMERGE], (unsigned*)(F.ctl + CW_NRM)};
        pg8::gemm_phase<epi::EpiProj, pg8::StaticOrder, true, true>(F.lds + RING_OFF, g, S, E); }
#endif
#undef IN
#undef SEAM
}

extern "C" void kernel_launch(void* const* d_in, const int* in_sizes, int n_in, void* d_out, int out_size, void* d_ws, size_t ws_size, hipStream_t stream) {
    static int grid = 0;
    if (grid == 0) {
        if (n_in != 25 || in_sizes[0] != M * DM || out_size != M * DM || ws_size < WS_END) { fprintf(stderr, "kernel_launch: unexpected problem (n_in %d, in0 %d, out %d, ws %zu, need %zu); nothing launched\n", n_in, n_in > 0 ? in_sizes[0] : -1, out_size, ws_size, (size_t)WS_END); grid = -1; return; }
        int dev = 0, cus = 0, per_cu = 0;
        if (hipGetDevice(&dev) != hipSuccess || hipDeviceGetAttribute(&cus, hipDeviceAttributeMultiprocessorCount, dev) != hipSuccess) { grid = -1; return; }
        if (hipFuncSetAttribute((const void*)skel_fwd, hipFuncAttributeMaxDynamicSharedMemorySize, LDS_BYTES) != hipSuccess) { fprintf(stderr, "kernel_launch: hipFuncSetAttribute failed\n"); grid = -1; return; }
        if (hipOccupancyMaxActiveBlocksPerMultiprocessor(&per_cu, (const void*)skel_fwd, NWAVES * 64, LDS_BYTES) != hipSuccess || per_cu < 1) { fprintf(stderr, "kernel_launch: occupancy query reports %d blocks per CU\n", per_cu); }
        (void)hipGetLastError();
        grid = cus;
    }
    if (grid < 0) return;
    if (hipMemsetAsync((char*)d_ws + WS_CTL, 0, CTL_ZERO_BYTES, stream) != hipSuccess) { fprintf(stderr, "kernel_launch: memset failed\n"); return; }
    Args a{};
    for (int i = 0; i < 25; ++i) a.in[i] = (const float*)d_in[i];
    a.out = (float*)d_out; a.ws = (unsigned char*)d_ws;
#if MK_PER_PHASE
    for (int p = 0; p < N_PHASES; ++p) { a.ph_lo = p; a.ph_hi = p + 1; hipLaunchKernelGGL(skel_fwd, dim3(grid), dim3(NWAVES * 64), LDS_BYTES, stream, a); }
#else
    { const int seq[] = MK_LAUNCH_SEQ; constexpr int nseq = sizeof(seq) / sizeof(int) / 2;
      for (int p = 0; p < nseq; ++p) { a.ph_lo = seq[2 * p]; a.ph_hi = seq[2 * p + 1];
          if (p > 0) (void)hipMemsetAsync((char*)d_ws + WS_CTL, 0, CTL_ZERO_BYTES, stream);
          hipLaunchKernelGGL(skel_fwd, dim3(grid), dim3(NWAVES * 64), LDS_BYTES, stream, a); } }
#endif
    const hipError_t le = hipPeekAtLastError();
    if (le != hipSuccess) fprintf(stderr, "kernel_launch: launch failed: %s\n", hipGetErrorName(le));
}
```

```cpp
#include <hip/hip_runtime.h>
#include <cstdio>
#include <cstdint>

constexpr int NB = 2, SEQ = 8192, DM = 1024, M = NB * SEQ;
constexpr int INCOLS = 5128, NPROJ = 5120;
constexpr int PC_FQ = 0, PC_FK = 512, PC_FV = 1024, PC_DQ = 1536, PC_DK = 2048, PC_DV = 2560, PC_G = 3072;
constexpr int NE = 32, TOPK = 4, NUP = 2048, DFF = 1024;
constexpr int PMAX = 73728;
constexpr float LOG2E = 1.4426950408889634f;
constexpr float QSCALE = 0.125f * LOG2E;
constexpr float LAMBDA_INIT = 0.2f;
namespace pg8 {
#define PG8_LAS __attribute__((address_space(3)))
typedef unsigned short bf16_t;
typedef short bf16x8 __attribute__((ext_vector_type(8)));
typedef float f32x4 __attribute__((ext_vector_type(4)));
typedef unsigned u32x4 __attribute__((ext_vector_type(4)));
constexpr int BM = 256, BK = 64, HALF = 128, HTB = HALF * BK * 2  , STAGE_BYTES = 8 * HTB, NXCD = 8, WGM = 4;

__host__ __device__ __forceinline__ int lds_byte(int r, int c) { const int st = (r >> 4) * 2 + (c >> 5), rr = r & 15, cc = c & 31, ob = rr * 64 + cc * 2; return st * 1024 + (ob ^ (((ob >> 9) & 1) << 5)); }
__host__ __device__ __forceinline__ void stage_rc(int b, int& R, int& C) { const int st = b / 1024, sb = b % 1024, swz = sb ^ (((sb >> 9) & 1) << 5); R = (st >> 1) * 16 + swz / 64; C = (st & 1) * 32 + (swz % 64) / 2; }
__host__ __device__ __forceinline__ int perm32(int rho) { const int n = rho >> 4, i = rho & 15; return 8 * (i >> 2) + 4 * n + (i & 3); }

struct Unit { int pm, pn, pb, e, ar, nr, md, ord; };
struct Gemm { const bf16_t* A; const bf16_t* Bt; int M, N, K; const int* idx; unsigned aoff2; const PG8_LAS unsigned short* tok = nullptr; };

struct StaticOrder {
    int nM, nN, nwg, G, c;
    __host__ __device__ void init(int M, int N, int G_, int c_) { nM = M / BM; nN = N / BM; nwg = nM * nN; G = G_; c = c_; }
    __host__ __device__ bool next(int i, Unit& u) const {
        const long L = (long)i * G + c; if (L >= nwg) return false;
        int wgid = (int)L; { const int q = nwg / NXCD, r = nwg % NXCD, xcd = wgid % NXCD, off = wgid / NXCD; wgid = (xcd < r ? xcd * (q + 1) : r * (q + 1) + (xcd - r) * q) + off; }
        const int nig = WGM * nN, gid = wgid / nig, fm = gid * WGM, gsz = (nM - fm) < WGM ? (nM - fm) : WGM;
        u.pm = fm + ((wgid % nig) % gsz); u.pn = (wgid % nig) / gsz; u.pb = u.pn; u.e = 0; u.ar = 0; u.nr = 0; u.md = 0; u.ord = i; return true;
    }
    __device__ __forceinline__ void a_ready(const Unit&) const {}
    __device__ __forceinline__ void done(const Unit&) const {}
};

__device__ __forceinline__ unsigned cvt_pk_bf16(float lo, float hi) { unsigned r; asm volatile("v_cvt_pk_bf16_f32 %0, %1, %2" : "=v"(r) : "v"(lo), "v"(hi)); return r; }
typedef float f32x2 __attribute__((ext_vector_type(2)));
template <class Epi, class Sched, bool ALIGN_EPI = false, bool SP2 = false, bool GATHER = false, bool FP8 = false>
__device__ __forceinline__ void gemm_phase(PG8_LAS unsigned char* lds, const Gemm g, const Sched& S, const Epi& E) {
    const int tid = threadIdx.x, wid = __builtin_amdgcn_readfirstlane(tid >> 6), lane = tid & 63, wr = wid >> 2, wc = wid & 3, fr = lane & 15, fq = lane >> 4;
    const int K = g.K, nt = K / BK;
    unsigned voffA[2], voffB[2];
#pragma unroll
    for (int i = 0; i < 2; ++i) { int R, C; stage_rc(tid * 16 + i * 8192, R, C); const int Rb = Epi::PERM ? ((R & ~31) + perm32(R & 31)) : R;
        voffA[i] = (unsigned)(R * K + C) * 2u; voffB[i] = (unsigned)(Rb * K + C) * 2u; }
    unsigned vgc[2][2] = {{0u, 0u}, {0u, 0u}}, vgn[2][2] = {{0u, 0u}, {0u, 0u}};
#define PG8_GOFF(dst, u, ord) do { _Pragma("unroll") for (int h_ = 0; h_ < 2; ++h_) _Pragma("unroll") for (int i_ = 0; i_ < 2; ++i_) { int R_, C_; stage_rc(tid * 16 + i_ * 8192, R_, C_); const int r_ = R_ + 128 * h_; \
        if ((u).md == 0) { const int tok_ = (int)g.tok[(ord) * 256 + r_]; dst[h_][i_] = (unsigned)(tok_ * K + C_) * 2u; } \
        else { dst[h_][i_] = g.aoff2 + (unsigned)((256 * (u).pm + r_) * K + C_) * 2u; } } } while (0)
    const size_t kstep = (size_t)(BK * 2);
    const size_t hstep = (size_t)HALF * K * 2;
    const size_t tstep = 2 * hstep;
    const unsigned ldsw = (unsigned)wid * 1024u;
    const int aoff = lds_byte(wr * 64 + fr, fq * 8), boff = lds_byte(wc * 32 + fr, fq * 8);
    const int aofk0 = FP8 ? lds_byte(wr * 64 + fr, fq * 16) : aoff, bofk0 = FP8 ? lds_byte(wc * 32 + fr, fq * 16) : boff;
    constexpr int KOFF = FP8 ? 16 : 1024;
#define PG8_SA(b, h) (((b) * 2 + (h)) * HTB)
#define PG8_SB(b, h) ((4 + (b) * 2 + (h)) * HTB)
#define PG8_STAGE(bufoff, gbase, voff) do { _Pragma("unroll") for (int _i = 0; _i < 2; ++_i) \
        __builtin_amdgcn_global_load_lds((const unsigned*)((const char*)(gbase) + (voff)[_i]), (PG8_LAS unsigned*)(lds + (bufoff) + ldsw + _i * 8192), 16, 0, 0); } while (0)
#define PG8_STAGE_A(bufoff, P, h, NX) do { if constexpr (GATHER) { unsigned vo_[2]; vo_[0] = (NX) ? vgn[h][0] : vgc[h][0]; vo_[1] = (NX) ? vgn[h][1] : vgc[h][1]; PG8_STAGE(bufoff, P, vo_); } \
        else { PG8_STAGE(bufoff, (P) + (h) * hstep, voffA); } } while (0)
#define PG8_LDA(dst, b, h) do { if constexpr (FP8) { _Pragma("unroll") for (int m = 0; m < 4; ++m) { dst##8[m].lo = *(const PG8_LAS i32x4_t*)(lds + PG8_SA(b, h) + aofk0 + m * 2048); dst##8[m].hi = *(const PG8_LAS i32x4_t*)(lds + PG8_SA(b, h) + aofk0 + m * 2048 + 16); } } \
        else { _Pragma("unroll") for (int m = 0; m < 4; ++m) _Pragma("unroll") for (int k = 0; k < 2; ++k) dst[m][k] = *(const PG8_LAS bf16x8*)(lds + PG8_SA(b, h) + aofk0 + m * 2048 + k * KOFF); } } while (0)
#define PG8_LDB(dst, b, h) do { if constexpr (FP8) { _Pragma("unroll") for (int n = 0; n < 2; ++n) { dst##8[n].lo = *(const PG8_LAS i32x4_t*)(lds + PG8_SB(b, h) + bofk0 + n * 2048); dst##8[n].hi = *(const PG8_LAS i32x4_t*)(lds + PG8_SB(b, h) + bofk0 + n * 2048 + 16); } } \
        else { _Pragma("unroll") for (int n = 0; n < 2; ++n) _Pragma("unroll") for (int k = 0; k < 2; ++k) dst[n][k] = *(const PG8_LAS bf16x8*)(lds + PG8_SB(b, h) + bofk0 + n * 2048 + k * KOFF); } } while (0)
#define PG8_MMA(ai, bj, At, Bt) do { if constexpr (FP8) __builtin_amdgcn_sched_barrier(0); __builtin_amdgcn_s_setprio(1); _Pragma("unroll") for (int m = 0; m < 4; ++m) _Pragma("unroll") for (int n = 0; n < 2; ++n) { \
        if constexpr (FP8) { asm volatile("s_nop 1\n\tv_mfma_scale_f32_16x16x128_f8f6f4 %0, %1, %2, %0, %3, %4 op_sel_hi:[0,0,0]" : "+v"(acc[ai][bj][m][n]) : "v"(Bt##8[n]), "v"(At##8[m]), "v"(sc_w), "v"(sc_a)); } \
        else { _Pragma("unroll") for (int k = 0; k < 2; ++k) acc[ai][bj][m][n] = __builtin_amdgcn_mfma_f32_16x16x32_bf16(Bt[n][k], At[m][k], acc[ai][bj][m][n], 0, 0, 0); } } \
        __builtin_amdgcn_s_setprio(0); if constexpr (FP8) __builtin_amdgcn_sched_barrier(0); } while (0)
#define PG8_WAIT_V(n) asm volatile("s_waitcnt vmcnt(" #n ")" ::: "memory")
#define PG8_WAIT_L(n) asm volatile("s_waitcnt lgkmcnt(" #n ")" ::: "memory")
#define PG8_BAR __builtin_amdgcn_s_barrier()
#define PG8_SCHED __builtin_amdgcn_sched_barrier(0)
    Unit cur, nxt; int ui = 0;
    if (!S.next(0, cur)) return;
    f32x4 acc[2][2][4][2];
#pragma unroll
    for (int a = 0; a < 2; ++a)
#pragma unroll
        for (int b = 0; b < 2; ++b)
#pragma unroll
            for (int m = 0; m < 4; ++m)
#pragma unroll
                for (int n = 0; n < 2; ++n) acc[a][b][m][n] = (f32x4){0.f, 0.f, 0.f, 0.f};
    typedef int i32x4_t __attribute__((ext_vector_type(4))); typedef int i32x8_t __attribute__((ext_vector_type(8)));
    bf16x8 At[4][2], B0[2][2], B1[2][2]; i32x8_t At8[4], B08[2], B18[2];
    int sc_w = 0x7a7a7a7a, sc_a = 0x7f7f7f7f; asm volatile("" : "+v"(sc_w), "+v"(sc_a));
    const char* cA = (const char*)g.A + (GATHER ? (size_t)0 : (size_t)cur.pm * tstep); const char* cB = (const char*)g.Bt + (size_t)cur.pb * tstep;
    if constexpr (GATHER) PG8_GOFF(vgc, cur, 0);
    S.a_ready(cur);
    if constexpr (SP2) {
        PG8_STAGE(PG8_SB(0, 0), cB, voffB); PG8_STAGE(PG8_SB(0, 1), cB + hstep, voffB); PG8_STAGE_A(PG8_SA(0, 0), cA, 0, false); PG8_STAGE_A(PG8_SA(0, 1), cA, 1, false);
        if (wr == 1) PG8_BAR;
        PG8_WAIT_V(2); PG8_BAR;
        PG8_STAGE(PG8_SB(1, 0), cB + kstep, voffB); PG8_STAGE_A(PG8_SA(1, 0), cA + kstep, 0, false); PG8_STAGE(PG8_SB(1, 1), cB + hstep + kstep, voffB);
        PG8_WAIT_V(6); PG8_BAR;
    } else {
        PG8_STAGE(PG8_SB(0, 0), cB, voffB); PG8_STAGE_A(PG8_SA(0, 0), cA, 0, false); PG8_STAGE(PG8_SB(0, 1), cB + hstep, voffB); PG8_STAGE_A(PG8_SA(0, 1), cA, 1, false);
        if (wr == 1) PG8_BAR;
        PG8_WAIT_V(4); PG8_BAR;
        PG8_STAGE(PG8_SB(1, 0), cB + kstep, voffB); PG8_STAGE_A(PG8_SA(1, 0), cA + kstep, 0, false); PG8_STAGE(PG8_SB(1, 1), cB + hstep + kstep, voffB);
        PG8_WAIT_V(6); PG8_BAR;
    }
    for (;;) {
        const bool has_next = S.next(ui + 1, nxt);
        if constexpr (GATHER) { if (has_next) { PG8_GOFF(vgn, nxt, ui + 1); } else { _Pragma("unroll") for (int h_ = 0; h_ < 2; ++h_) _Pragma("unroll") for (int i_ = 0; i_ < 2; ++i_) vgn[h_][i_] = vgc[h_][i_]; } }
        const char* nA = (has_next && !GATHER) ? (const char*)g.A + (size_t)nxt.pm * tstep : cA; const char* nB = has_next ? (const char*)g.Bt + (size_t)nxt.pb * tstep : cB;
#pragma nounroll
        for (int t = 0; t < nt; t += 2) {
            const bool last = (t == nt - 2);
            const char* a1 = cA + (size_t)(t + 1) * kstep;
            const char* a2 = last ? nA : cA + (size_t)(t + 2) * kstep; const char* b2 = last ? nB : cB + (size_t)(t + 2) * kstep;
            const char* a3 = a2 + kstep; const char* b3 = b2 + kstep;
            if (last && has_next) S.a_ready(nxt);
            if constexpr (SP2) {
            PG8_LDB(B0, 0, 0); PG8_LDB(B1, 0, 1); PG8_SCHED; PG8_LDA(At, 0, 0); PG8_STAGE_A(PG8_SA(1, 1), a1, 1, false);
            PG8_WAIT_V(8); PG8_WAIT_L(0); PG8_BAR; PG8_MMA(0, 0, At, B0); PG8_MMA(0, 1, At, B1); PG8_BAR; PG8_SCHED;
            PG8_LDA(At, 0, 1); PG8_STAGE(PG8_SB(0, 0), b2, voffB); PG8_STAGE(PG8_SB(0, 1), b2 + hstep, voffB); PG8_STAGE_A(PG8_SA(0, 0), a2, 0, last);
            PG8_WAIT_V(8); PG8_WAIT_L(0); PG8_BAR; PG8_MMA(1, 0, At, B0); PG8_MMA(1, 1, At, B1); PG8_BAR; PG8_SCHED;
            PG8_LDB(B0, 1, 0); PG8_LDB(B1, 1, 1); PG8_SCHED; PG8_LDA(At, 1, 0); PG8_STAGE_A(PG8_SA(0, 1), a2, 1, last);
            PG8_WAIT_V(8); PG8_WAIT_L(0); PG8_BAR; PG8_MMA(0, 0, At, B0); PG8_MMA(0, 1, At, B1); PG8_BAR; PG8_SCHED;
            PG8_LDA(At, 1, 1); PG8_STAGE(PG8_SB(1, 0), b3, voffB); PG8_STAGE(PG8_SB(1, 1), b3 + hstep, voffB); PG8_STAGE_A(PG8_SA(1, 0), a3, 0, last);
            PG8_WAIT_V(8); PG8_WAIT_L(0); PG8_BAR; PG8_MMA(1, 0, At, B0); PG8_MMA(1, 1, At, B1); PG8_BAR; PG8_SCHED;
            } else {
            PG8_LDB(B0, 0, 0); PG8_SCHED; PG8_LDA(At, 0, 0); PG8_STAGE_A(PG8_SA(1, 1), a1, 1, false);
            PG8_WAIT_L(8); PG8_BAR; PG8_WAIT_L(0); PG8_MMA(0, 0, At, B0); PG8_BAR; PG8_SCHED;
            PG8_LDB(B1, 0, 1); PG8_STAGE(PG8_SB(0, 0), b2, voffB);
            PG8_BAR; PG8_WAIT_L(0); PG8_MMA(0, 1, At, B1); PG8_BAR;
            PG8_LDA(At, 0, 1); PG8_STAGE_A(PG8_SA(0, 0), a2, 0, last);
            PG8_BAR; PG8_WAIT_L(0); PG8_MMA(1, 0, At, B0); PG8_BAR; PG8_SCHED;
            PG8_STAGE(PG8_SB(0, 1), b2 + hstep, voffB);
            PG8_WAIT_V(6); PG8_BAR; PG8_MMA(1, 1, At, B1); PG8_BAR;
            PG8_LDB(B0, 1, 0); PG8_SCHED; PG8_LDA(At, 1, 0); PG8_STAGE_A(PG8_SA(0, 1), a2, 1, last);
            PG8_WAIT_L(8); PG8_BAR; PG8_WAIT_L(0); PG8_MMA(0, 0, At, B0); PG8_BAR; PG8_SCHED;
            PG8_LDB(B1, 1, 1); PG8_STAGE(PG8_SB(1, 0), b3, voffB);
            PG8_BAR; PG8_WAIT_L(0); PG8_MMA(0, 1, At, B1); PG8_BAR;
            PG8_LDA(At, 1, 1); PG8_STAGE_A(PG8_SA(1, 0), a3, 0, last);
            PG8_BAR; PG8_WAIT_L(0); PG8_MMA(1, 0, At, B0); PG8_BAR; PG8_SCHED;
            PG8_STAGE(PG8_SB(1, 1), b3 + hstep, voffB);
            PG8_WAIT_V(6); PG8_BAR; PG8_MMA(1, 1, At, B1); PG8_BAR;
            }
        }
        if constexpr (ALIGN_EPI) { if (wr == 0) PG8_BAR; }
        if constexpr (FP8) asm volatile("s_nop 15\n\ts_nop 15" ::: "memory");
        if constexpr (!Epi::AFTER_DRAIN) { int fr_ = fr, fq_ = fq; asm volatile("" : "+v"(fr_), "+v"(fq_));
            E(acc, cur, wr, wc, fr_, fq_); S.done(cur); }
        if (!has_next) break;
#pragma unroll
        for (int a = 0; a < 2; ++a)
#pragma unroll
            for (int b = 0; b < 2; ++b)
#pragma unroll
                for (int m = 0; m < 4; ++m)
#pragma unroll
                    for (int n = 0; n < 2; ++n) acc[a][b][m][n] = (f32x4){0.f, 0.f, 0.f, 0.f};
        cur = nxt; cA = nA; cB = nB; ++ui;
        if constexpr (GATHER) { _Pragma("unroll") for (int h_ = 0; h_ < 2; ++h_) _Pragma("unroll") for (int i_ = 0; i_ < 2; ++i_) vgc[h_][i_] = vgn[h_][i_]; }
        if constexpr (ALIGN_EPI) { if (wr == 1) PG8_BAR; }
    }
    PG8_WAIT_V(0);
    if constexpr (!ALIGN_EPI) { if (wr == 0) PG8_BAR; }
    PG8_BAR;
    if constexpr (Epi::AFTER_DRAIN) { E.fused(acc, cur, wr, wc, fr, fq, lds, wid, lane); S.done(cur); }
#undef PG8_SA
#undef PG8_SB
#undef PG8_STAGE
#undef PG8_STAGE_A
#undef PG8_GOFF
#undef PG8_LDA
#undef PG8_LDB
#undef PG8_MMA
#undef PG8_WAIT_V
#undef PG8_WAIT_L
#undef PG8_BAR
#undef PG8_SCHED
}
}
namespace epi {
using pg8::f32x4; using pg8::u32x4; using pg8::Unit; using pg8::bf16_t; using pg8::BM; using pg8::HALF; using pg8::cvt_pk_bf16;
typedef unsigned u32x2 __attribute__((ext_vector_type(2)));
__device__ __forceinline__ float bflo(unsigned w) { return __uint_as_float(w << 16); }
__device__ __forceinline__ float bfhi(unsigned w) { return __uint_as_float(w & 0xffff0000u); }
__device__ __forceinline__ float sigmoidf_fast(float z) { return __builtin_amdgcn_rcpf(1.0f + __builtin_amdgcn_exp2f(-z * LOG2E)); }

struct EpiProj {
    static constexpr bool PERM = true, AFTER_DRAIN = false;
    bf16_t* O; const PG8_LAS float* bmerge; unsigned* nrm;
    __device__ __forceinline__ void operator()(const f32x4 (&acc)[2][2][4][2], const Unit& u, int wr, int wc, int fr, int fq) const {
        const int row0 = u.pm * BM + wr * 64 + fr, col0 = u.pn * BM + wc * 32 + 8 * fq;
        const bool isq = (u.pn < 2) || (u.pn == 6) || (u.pn == 7), isg = (u.pn >= 12);
        const float sc = isq ? QSCALE : 1.0f; const bool isn = (u.pn < 4); float nmx[2] = {0.f, 0.f};
        f32x4 bv[2][2];
#pragma unroll
        for (int bj = 0; bj < 2; ++bj)
#pragma unroll
            for (int n = 0; n < 2; ++n) bv[bj][n] = isg ? *(const PG8_LAS f32x4*)(bmerge + (col0 - PC_G) + bj * HALF + 4 * n) : (f32x4){0.f, 0.f, 0.f, 0.f};
#pragma unroll
        for (int ai = 0; ai < 2; ++ai)
#pragma unroll
            for (int m = 0; m < 4; ++m) { bf16_t* rowp = O + (size_t)(row0 + ai * HALF + m * 16) * NPROJ + col0;
#pragma unroll
                for (int bj = 0; bj < 2; ++bj) { f32x4 v0 = acc[ai][bj][m][0], v1 = acc[ai][bj][m][1];
                    if (isg) { v0 = v0 + bv[bj][0]; v1 = v1 + bv[bj][1];
#pragma unroll
                        for (int e = 0; e < 4; ++e) { v0[e] = sigmoidf_fast(v0[e]); v1[e] = sigmoidf_fast(v1[e]); } }
                    else { v0 = v0 * sc; v1 = v1 * sc; }
                    if (isn) { float ss = (v0[0] * v0[0] + v0[1] * v0[1]) + (v0[2] * v0[2] + v0[3] * v0[3]) + (v1[0] * v1[0] + v1[1] * v1[1]) + (v1[2] * v1[2] + v1[3] * v1[3]);
                        ss += __shfl_xor(ss, 16); ss += __shfl_xor(ss, 32); nmx[bj] = fmaxf(nmx[bj], ss); }
                    u32x4 w; w.x = cvt_pk_bf16(v0[0], v0[1]); w.y = cvt_pk_bf16(v0[2], v0[3]); w.z = cvt_pk_bf16(v1[0], v1[1]); w.w = cvt_pk_bf16(v1[2], v1[3]);
                    *(u32x4*)(rowp + bj * HALF) = w; } }
        if (isn) {
#pragma unroll
            for (int bj = 0; bj < 2; ++bj) { float v = nmx[bj]; v = fmaxf(v, __shfl_xor(v, 1)); v = fmaxf(v, __shfl_xor(v, 2)); v = fmaxf(v, __shfl_xor(v, 4)); v = fmaxf(v, __shfl_xor(v, 8));
                if (fr == 0 && fq == 0) atomicMax(nrm + ((((u.pn >> 1) * 2 + (u.pm * BM) / SEQ) * 8 + 4 * (u.pn & 1) + 2 * bj + (wc >> 1)) * 2 + (wc & 1)), __float_as_uint(v)); } }
    }
};
template <int MODE> struct EpiBranch {
    static constexpr bool PERM = true, AFTER_DRAIN = false;
    const bf16_t* PROJ; const bf16_t* T1in; bf16_t* O;
    __device__ __forceinline__ void operator()(const f32x4 (&acc)[2][2][4][2], const Unit& u, int wr, int wc, int fr, int fq) const {
        const int row0 = u.pm * BM + wr * 64 + fr, col0 = u.pn * BM + wc * 32 + 8 * fq;
#pragma unroll
        for (int ai = 0; ai < 2; ++ai) { u32x4 gg[4][2], tt[4][2];
#pragma unroll
            for (int m = 0; m < 4; ++m)
#pragma unroll
                for (int bj = 0; bj < 2; ++bj) { const size_t row = (size_t)(row0 + ai * HALF + m * 16); const int col = col0 + bj * HALF;
                    gg[m][bj] = *(const u32x4*)(PROJ + row * NPROJ + PC_G + MODE * 1024 + col); if (MODE == 1) tt[m][bj] = *(const u32x4*)(T1in + row * DM + col); }
            asm volatile("" ::: "memory");
#pragma unroll
            for (int m = 0; m < 4; ++m)
#pragma unroll
                for (int bj = 0; bj < 2; ++bj) { const size_t row = (size_t)(row0 + ai * HALF + m * 16); const int col = col0 + bj * HALF; const u32x4 g = gg[m][bj];
                    f32x4 v0 = acc[ai][bj][m][0], v1 = acc[ai][bj][m][1];
                    v0[0] *= bflo(g.x); v0[1] *= bfhi(g.x); v0[2] *= bflo(g.y); v0[3] *= bfhi(g.y); v1[0] *= bflo(g.z); v1[1] *= bfhi(g.z); v1[2] *= bflo(g.w); v1[3] *= bfhi(g.w);
                    if (MODE == 1) { const u32x4 t = tt[m][bj];
                        v0[0] += bflo(t.x); v0[1] += bfhi(t.x); v0[2] += bflo(t.y); v0[3] += bfhi(t.y); v1[0] += bflo(t.z); v1[1] += bfhi(t.z); v1[2] += bflo(t.w); v1[3] += bfhi(t.w); }
                    if (MODE == 1) {
                        int w0 = 0, w1 = 0;
                        w0 = __builtin_amdgcn_cvt_pk_fp8_f32(__builtin_amdgcn_fmed3f(v0[0] * 8.0f, -448.0f, 448.0f), __builtin_amdgcn_fmed3f(v0[1] * 8.0f, -448.0f, 448.0f), w0, false); w0 = __builtin_amdgcn_cvt_pk_fp8_f32(__builtin_amdgcn_fmed3f(v0[2] * 8.0f, -448.0f, 448.0f), __builtin_amdgcn_fmed3f(v0[3] * 8.0f, -448.0f, 448.0f), w0, true);
                        w1 = __builtin_amdgcn_cvt_pk_fp8_f32(__builtin_amdgcn_fmed3f(v1[0] * 8.0f, -448.0f, 448.0f), __builtin_amdgcn_fmed3f(v1[1] * 8.0f, -448.0f, 448.0f), w1, false); w1 = __builtin_amdgcn_cvt_pk_fp8_f32(__builtin_amdgcn_fmed3f(v1[2] * 8.0f, -448.0f, 448.0f), __builtin_amdgcn_fmed3f(v1[3] * 8.0f, -448.0f, 448.0f), w1, true);
                        *(unsigned long long*)((unsigned char*)O + row * DM + col) = (unsigned long long)(unsigned)w0 | ((unsigned long long)(unsigned)w1 << 32); }
                    else { u32x4 w; w.x = cvt_pk_bf16(v0[0], v0[1]); w.y = cvt_pk_bf16(v0[2], v0[3]); w.z = cvt_pk_bf16(v1[0], v1[1]); w.w = cvt_pk_bf16(v1[2], v1[3]);
                        *(u32x4*)(O + row * DM + col) = w; } }
            asm volatile("" ::: "memory"); }
    }
};
struct EpiWo {
    static constexpr bool PERM = true, AFTER_DRAIN = false;
    const float* x; const float* mod; bf16_t* X1;
    __device__ __forceinline__ void operator()(const f32x4 (&acc)[2][2][4][2], const Unit& u, int wr, int wc, int fr, int fq) const {
        const int row0 = u.pm * BM + wr * 64 + fr, col0 = u.pn * BM + wc * 32 + 8 * fq;
        const float* g1 = mod + (size_t)((u.pm * BM) / SEQ) * (6 * DM) + 2 * DM;
        f32x4 gv[2][2];
#pragma unroll
        for (int bj = 0; bj < 2; ++bj)
#pragma unroll
            for (int n = 0; n < 2; ++n) gv[bj][n] = *(const f32x4*)(g1 + col0 + bj * HALF + n * 4) * 0.125f;
#pragma unroll
        for (int ai = 0; ai < 2; ++ai)
#pragma unroll
          for (int mh = 0; mh < 2; ++mh) { f32x4 xv[2][2][2];
#pragma unroll
            for (int m2 = 0; m2 < 2; ++m2)
#pragma unroll
                for (int bj = 0; bj < 2; ++bj)
#pragma unroll
                    for (int n = 0; n < 2; ++n) xv[m2][bj][n] = *(const f32x4*)(x + (size_t)(row0 + ai * HALF + (2 * mh + m2) * 16) * DM + col0 + bj * HALF + n * 4);
            asm volatile("" ::: "memory");
#pragma unroll
            for (int m2 = 0; m2 < 2; ++m2)
#pragma unroll
                for (int bj = 0; bj < 2; ++bj) { const f32x4 v0 = xv[m2][bj][0] + gv[bj][0] * acc[ai][bj][2 * mh + m2][0], v1 = xv[m2][bj][1] + gv[bj][1] * acc[ai][bj][2 * mh + m2][1];
                    u32x4 w; w.x = cvt_pk_bf16(v0[0], v0[1]); w.y = cvt_pk_bf16(v0[2], v0[3]); w.z = cvt_pk_bf16(v1[0], v1[1]); w.w = cvt_pk_bf16(v1[2], v1[3]);
                    *(u32x4*)(X1 + (size_t)(row0 + ai * HALF + (2 * mh + m2) * 16) * DM + col0 + bj * HALF) = w; }
            asm volatile("" ::: "memory"); }
    }
};
struct EpiUp {
    static constexpr bool PERM = true, AFTER_DRAIN = false;
    const PG8_LAS float* lbias; unsigned char* ACT;
    __device__ __forceinline__ float act1(float a, float b) const {
        const float glu = fminf(a, 7.0f), lin = fminf(fmaxf(b, -7.0f), 7.0f);
        return glu * sigmoidf_fast(1.702f * glu) * (lin + 1.0f);
    }
    __device__ __forceinline__ void operator()(const f32x4 (&acc)[2][2][4][2], const Unit& u, int wr, int wc, int fr, int fq) const {
        const int row0 = u.pm * BM + wr * 64 + fr, col0 = u.pn * BM + wc * 32 + 8 * fq;
        const PG8_LAS float* bb = lbias + u.ord * 256 + wc * 32 + 8 * fq;
        f32x4 bv[2][2];
#pragma unroll
        for (int bj = 0; bj < 2; ++bj)
#pragma unroll
            for (int n = 0; n < 2; ++n) bv[bj][n] = *(const PG8_LAS f32x4*)(bb + bj * HALF + 4 * n);
#pragma unroll
        for (int ai = 0; ai < 2; ++ai)
#pragma unroll
            for (int m = 0; m < 4; ++m) { unsigned char* rowp = ACT + (size_t)(row0 + ai * HALF + m * 16) * DFF + (col0 >> 1);
#pragma unroll
                for (int bj = 0; bj < 2; ++bj) { const f32x4 v0 = acc[ai][bj][m][0] + bv[bj][0], v1 = acc[ai][bj][m][1] + bv[bj][1];
                    int w = 0; w = __builtin_amdgcn_cvt_pk_fp8_f32(act1(v0[0], v0[1]), act1(v0[2], v0[3]), w, false); w = __builtin_amdgcn_cvt_pk_fp8_f32(act1(v1[0], v1[1]), act1(v1[2], v1[3]), w, true);
                    *(unsigned*)(rowp + bj * (HALF / 2)) = (unsigned)w; } }
    }
};
struct EpiDown {
    static constexpr bool PERM = true, AFTER_DRAIN = false;
    const PG8_LAS float* lbias; const PG8_LAS float* lgate; bf16_t* YP;
    __device__ __forceinline__ void operator()(const f32x4 (&acc)[2][2][4][2], const Unit& u, int wr, int wc, int fr, int fq) const {
        const int row0 = u.pm * BM + wr * 64 + fr, col0 = u.pn * BM + wc * 32 + 8 * fq;
        const PG8_LAS float* bb = lbias + u.ord * 256 + wc * 32 + 8 * fq;
        f32x4 bv[2][2]; float gts[2][4];
#pragma unroll
        for (int bj = 0; bj < 2; ++bj)
#pragma unroll
            for (int n = 0; n < 2; ++n) bv[bj][n] = *(const PG8_LAS f32x4*)(bb + bj * HALF + 4 * n);
#pragma unroll
        for (int ai = 0; ai < 2; ++ai)
#pragma unroll
            for (int m = 0; m < 4; ++m) gts[ai][m] = lgate[u.ord * 256 + (wr * 64 + fr + ai * HALF + m * 16)];
#pragma unroll
        for (int ai = 0; ai < 2; ++ai)
#pragma unroll
            for (int m = 0; m < 4; ++m) { const size_t row = (size_t)(row0 + ai * HALF + m * 16); const float gt = gts[ai][m]; bf16_t* rowp = YP + row * DM + col0;
#pragma unroll
                for (int bj = 0; bj < 2; ++bj) { const f32x4 v0 = (acc[ai][bj][m][0] + bv[bj][0]) * gt, v1 = (acc[ai][bj][m][1] + bv[bj][1]) * gt;
                    u32x4 w; w.x = cvt_pk_bf16(v0[0], v0[1]); w.y = cvt_pk_bf16(v0[2], v0[3]); w.z = cvt_pk_bf16(v1[0], v1[1]); w.w = cvt_pk_bf16(v1[2], v1[3]);
                    *(u32x4*)(rowp + bj * HALF) = w; } }
    }
};
struct ListOrder {
    const PG8_LAS int* lst; int n;
    __device__ __forceinline__ bool next(int i, Unit& u) const { if (i >= n) return false; u.pm = __builtin_amdgcn_readfirstlane(lst[6 * i]); u.pn = __builtin_amdgcn_readfirstlane(lst[6 * i + 1]); u.pb = __builtin_amdgcn_readfirstlane(lst[6 * i + 2]); u.e = __builtin_amdgcn_readfirstlane(lst[6 * i + 3]);
        u.ar = __builtin_amdgcn_readfirstlane(lst[6 * i + 4]); u.nr = __builtin_amdgcn_readfirstlane(lst[6 * i + 5]); u.md = 0; u.ord = i; return true; }
    __device__ __forceinline__ void a_ready(const Unit&) const {}
    __device__ __forceinline__ void done(const Unit&) const {}
};
}
constexpr size_t MiB = 1u << 20;
constexpr int ECAP = 16384;
constexpr size_t WS_CTL = 0, CTL_ZERO_BYTES = 1 * MiB;
constexpr size_t WS_MOD = 1 * MiB;
constexpr size_t WS_SCAL = WS_MOD + 64 * 1024;
constexpr size_t WS_LUT = WS_MOD + 128 * 1024;
constexpr size_t WS_FG = WS_MOD + 512 * 1024;
constexpr size_t WS_BT = WS_MOD + 256 * 1024;
constexpr size_t WS_FLOC = 2 * MiB;
constexpr size_t WS_F2 = 3 * MiB;
constexpr size_t WS_TOPE = 4 * MiB, WS_RANK = WS_TOPE + 256 * 1024, WS_GATE = WS_RANK + 256 * 1024, WS_SLOT = WS_GATE + 256 * 1024;
constexpr size_t WS_SGATE = 5 * MiB;
constexpr size_t WS_WIN = 6 * MiB;
constexpr size_t WS_WBF = 16 * MiB, WS_WBD = 17 * MiB, WS_WO = 18 * MiB;
constexpr size_t WS_WUP = 20 * MiB;
constexpr size_t WS_WDN = 148 * MiB;
constexpr size_t WS_XN = 212 * MiB;
constexpr size_t WS_PROJ = 244 * MiB;
constexpr size_t WS_XG = WS_PROJ;
constexpr size_t WS_YFOX = 404 * MiB;
constexpr size_t WS_OD = 420 * MiB;
constexpr size_t WS_YD = 452 * MiB;
constexpr size_t WS_T1 = 468 * MiB;
constexpr size_t WS_MRG = 500 * MiB;
constexpr size_t WS_ACT = WS_PROJ;
constexpr size_t WS_YP = WS_YFOX;
constexpr size_t WS_X1B = 548 * MiB;
constexpr size_t WS_KA = 820 * MiB;
constexpr size_t WS_IDX = 822 * MiB;
constexpr size_t WS_GX = 824 * MiB;
constexpr size_t WS_END = 826 * MiB;
static_assert(WS_PROJ + (size_t)M * NPROJ * 2 <= WS_YFOX && WS_ACT + (size_t)PMAX * DM * 2 <= WS_YFOX && WS_MRG + (size_t)M * DM * 2 <= WS_YP + (size_t)PMAX * DM * 2 && WS_YP + (size_t)PMAX * DM * 2 <= WS_KA, "d_ws map");
constexpr int CW_TMO = 0;
constexpr int CW_CNT = 1024;
constexpr int CW_NRM = 3200;
constexpr int CW_BAR = 4096;
constexpr int CW_PAN = 16384;
constexpr int CW_Q = 8192;

constexpr int RING_OFF = 0, RING_BYTES = 131072;
constexpr int LDSCTL_OFF = RING_BYTES, MISC_OFF = LDSCTL_OFF + 320;
constexpr int TAB_OFF = LDSCTL_OFF + 1024;
constexpr int TOK_OFF = LDSCTL_OFF + 9216, TOK_UNITS = 10;
constexpr int LDS_BYTES = 163840;
constexpr int EPI_OFF = 147456, EPI_UNITS_UP = 10, EPI_UNITS_DN = 6;
constexpr int NWAVES = 8;
#define GAS __attribute__((address_space(1)))
#define LAS __attribute__((address_space(3)))
typedef unsigned short bf16;
typedef unsigned v4u __attribute__((ext_vector_type(4)));
typedef float f32x4 __attribute__((ext_vector_type(4)));
typedef short bf16x8 __attribute__((ext_vector_type(8)));
typedef GAS unsigned gu32;
typedef GAS unsigned long long gu64;
#define RLX_AGENT __ATOMIC_RELAXED, __HIP_MEMORY_SCOPE_AGENT
#define LDS_WAIT() asm volatile("s_waitcnt lgkmcnt(0)" ::: "memory")
#define VM_WAIT() asm volatile("s_waitcnt vmcnt(0)" ::: "memory")
__device__ __forceinline__ unsigned long long rt() { return __builtin_amdgcn_s_memrealtime(); }
__device__ __forceinline__ unsigned f2bf(float f) { unsigned u = __builtin_bit_cast(unsigned, f); return (u + 0x7fffu + ((u >> 16) & 1u)) >> 16; }
__device__ __forceinline__ unsigned pk2(float lo, float hi) { return f2bf(lo) | (f2bf(hi) << 16); }

#define XB_TMO      128
#define XB_XCNT(j)  (256  + 64 * (j))
#define XB_XSUB(j)  (1280 + 64 * (j))
#define XB_XGEN(j)  (2304 + 64 * (j))
#define XB_TOP      3328
#define XB_TOPGEN   3392
#define XCD_BAR_WORDS 3456
#define XB_SPIN_CAP (1u << 18)

__device__ __forceinline__ unsigned xb_ld(unsigned* p)              { return __hip_atomic_load(p, __ATOMIC_RELAXED, __HIP_MEMORY_SCOPE_AGENT); }
__device__ __forceinline__ unsigned xb_add(unsigned* p, unsigned v) { return __hip_atomic_fetch_add(p, v, __ATOMIC_RELAXED, __HIP_MEMORY_SCOPE_AGENT); }
__device__ __forceinline__ unsigned xb_xcc_id() { return (unsigned)__builtin_amdgcn_s_getreg((3 << 11) | 20) & 0xFu; }
#define XB_SPIN(cond, bar) do { unsigned _sp = 0; while (cond) { __builtin_amdgcn_s_sleep(1); \
    if ((++_sp & 255u) == 0u) { if (xb_ld(&(bar)[XB_TMO])) break; if (_sp > XB_SPIN_CAP) { atomicAdd(&(bar)[XB_TMO], 1u); break; } } } } while (0)

struct XcdBarrier {
    unsigned* bar; unsigned x;
    volatile LAS unsigned* st;
};

__device__ __forceinline__ XcdBarrier xcd_barrier_post(unsigned* bar, volatile LAS unsigned* st) {
    XcdBarrier b; b.bar = bar; b.x = xb_xcc_id(); b.st = st;
    if (threadIdx.x == 0) (void)xb_add(&bar[XB_XCNT(b.x)], 1u);
    return b;
}
__device__ __forceinline__ void xcd_barrier_complete(unsigned* bar, unsigned x, unsigned& nloc, unsigned& nx) {
    const unsigned G = gridDim.x * gridDim.y * gridDim.z;
    unsigned sum, cnt, mine, sp = 0u;
    for (;;) {
        sum = 0u; cnt = 0u; mine = 0u;
#pragma unroll
        for (unsigned j = 0; j < 16; ++j) { const unsigned c = xb_ld(&bar[XB_XCNT(j)]); sum += c; cnt += (c > 0u) ? 1u : 0u; mine = (j == x) ? c : mine; }
        if (sum == G) break;
        __builtin_amdgcn_s_sleep(1);
        if ((++sp & 255u) == 0u) { if (xb_ld(&bar[XB_TMO])) break; if (sp > XB_SPIN_CAP) { atomicAdd(&bar[XB_TMO], 1u); break; } }
    }
    nloc = mine > 0u ? mine : 1u; nx = cnt > 0u ? cnt : 1u;
}

__device__ __forceinline__ void xcd_barrier(const XcdBarrier& b) {
    asm volatile("s_waitcnt vmcnt(0)" ::: "memory");
    __syncthreads();
    if (threadIdx.x == 0) {
        unsigned* bar = b.bar;
        __builtin_amdgcn_s_waitcnt(0);
        unsigned nloc = b.st[0], nx = b.st[1];
        if (nloc == 0u) { xcd_barrier_complete(bar, b.x, nloc, nx); b.st[0] = nloc; b.st[1] = nx; }
        const unsigned old = xb_add(&bar[XB_XSUB(b.x)], 1u);
        const unsigned gen = old / nloc;
        if (old + 1u == (gen + 1u) * nloc) {
            __builtin_amdgcn_fence(__ATOMIC_RELEASE, "agent");
            asm volatile("s_waitcnt vmcnt(0)" ::: "memory");
            const unsigned og = xb_add(&bar[XB_TOP], 1u);
            const unsigned tg = og / nx;
            if (og + 1u == (tg + 1u) * nx) xb_add(&bar[XB_TOPGEN], 1u);
            else XB_SPIN(xb_ld(&bar[XB_TOPGEN]) == tg, bar);
            __builtin_amdgcn_fence(__ATOMIC_ACQUIRE, "agent");
            xb_add(&bar[XB_XGEN(b.x)], 1u);
            asm volatile("s_waitcnt vmcnt(0)" ::: "memory");
        } else {
            XB_SPIN(xb_ld(&bar[XB_XGEN(b.x)]) == gen, bar);
            __builtin_amdgcn_fence(__ATOMIC_ACQUIRE, "agent");
            asm volatile("s_waitcnt vmcnt(0)" ::: "memory");
        }
    }
    __syncthreads();
}
#include <hip/hip_bf16.h>
#include <cmath>
namespace attn_body {
using bf16=__hip_bfloat16;
using bf16x8=__attribute__((ext_vector_type(8)))short;
using s16x4=__attribute__((ext_vector_type(4)))short;
using f32x16=__attribute__((ext_vector_type(16)))float;
using u32x4=__attribute__((ext_vector_type(4)))unsigned;
using f32x4_t=__attribute__((ext_vector_type(4)))float;
constexpr int D=64,PITCH=NPROJ;
constexpr int NW=8,QBLK=32,QB=QBLK*NW,KVBLK=64,NQB=SEQ/QB;
constexpr int ATTN_UNIT_ROWS=QB;
__device__ __forceinline__ int crow(int r,int hi){return (r&3)+8*(r>>2)+4*hi;}
#define SBAR() __builtin_amdgcn_sched_barrier(0)
__device__ __forceinline__ void cmask(f32x16&p0,f32x16&p1,int jb,int qrel,int hi){
  const float NEG=-INFINITY; int kb=64*jb+4*hi;
  #pragma unroll
  for(int r=0;r<16;++r){int kv=kb+(r&3)+8*(r>>2); if(kv>qrel)p0[r]=NEG; if(kv+32>qrel)p1[r]=NEG;}
}

constexpr int NSLOT=3, SLOTB=9216;
constexpr int LDS_K=0, LDS_V=NSLOT*SLOTB, LDS_WS=2*NSLOT*SLOTB, LDS_OST=LDS_WS+NW*64*4, LDS_BYTES=LDS_OST+NW*4096;
constexpr int LDS_LUT=LDS_BYTES, LUTN=644, LDS_TOTAL=LDS_LUT+4*LUTN*4;
static_assert(LDS_TOTAL<=131072 && LDS_LUT%16==0, "attention LDS map");
constexpr float C2=0.125f*1.4426950408889634f;
__device__ __forceinline__ void glds16(const void*gsrc,unsigned lds_dst){unsigned keep;
  asm volatile("s_mov_b32 %0, m0\n\ts_mov_b32 m0, %2\n\ts_nop 0\n\tglobal_load_lds_dwordx4 %1, off\n\ts_mov_b32 m0, %0":"=&s"(keep):"v"(gsrc),"s"(lds_dst):"memory");}
__device__ __forceinline__ float max3f(float a,float b,float c){float r;asm("v_max3_f32 %0, %1, %2, %3":"=v"(r):"v"(a),"v"(b),"v"(c));return r;}
__device__ __forceinline__ float max2f(float a,float b){float r;asm("v_max_f32_e32 %0, %1, %2":"=v"(r):"v"(a),"v"(b));return r;}
__device__ __forceinline__ float fadd_s(float a,float b){float r;asm("v_add_f32_e32 %0, %1, %2":"=v"(r):"v"(a),"v"(b));return r;}
__device__ __forceinline__ float fsub_s(float a,float b){float r;asm("v_sub_f32_e32 %0, %1, %2":"=v"(r):"v"(a),"v"(b));return r;}
typedef float f32x2_t __attribute__((ext_vector_type(2))); typedef __bf16 bf16x2_t __attribute__((ext_vector_type(2)));
__device__ __forceinline__ unsigned cvtpk_s(float lo,float hi){f32x2_t v={lo,hi};bf16x2_t b=__builtin_convertvector(v,bf16x2_t);return __builtin_bit_cast(unsigned,b);}
#define WAIT_BAR(N) asm volatile("s_waitcnt vmcnt(" #N ") lgkmcnt(0)\n\ts_barrier":::"memory")

__device__ __forceinline__ void qkt(f32x16&p0,f32x16&p1,const char*Kslot,const bf16x8*qr,const f32x16&c0,const f32x16&c1,int r32,int hi){
  const char*kb=Kslot+hi*1024+r32*16;
  #pragma unroll
  for(int d0=0;d0<4;++d0){
    const bf16x8 b0=*reinterpret_cast<const bf16x8*>(kb+d0*2048);
    const bf16x8 b1=*reinterpret_cast<const bf16x8*>(kb+d0*2048+512);
    if(d0==0){p0=__builtin_amdgcn_mfma_f32_32x32x16_bf16(b0,qr[0],c0,0,0,0);p1=__builtin_amdgcn_mfma_f32_32x32x16_bf16(b1,qr[0],c1,0,0,0);}
    else{p0=__builtin_amdgcn_mfma_f32_32x32x16_bf16(b0,qr[d0],p0,0,0,0);p1=__builtin_amdgcn_mfma_f32_32x32x16_bf16(b1,qr[d0],p1,0,0,0);}}
}
__device__ __forceinline__ bf16x8 make_qaug(float v,int hi){
  const unsigned h=cvtpk_s(v,0.f)&0xffffu; const float r1=v-__uint_as_float(h<<16);
  const unsigned m=cvtpk_s(r1,0.f)&0xffffu; const float r2=r1-__uint_as_float(m<<16);
  const unsigned l=cvtpk_s(r2,0.f)&0xffffu;
  u32x4 w; w.x=0x3F803F80u; w.y=0x3F80u|(h<<16); w.z=m|(l<<16); w.w=0u; if(hi){w.x=0u;w.y=0u;w.z=0u;}
  return __builtin_bit_cast(bf16x8,w);
}
typedef __attribute__((address_space(3))) const char* lds_cptr;
typedef short v4i16_t __attribute__((ext_vector_type(4)));
__device__ __forceinline__ void kload8(bf16x8*kf,lds_cptr kp){
  kf[0]=*(const __attribute__((address_space(3))) bf16x8*)(kp);      kf[1]=*(const __attribute__((address_space(3))) bf16x8*)(kp+512);
  kf[2]=*(const __attribute__((address_space(3))) bf16x8*)(kp+2048); kf[3]=*(const __attribute__((address_space(3))) bf16x8*)(kp+2560);
  kf[4]=*(const __attribute__((address_space(3))) bf16x8*)(kp+4096); kf[5]=*(const __attribute__((address_space(3))) bf16x8*)(kp+4608);
  kf[6]=*(const __attribute__((address_space(3))) bf16x8*)(kp+6144); kf[7]=*(const __attribute__((address_space(3))) bf16x8*)(kp+6656);
}
__device__ __forceinline__ void kload2(bf16x8*kf,lds_cptr kp,int j){ kf[2*j]=*(const __attribute__((address_space(3))) bf16x8*)(kp+j*2048); kf[2*j+1]=*(const __attribute__((address_space(3))) bf16x8*)(kp+j*2048+512); }
__device__ __forceinline__ s16x4 vtr(lds_cptr p){ return __builtin_bit_cast(s16x4,__builtin_amdgcn_ds_read_tr16_b64_v4i16((__attribute__((address_space(3))) v4i16_t*)p)); }
__device__ __forceinline__ float rowmax(const f32x16&p0,const f32x16&p1){
  float a=max3f(p0[0],p0[1],p1[0]),b=max3f(p0[2],p0[3],p1[1]);a=max3f(a,p1[2],p1[3]);
  #pragma unroll
  for(int r=4;r<16;r+=4){a=max3f(a,p0[r],p0[r+1]);b=max3f(b,p0[r+2],p0[r+3]);a=max3f(a,p1[r],p1[r+1]);b=max3f(b,p1[r+2],p1[r+3]);}
  const float m=max2f(a,b);
  auto rr=__builtin_amdgcn_permlane32_swap(__float_as_uint(m),__float_as_uint(m),false,false);
  return max2f(__uint_as_float(rr[0]),__uint_as_float(rr[1]));
}
__device__ __forceinline__ void pv(f32x16*o,int vb,bf16x8 pa0,bf16x8 pa1,bf16x8 pa2,bf16x8 pa3){
  #pragma unroll
  for(int d0=0;d0<2;++d0){s16x4 lo[4],hi[4];
    #pragma unroll
    for(int ks=0;ks<4;++ks){
      asm volatile("ds_read_b64_tr_b16 %0,%1 offset:%c2":"=&v"(lo[ks]):"v"(vb),"i"(d0*4096+ks*1024):"memory");
      asm volatile("ds_read_b64_tr_b16 %0,%1 offset:%c2":"=&v"(hi[ks]):"v"(vb),"i"(d0*4096+ks*1024+512):"memory");}
    asm volatile("s_waitcnt lgkmcnt(0)":::"memory");SBAR();
    #define PK(k) (bf16x8){lo[k][0],lo[k][1],lo[k][2],lo[k][3],hi[k][0],hi[k][1],hi[k][2],hi[k][3]}
    o[d0]=__builtin_amdgcn_mfma_f32_32x32x16_bf16(pa0,PK(0),o[d0],0,0,0);
    o[d0]=__builtin_amdgcn_mfma_f32_32x32x16_bf16(pa1,PK(1),o[d0],0,0,0);
    o[d0]=__builtin_amdgcn_mfma_f32_32x32x16_bf16(pa2,PK(2),o[d0],0,0,0);
    o[d0]=__builtin_amdgcn_mfma_f32_32x32x16_bf16(pa3,PK(3),o[d0],0,0,0);
    #undef PK
  }
}

#ifndef ATTN_STORE16
#define ATTN_STORE16(p,v) (*(u32x4*)(p)=(v))
#endif
template<int MODE,int THRL> __device__ __forceinline__ void attn_unit(int qb,const bf16*Qj,const bf16*__restrict__ Kj,const bf16*__restrict__ Vj,bf16*Oj,int opitch,const float*__restrict__ F2h,const bf16*__restrict__ KAh0,float twoB,int dhead,char*shm){
  int tid_=threadIdx.x; asm volatile("":"+v"(tid_));
  const int tid=tid_,lane=tid&63,r32=lane&31,hi=lane>>5; const int wid=__builtin_amdgcn_readfirstlane(tid>>6);
  const int q0=qb*QB;
  const bf16*Qw=Qj+(long)(q0+wid*QBLK)*PITCH;
  int t0=0;
  if(MODE==0){ const int NT0=(q0+QB)/KVBLK; const float fq0=F2h[q0]; const int j0=lane,j1=lane+64;
    const bool s0=(j0<NT0-4)&&(twoB+fq0-F2h[64*j0+63]<-60.f), s1=(j1<NT0-4)&&(twoB+fq0-F2h[64*j1+63]<-60.f);
    t0=(__builtin_popcountll(__ballot(s0))+__builtin_popcountll(__ballot(s1)))&~1; t0=__builtin_amdgcn_readfirstlane(t0); }
  const bf16*Kh=Kj+(long)t0*KVBLK*PITCH,*Vh=Vj+(long)t0*KVBLK*PITCH; const bf16*KAh=KAh0+(long)t0*KVBLK*8;
  const unsigned lds0=(unsigned)(uintptr_t)shm;
  float*wsf=(float*)(shm+LDS_WS)+wid*64;
  const bf16*ksrc=Kh+(long)lane*PITCH+wid*8;
  const bf16*vsrc=Vh+(long)(16*(wid&3)+(lane>>2))*PITCH+(wid>>2)*32+(lane&3)*8;
  const unsigned kdst=lds0+LDS_K+wid*1024, vdst=lds0+LDS_V+wid*1024;
  const bf16*kasrc=KAh+(long)lane*8; const unsigned kadst=lds0+LDS_K+8192;
  #define DMA_K(t,slot) do{ glds16(ksrc+(long)(t)*KVBLK*PITCH,(unsigned)__builtin_amdgcn_readfirstlane(kdst+(slot))); \
    if(MODE==0&&wid==0) glds16(kasrc+(long)(t)*KVBLK*8,(unsigned)__builtin_amdgcn_readfirstlane(kadst+(slot))); }while(0)
  #define WAITK(N0,N1) do{ if(MODE==0&&wid==0){WAIT_BAR(N1);}else{WAIT_BAR(N0);} }while(0)
  #define DMA_V(t,slot) glds16(vsrc+(long)(t)*KVBLK*PITCH,(unsigned)__builtin_amdgcn_readfirstlane(vdst+(slot)))
  const int vb0=(int)(lds0+LDS_V)+((lane>>4)&1)*32+(lane&3)*8+(4*hi+((lane&15)>>2))*64;
  const char*Kbase=shm+LDS_K; bf16x8 kf[8];
  const lds_cptr shm3=(lds_cptr)shm; const lds_cptr kp0=shm3+LDS_K+hi*1024+r32*16; const lds_cptr vp0=shm3+LDS_V+((lane>>4)&1)*32+(lane&3)*8+(4*hi+((lane&15)>>2))*64;
  const int NT=(q0+QB)/KVBLK-t0;
  const int qrel=wid*QBLK+r32;
  float qoff=0.f, mhat=0.f; bf16x8 qaug=bf16x8{}, ka0=bf16x8{}, ka1=bf16x8{};
  if(MODE==0){ qoff=F2h[q0+qrel];
    const bf16*kd=Kj+(long)(q0+qrel)*PITCH+hi*8; const bf16*qd=Qw+(long)r32*PITCH+hi*8; float dsum=0.f;
    _Pragma("unroll") for(int d0=0;d0<4;++d0){ const u32x4 kw=*reinterpret_cast<const u32x4*>(kd+d0*16), qw=*reinterpret_cast<const u32x4*>(qd+d0*16);
      _Pragma("unroll") for(int e=0;e<4;++e){ dsum+=__uint_as_float(kw[e]<<16)*__uint_as_float(qw[e]<<16)+__uint_as_float(kw[e]&0xffff0000u)*__uint_as_float(qw[e]&0xffff0000u); } }
    dsum+=__shfl_xor(dsum,32); mhat=dsum; qaug=make_qaug(qoff-mhat,hi); }
  const __attribute__((address_space(3))) float* lutr=(const __attribute__((address_space(3))) float*)(shm3+LDS_LUT)+dhead*LUTN;
  DMA_K(0,0);DMA_V(0,0);DMA_K(1,SLOTB);
  bf16x8 qr[4];
  #pragma unroll
  for(int d0=0;d0<4;++d0)qr[d0]=*reinterpret_cast<const bf16x8*>(&Qw[(long)r32*PITCH+d0*16+hi*8]);
  float l_reg=0.f;f32x16 o[2];o[0]=f32x16{};o[1]=f32x16{};f32x16 negm;
  _Pragma("unroll") for(int r=0;r<16;++r)negm[r]=0.f; asm volatile("":"+v"(negm));
  #define BIAS_(P0,P1,t,NEAR_) do{ if(MODE==0){} \
    else if(NEAR_ && (t)>=NT-6){ const __attribute__((address_space(3))) float* lp_=lutr+(383-(q0-64*(t)+qrel-4*hi)); \
      _Pragma("unroll") for(int r_=0;r_<16;++r_){ P0[r_]+=lp_[(r_&3)+8*(r_>>2)]; P1[r_]+=lp_[32+(r_&3)+8*(r_>>2)]; if((r_&3)==3)SBAR(); } } }while(0)
  #define BIAS(P0,P1,t) BIAS_(P0,P1,t,true)
  #define CMASK(P0,P1,t) do{int jb_=(t)-(NT-4); if(jb_>=0)cmask(P0,P1,jb_,qrel,hi);}while(0)
  bool resc=false;
  #define START(P0,P1) do{ const float rm=rowmax(P0,P1); resc=false; \
    { const float dl=rm; mhat=fadd_s(mhat,dl); \
      _Pragma("unroll") for(int r=0;r<16;++r){P0[r]=fsub_s(P0[r],dl);P1[r]=fsub_s(P1[r],dl);} \
      _Pragma("unroll") for(int r=0;r<16;++r)negm[r]=-mhat; asm volatile("":"+v"(negm)); } \
    _Pragma("unroll") for(int r=0;r<16;++r)P0[r]=__builtin_amdgcn_exp2f(P0[r]); }while(0)
  #define RESC() do{ if(resc){ asm volatile("s_waitcnt lgkmcnt(0)":::"memory"); \
      _Pragma("unroll") for(int d_=0;d_<2;++d_) _Pragma("unroll") for(int r=0;r<16;++r)o[d_][r]*=wsf[crow(r,hi)]; } }while(0)
  f32x16 pA0,pA1,pB0,pB1;
  #define MX3_(a,b,c) __builtin_fmaxf(__builtin_fmaxf((a),(b)),(c))
  int sl_prev=0,sl_cur=0,sl_next=SLOTB;
  #define ROT() do{sl_prev=sl_cur;sl_cur=sl_next;sl_next=(sl_next==(NSLOT-1)*SLOTB)?0:sl_next+SLOTB;}while(0)
  DMA_K(2,2*SLOTB);
  WAITK(3,5);
  const lds_cptr kap0=shm3+LDS_K+8192+r32*16;
  #define KALD(sl) do{ ka0=*(const __attribute__((address_space(3))) bf16x8*)(kap0+(sl)); ka1=*(const __attribute__((address_space(3))) bf16x8*)(kap0+(sl)+512); }while(0)
  if(MODE==0){ KALD(0); const f32x16 z16=f32x16{};
    const f32x16 a0=__builtin_amdgcn_mfma_f32_32x32x16_bf16(ka0,qaug,z16,0,0,0), a1=__builtin_amdgcn_mfma_f32_32x32x16_bf16(ka1,qaug,z16,0,0,0);
    qkt(pA0,pA1,Kbase,qr,a0,a1,r32,hi); CMASK(pA0,pA1,0);
    { float a=MX3_(pA0[0],pA0[1],pA1[0]),b=MX3_(pA0[2],pA0[3],pA1[1]); a=MX3_(a,pA1[2],pA1[3]);
      _Pragma("unroll") for(int r=4;r<16;r+=4){a=MX3_(a,pA0[r],pA0[r+1]);b=MX3_(b,pA0[r+2],pA0[r+3]);a=MX3_(a,pA1[r],pA1[r+1]);b=MX3_(b,pA1[r+2],pA1[r+3]);}
      float rm=__builtin_fmaxf(a,b); { auto rr=__builtin_amdgcn_permlane32_swap(__float_as_uint(rm),__float_as_uint(rm),false,false); rm=__builtin_fmaxf(__uint_as_float(rr[0]),__uint_as_float(rr[1])); }
      if(__any(rm>(float)THRL)){ const float dl=__builtin_fmaxf(rm,0.f); mhat+=dl; _Pragma("unroll") for(int r=0;r<16;++r){pA0[r]-=dl;pA1[r]-=dl;} qaug=make_qaug(qoff-mhat,hi); } }
    _Pragma("unroll") for(int r=0;r<16;++r)pA0[r]=__builtin_amdgcn_exp2f(pA0[r]);
  } else {
  qkt(pA0,pA1,Kbase,qr,negm,negm,r32,hi);asm volatile("s_nop 15\n\ts_nop 7":"+v"(pA0),"+v"(pA1));BIAS(pA0,pA1,0);CMASK(pA0,pA1,0);
  START(pA0,pA1);
  }
  _Pragma("unroll") for(int r=0;r<16;++r)pA1[r]=__builtin_amdgcn_exp2f(pA1[r]);
  WAIT_BAR(0);
  DMA_K(3,0);DMA_V(1,SLOTB);
  ROT();
  kload8(kf,kp0+sl_cur); if(MODE==0)KALD(sl_cur);
  WAITK(2,3);
  s16x4 vlo[8],vhi[8]; u32x4 pw0,pw1,pw2,pw3;
  #define PKW(P,B) cvtpk_s(P[B],P[B+1])
  #define PAF(k) __builtin_bit_cast(bf16x8,pw##k)
  #define VFR(i) (bf16x8){vlo[i][0],vlo[i][1],vlo[i][2],vlo[i][3],vhi[i][0],vhi[i][1],vhi[i][2],vhi[i][3]}
  #define PIN(x) asm volatile("":"+v"(x))
  #define MX3(a,b,c) __builtin_fmaxf(__builtin_fmaxf((a),(b)),(c))
  #define GAPA(MF,A0,A1,A2,A3,W0,W1,PW) do{ MF; sacc+=A0; sacc+=A1; sacc+=A2; sacc+=A3; PIN(sacc); W0; W1; PIN(PW); SBAR(); }while(0)
  #define EX(v) __builtin_amdgcn_exp2f(v)
  #define GAPB(MF,X,B) do{ MF; X[B]=EX(X[B]); X[B+1]=EX(X[B+1]); X[B+2]=EX(X[B+2]); X[B+3]=EX(X[B+3]); PIN(X); SBAR(); }while(0)
  #define VRD(i) do{ vlo[i]=vtr(vp_+(((i)>>2)*4096+((i)&3)*1024)); vhi[i]=vtr(vp_+(((i)>>2)*4096+((i)&3)*1024+512)); }while(0)
  #define KRD(G,j) do{ if(G){ kload2(kf,kp0+sl_next,j); if(MODE==0&&(j)==0)KALD(sl_next); SBAR(); } }while(0)
  #define STEP(C0,C1,P0,P1,t,GK,GV,GL) do{ SBAR(); \
    if(MODE==0){ const f32x16 z16_=f32x16{}; C0=__builtin_amdgcn_mfma_f32_32x32x16_bf16(ka0,qaug,z16_,0,0,0); C1=__builtin_amdgcn_mfma_f32_32x32x16_bf16(ka1,qaug,z16_,0,0,0); SBAR(); } \
    const lds_cptr vp_=vp0+sl_prev; \
    VRD(0); SBAR(); float sacc=(P0[0]+P0[1]); \
    GAPA(C0=__builtin_amdgcn_mfma_f32_32x32x16_bf16(kf[0],qr[0],(MODE==0?C0:negm),0,0,0), P0[2],P0[3],P0[4],P0[5],     pw0[0]=PKW(P0,0), pw0[1]=PKW(P0,2), pw0); \
    VRD(4); SBAR(); GAPA(C1=__builtin_amdgcn_mfma_f32_32x32x16_bf16(kf[1],qr[0],(MODE==0?C1:negm),0,0,0), P0[6],P0[7],P0[8],P0[9],     pw0[2]=PKW(P0,4), pw0[3]=PKW(P0,6), pw0); \
    VRD(1); SBAR(); GAPA(C0=__builtin_amdgcn_mfma_f32_32x32x16_bf16(kf[2],qr[1],C0,0,0,0),   P0[10],P0[11],P0[12],P0[13], pw1[0]=PKW(P0,8), pw1[1]=PKW(P0,10), pw1); \
    VRD(5); SBAR(); GAPA(C1=__builtin_amdgcn_mfma_f32_32x32x16_bf16(kf[3],qr[1],C1,0,0,0),   P0[14],P0[15],P1[0],P1[1],   pw1[2]=PKW(P0,12),pw1[3]=PKW(P0,14), pw1); \
    VRD(2); SBAR(); GAPA(C0=__builtin_amdgcn_mfma_f32_32x32x16_bf16(kf[4],qr[2],C0,0,0,0),   P1[2],P1[3],P1[4],P1[5],     pw2[0]=PKW(P1,0), pw2[1]=PKW(P1,2), pw2); \
    VRD(6); SBAR(); GAPA(C1=__builtin_amdgcn_mfma_f32_32x32x16_bf16(kf[5],qr[2],C1,0,0,0),   P1[6],P1[7],P1[8],P1[9],     pw2[2]=PKW(P1,4), pw2[3]=PKW(P1,6), pw2); \
    VRD(3); SBAR(); GAPA(C0=__builtin_amdgcn_mfma_f32_32x32x16_bf16(kf[6],qr[3],C0,0,0,0),   P1[10],P1[11],P1[12],P1[13], pw3[0]=PKW(P1,8), pw3[1]=PKW(P1,10), pw3); \
    VRD(7); SBAR(); GAPA(C1=__builtin_amdgcn_mfma_f32_32x32x16_bf16(kf[7],qr[3],C1,0,0,0),   P1[14],P1[15],0.f,0.f,       pw3[2]=PKW(P1,12),pw3[3]=PKW(P1,14), pw3); \
    l_reg+=sacc; \
    if(GK){DMA_K((t)+3,sl_cur);} if(GV){DMA_V((t)+1,sl_next);} \
    BIAS(C0,C1,t); CMASK(C0,C1,t); \
    { float a=MX3(C0[0],C0[1],C1[0]),b=MX3(C0[2],C0[3],C1[1]); a=MX3(a,C1[2],C1[3]); \
      _Pragma("unroll") for(int r=4;r<16;r+=4){a=MX3(a,C0[r],C0[r+1]);b=MX3(b,C0[r+2],C0[r+3]);a=MX3(a,C1[r],C1[r+1]);b=MX3(b,C1[r+2],C1[r+3]);} \
      float rm=__builtin_fmaxf(a,b); { auto rr=__builtin_amdgcn_permlane32_swap(__float_as_uint(rm),__float_as_uint(rm),false,false); rm=__builtin_fmaxf(__uint_as_float(rr[0]),__uint_as_float(rr[1])); } \
      resc=false; \
      if(__builtin_expect(__any(rm>(float)THRL),0)){ const float dl=__builtin_fmaxf(rm,0.f); mhat+=dl; \
        _Pragma("unroll") for(int r=0;r<16;++r){C0[r]-=dl;C1[r]-=dl;} \
        if(MODE==0){ qaug=make_qaug(qoff-mhat,hi); } else { _Pragma("unroll") for(int r=0;r<16;++r)negm[r]=-mhat; asm volatile("":"+v"(negm)); } \
        const float f=__builtin_amdgcn_exp2f(-dl); l_reg*=f; if(hi==0)wsf[r32]=f; resc=true; } } \
    SBAR(); \
    GAPB(o[0]=__builtin_amdgcn_mfma_f32_32x32x16_bf16(PAF(0),VFR(0),o[0],0,0,0), C0,0); \
    GAPB(o[1]=__builtin_amdgcn_mfma_f32_32x32x16_bf16(PAF(0),VFR(4),o[1],0,0,0), C0,4); \
    KRD(GL,0); GAPB(o[0]=__builtin_amdgcn_mfma_f32_32x32x16_bf16(PAF(1),VFR(1),o[0],0,0,0), C0,8); \
    KRD(GL,1); GAPB(o[1]=__builtin_amdgcn_mfma_f32_32x32x16_bf16(PAF(1),VFR(5),o[1],0,0,0), C0,12); \
    KRD(GL,2); GAPB(o[0]=__builtin_amdgcn_mfma_f32_32x32x16_bf16(PAF(2),VFR(2),o[0],0,0,0), C1,0); \
    KRD(GL,3); GAPB(o[1]=__builtin_amdgcn_mfma_f32_32x32x16_bf16(PAF(2),VFR(6),o[1],0,0,0), C1,4); \
    GAPB(o[0]=__builtin_amdgcn_mfma_f32_32x32x16_bf16(PAF(3),VFR(3),o[0],0,0,0), C1,8); \
    GAPB(o[1]=__builtin_amdgcn_mfma_f32_32x32x16_bf16(PAF(3),VFR(7),o[1],0,0,0), C1,12); \
    }while(0)
  int t=1;
  #undef CMASK
  #define CMASK(P0,P1,t) do{}while(0)
  #undef BIAS
  #define BIAS(P0,P1,t) BIAS_(P0,P1,t,false)
  for(;t+7<NT;t+=2){
    STEP(pB0,pB1,pA0,pA1,t,true,true,true);     WAITK(2,3); RESC(); ROT();
    STEP(pA0,pA1,pB0,pB1,t+1,true,true,true);   WAITK(2,3); RESC(); ROT();
  }
  #undef CMASK
  #define CMASK(P0,P1,t) do{int jb_=(t)-(NT-4); if(jb_>=0)cmask(P0,P1,jb_,qrel,hi);}while(0)
  #undef BIAS
  #define BIAS(P0,P1,t) BIAS_(P0,P1,t,true)
  #define ENDW(tt) do{ if((tt)+3<NT){WAITK(2,3);} else if((tt)+2<NT){WAIT_BAR(1);} else {WAIT_BAR(0);} }while(0)
  for(;t+1<NT;t+=2){
    STEP(pB0,pB1,pA0,pA1,t,(t+3<NT),(t+1<NT),(t+1<NT));       ENDW(t);   RESC(); ROT();
    STEP(pA0,pA1,pB0,pB1,t+1,(t+4<NT),(t+2<NT),(t+2<NT));     ENDW(t+1); RESC(); ROT();
  }
  STEP(pB0,pB1,pA0,pA1,NT-1,false,false,false); RESC();
  { float sacc=pB0[0]+pB0[1]; _Pragma("unroll") for(int r=2;r<16;++r)sacc+=pB0[r]; _Pragma("unroll") for(int r=0;r<16;++r)sacc+=pB1[r]; l_reg+=sacc;
    pw0=(u32x4){PKW(pB0,0),PKW(pB0,2),PKW(pB0,4),PKW(pB0,6)};pw1=(u32x4){PKW(pB0,8),PKW(pB0,10),PKW(pB0,12),PKW(pB0,14)};pw2=(u32x4){PKW(pB1,0),PKW(pB1,2),PKW(pB1,4),PKW(pB1,6)};pw3=(u32x4){PKW(pB1,8),PKW(pB1,10),PKW(pB1,12),PKW(pB1,14)};
    SBAR(); pv(o,vb0+sl_cur,PAF(0),PAF(1),PAF(2),PAF(3)); }
  #undef PKW
  #undef PAF
  #undef VFR
  #undef PIN
  #undef MX3
  #undef GAPA
  #undef GAPB
  #undef EX
  #undef VRD
  #undef KRD
  #undef STEP
  #undef ENDW
  {auto rr=__builtin_amdgcn_permlane32_swap(__float_as_uint(l_reg),__float_as_uint(l_reg),false,false);l_reg=__uint_as_float(rr[0])+__uint_as_float(rr[1]);}
  if(hi==0)wsf[32+r32]=l_reg;asm volatile("s_waitcnt lgkmcnt(0)":::"memory");
  float rli[16];
  #pragma unroll
  for(int r=0;r<16;++r)rli[r]=__builtin_amdgcn_rcpf(wsf[32+crow(r,hi)]);
  bf16*Ow=Oj+(long)(q0+wid*QBLK)*opitch;
  { bf16*stg=(bf16*)(shm+LDS_OST)+wid*2048;
    #pragma unroll
    for(int r=0;r<16;++r){const int orow=crow(r,hi);
      #pragma unroll
      for(int d0=0;d0<2;++d0)stg[orow*64+d0*32+r32]=__float2bfloat16(o[d0][r]*rli[r]);}
    asm volatile("s_waitcnt lgkmcnt(0)":::"memory");
    #pragma unroll
    for(int i=0;i<4;++i){const int row=i*8+(lane>>3),ch=lane&7; const u32x4 v=*(const u32x4*)(stg+row*64+ch*8); ATTN_STORE16(Ow+(long)row*opitch+ch*8,v);} }
  asm volatile("s_waitcnt lgkmcnt(0)\n\ts_barrier":::"memory");
  #undef DMA_K
  #undef WAITK
  #undef KALD
  #undef MX3_
  #undef DMA_V
  #undef CMASK
  #undef BIAS
  #undef BIAS_
  #undef START
  #undef RESC
  #undef ROT
}
constexpr int ATTN_LDS_BYTES=LDS_TOTAL;

constexpr int D1_SLK=9216, D1_SLV=16384, D1_V=NSLOT*D1_SLK, D1_WS=D1_V+NSLOT*D1_SLV, D1_END=D1_WS+NW*64*4;
static_assert(D1_END<=LDS_LUT && NW*8192<=D1_WS, "d128 attention LDS map");
template<int THRL> __device__ __forceinline__ void attn_unit_d128(int qb,const bf16*Qj,const bf16*__restrict__ Kj,const bf16*__restrict__ Vj,bf16*Oj,int opitch,int dhead,char*shm){
  int tid_=threadIdx.x; asm volatile("":"+v"(tid_));
  const int tid=tid_,lane=tid&63,r32=lane&31,hi=lane>>5; const int wid=__builtin_amdgcn_readfirstlane(tid>>6);
  const int q0=qb*QB;
  const bf16*Qw=Qj+(long)(q0+wid*QBLK)*PITCH;
  const unsigned lds0=(unsigned)(uintptr_t)shm;
  float*wsf=(float*)(shm+D1_WS)+wid*64;
  const bf16*ksrc=Kj+(long)lane*PITCH+wid*8;
  const bf16*vsrc=Vj+(long)(16*(wid&3)+(lane>>2))*PITCH+(wid>>2)*32+(lane&3)*8;
  const unsigned kdst=lds0+wid*1024, vdst=lds0+D1_V+wid*1024;
  #define DMA_K(t,si) glds16(ksrc+(long)(t)*KVBLK*PITCH,(unsigned)__builtin_amdgcn_readfirstlane(kdst+(si)*D1_SLK))
  #define DMA_V(t,si) do{ glds16(vsrc+(long)(t)*KVBLK*PITCH,(unsigned)__builtin_amdgcn_readfirstlane(vdst+(si)*D1_SLV)); \
    glds16(vsrc+(long)(t)*KVBLK*PITCH+64,(unsigned)__builtin_amdgcn_readfirstlane(vdst+(si)*D1_SLV+8192)); }while(0)
  const char*Kbase=shm; bf16x8 kf[8];
  const lds_cptr shm3=(lds_cptr)shm; const lds_cptr kp0=shm3+hi*1024+r32*16; const lds_cptr vp0=shm3+D1_V+((lane>>4)&1)*32+(lane&3)*8+(4*hi+((lane&15)>>2))*64;
  const int NT=(q0+QB)/KVBLK;
  const int qrel=wid*QBLK+r32;
  const __attribute__((address_space(3))) float* lutr=(const __attribute__((address_space(3))) float*)(shm3+LDS_LUT)+dhead*LUTN;
  DMA_K(0,0);DMA_V(0,0);DMA_K(1,1);
  bf16x8 qr[4];
  #pragma unroll
  for(int d0=0;d0<4;++d0)qr[d0]=*reinterpret_cast<const bf16x8*>(&Qw[(long)r32*PITCH+d0*16+hi*8]);
  float mhat=0.f,l_reg=0.f;f32x16 o[4];o[0]=f32x16{};o[1]=f32x16{};o[2]=f32x16{};o[3]=f32x16{};f32x16 negm;
  _Pragma("unroll") for(int r=0;r<16;++r)negm[r]=0.f; asm volatile("":"+v"(negm));
  #define BIAS_(P0,P1,t,NEAR_) do{ if(NEAR_ && (t)>=NT-6){ const __attribute__((address_space(3))) float* lp_=lutr+(383-(q0-64*(t)+qrel-4*hi)); \
      _Pragma("unroll") for(int r_=0;r_<16;++r_){ P0[r_]+=lp_[(r_&3)+8*(r_>>2)]; P1[r_]+=lp_[32+(r_&3)+8*(r_>>2)]; if((r_&3)==3)SBAR(); } } }while(0)
  #define BIAS(P0,P1,t) BIAS_(P0,P1,t,true)
  #define CMASK(P0,P1,t) do{int jb_=(t)-(NT-4); if(jb_>=0)cmask(P0,P1,jb_,qrel,hi);}while(0)
  bool resc=false;
  #define START(P0,P1) do{ const float rm=rowmax(P0,P1); resc=false; \
    { const float dl=rm; mhat=fadd_s(mhat,dl); \
      _Pragma("unroll") for(int r=0;r<16;++r){P0[r]=fsub_s(P0[r],dl);P1[r]=fsub_s(P1[r],dl);} \
      _Pragma("unroll") for(int r=0;r<16;++r)negm[r]=-mhat; asm volatile("":"+v"(negm)); } \
    _Pragma("unroll") for(int r=0;r<16;++r)P0[r]=__builtin_amdgcn_exp2f(P0[r]); }while(0)
  #define RESC() do{ if(resc){ asm volatile("s_waitcnt lgkmcnt(0)":::"memory"); \
      _Pragma("unroll") for(int d_=0;d_<4;++d_) _Pragma("unroll") for(int r=0;r<16;++r)o[d_][r]*=wsf[crow(r,hi)]; } }while(0)
  f32x16 pA0,pA1,pB0,pB1;
  int i_prev=0,i_cur=0,i_next=1;
  #define ROT() do{i_prev=i_cur;i_cur=i_next;i_next=(i_next==NSLOT-1)?0:i_next+1;}while(0)
  DMA_K(2,2);
  WAIT_BAR(4);
  qkt(pA0,pA1,Kbase,qr,negm,negm,r32,hi);asm volatile("s_nop 15\n\ts_nop 7":"+v"(pA0),"+v"(pA1));BIAS(pA0,pA1,0);CMASK(pA0,pA1,0);
  START(pA0,pA1);
  _Pragma("unroll") for(int r=0;r<16;++r)pA1[r]=__builtin_amdgcn_exp2f(pA1[r]);
  WAIT_BAR(0);
  DMA_K(3,0);DMA_V(1,1);
  ROT();
  kload8(kf,kp0+i_cur*D1_SLK);
  WAIT_BAR(3);
  s16x4 vl[16],vh[16]; u32x4 pw0,pw1,pw2,pw3;
  #define PKW(P,B) cvtpk_s(P[B],P[B+1])
  #define PAF(k) __builtin_bit_cast(bf16x8,pw##k)
  #define VFR(f) (bf16x8){vl[f][0],vl[f][1],vl[f][2],vl[f][3],vh[f][0],vh[f][1],vh[f][2],vh[f][3]}
  #define PIN(x) asm volatile("":"+v"(x))
  #define MX3(a,b,c) __builtin_fmaxf(__builtin_fmaxf((a),(b)),(c))
  #define GAPA(MF,A0,A1,A2,A3,W0,W1,PW) do{ MF; sacc+=A0; sacc+=A1; sacc+=A2; sacc+=A3; PIN(sacc); W0; W1; PIN(PW); SBAR(); }while(0)
  #define EX(v) __builtin_amdgcn_exp2f(v)
  #define VRD(f) do{ vl[f]=vtr(vp_+(f)*1024); vh[f]=vtr(vp_+(f)*1024+512); }while(0)
  #define KRD(G,j) do{ if(G){ kload2(kf,kp0+i_next*D1_SLK,j); } }while(0)
  #define GAPB(n,X,B,GL) do{ o[(n)&3]=__builtin_amdgcn_mfma_f32_32x32x16_bf16(PAFN(n),VFR(4*((n)&3)+((n)>>2)),o[(n)&3],0,0,0); \
    X[B]=EX(X[B]); X[B+1]=EX(X[B+1]); PIN(X); if((n)+3<16){ VRD(4*(((n)+3)&3)+(((n)+3)>>2)); } \
    if((n)==2)KRD(GL,0); if((n)==4)KRD(GL,1); if((n)==6)KRD(GL,2); if((n)==8)KRD(GL,3); SBAR(); }while(0)
  #define PAFN(n) (((n)>>2)==0?PAF(0):((n)>>2)==1?PAF(1):((n)>>2)==2?PAF(2):PAF(3))
  #define STEP(C0,C1,P0,P1,t,GK,GV,GL) do{ SBAR(); \
    const lds_cptr vp_=vp0+i_prev*D1_SLV; \
    VRD(0); SBAR(); float sacc=(P0[0]+P0[1]); \
    GAPA(C0=__builtin_amdgcn_mfma_f32_32x32x16_bf16(kf[0],qr[0],negm,0,0,0), P0[2],P0[3],P0[4],P0[5],     pw0[0]=PKW(P0,0), pw0[1]=PKW(P0,2), pw0); \
    VRD(4); SBAR(); GAPA(C1=__builtin_amdgcn_mfma_f32_32x32x16_bf16(kf[1],qr[0],negm,0,0,0), P0[6],P0[7],P0[8],P0[9],     pw0[2]=PKW(P0,4), pw0[3]=PKW(P0,6), pw0); \
    VRD(8); SBAR(); GAPA(C0=__builtin_amdgcn_mfma_f32_32x32x16_bf16(kf[2],qr[1],C0,0,0,0),   P0[10],P0[11],P0[12],P0[13], pw1[0]=PKW(P0,8), pw1[1]=PKW(P0,10), pw1); \
    GAPA(C1=__builtin_amdgcn_mfma_f32_32x32x16_bf16(kf[3],qr[1],C1,0,0,0),   P0[14],P0[15],P1[0],P1[1],   pw1[2]=PKW(P0,12),pw1[3]=PKW(P0,14), pw1); \
    GAPA(C0=__builtin_amdgcn_mfma_f32_32x32x16_bf16(kf[4],qr[2],C0,0,0,0),   P1[2],P1[3],P1[4],P1[5],     pw2[0]=PKW(P1,0), pw2[1]=PKW(P1,2), pw2); \
    GAPA(C1=__builtin_amdgcn_mfma_f32_32x32x16_bf16(kf[5],qr[2],C1,0,0,0),   P1[6],P1[7],P1[8],P1[9],     pw2[2]=PKW(P1,4), pw2[3]=PKW(P1,6), pw2); \
    GAPA(C0=__builtin_amdgcn_mfma_f32_32x32x16_bf16(kf[6],qr[3],C0,0,0,0),   P1[10],P1[11],P1[12],P1[13], pw3[0]=PKW(P1,8), pw3[1]=PKW(P1,10), pw3); \
    GAPA(C1=__builtin_amdgcn_mfma_f32_32x32x16_bf16(kf[7],qr[3],C1,0,0,0),   P1[14],P1[15],0.f,0.f,       pw3[2]=PKW(P1,12),pw3[3]=PKW(P1,14), pw3); \
    l_reg+=sacc; \
    if(GK){DMA_K((t)+3,i_cur);} if(GV){DMA_V((t)+1,i_next);} \
    BIAS(C0,C1,t); CMASK(C0,C1,t); \
    { float a=MX3(C0[0],C0[1],C1[0]),b=MX3(C0[2],C0[3],C1[1]); a=MX3(a,C1[2],C1[3]); \
      _Pragma("unroll") for(int r=4;r<16;r+=4){a=MX3(a,C0[r],C0[r+1]);b=MX3(b,C0[r+2],C0[r+3]);a=MX3(a,C1[r],C1[r+1]);b=MX3(b,C1[r+2],C1[r+3]);} \
      float rm=__builtin_fmaxf(a,b); { auto rr=__builtin_amdgcn_permlane32_swap(__float_as_uint(rm),__float_as_uint(rm),false,false); rm=__builtin_fmaxf(__uint_as_float(rr[0]),__uint_as_float(rr[1])); } \
      resc=false; \
      if(__builtin_expect(__any(rm>(float)THRL),0)){ const float dl=__builtin_fmaxf(rm,0.f); mhat+=dl; \
        _Pragma("unroll") for(int r=0;r<16;++r){C0[r]-=dl;C1[r]-=dl;} \
        _Pragma("unroll") for(int r=0;r<16;++r)negm[r]=-mhat; asm volatile("":"+v"(negm)); \
        const float f=__builtin_amdgcn_exp2f(-dl); l_reg*=f; if(hi==0)wsf[r32]=f; resc=true; } } \
    SBAR(); \
    GAPB(0,C0,0,GL); GAPB(1,C0,2,GL); GAPB(2,C0,4,GL); GAPB(3,C0,6,GL); GAPB(4,C0,8,GL); GAPB(5,C0,10,GL); GAPB(6,C0,12,GL); GAPB(7,C0,14,GL); \
    GAPB(8,C1,0,GL); GAPB(9,C1,2,GL); GAPB(10,C1,4,GL); GAPB(11,C1,6,GL); GAPB(12,C1,8,GL); GAPB(13,C1,10,GL); GAPB(14,C1,12,GL); GAPB(15,C1,14,GL); \
    }while(0)
  int t=1;
  #undef CMASK
  #define CMASK(P0,P1,t) do{}while(0)
  #undef BIAS
  #define BIAS(P0,P1,t) BIAS_(P0,P1,t,false)
  for(;t+7<NT;t+=2){
    STEP(pB0,pB1,pA0,pA1,t,true,true,true);     WAIT_BAR(3); RESC(); ROT();
    STEP(pA0,pA1,pB0,pB1,t+1,true,true,true);   WAIT_BAR(3); RESC(); ROT();
  }
  #undef CMASK
  #define CMASK(P0,P1,t) do{int jb_=(t)-(NT-4); if(jb_>=0)cmask(P0,P1,jb_,qrel,hi);}while(0)
  #undef BIAS
  #define BIAS(P0,P1,t) BIAS_(P0,P1,t,true)
  #define ENDW(tt) do{ if((tt)+3<NT){WAIT_BAR(3);} else if((tt)+2<NT){WAIT_BAR(2);} else {WAIT_BAR(0);} }while(0)
  for(;t+1<NT;t+=2){
    STEP(pB0,pB1,pA0,pA1,t,(t+3<NT),(t+1<NT),(t+1<NT));       ENDW(t);   RESC(); ROT();
    STEP(pA0,pA1,pB0,pB1,t+1,(t+4<NT),(t+2<NT),(t+2<NT));     ENDW(t+1); RESC(); ROT();
  }
  STEP(pB0,pB1,pA0,pA1,NT-1,false,false,false); RESC();
  { float sacc=pB0[0]+pB0[1]; _Pragma("unroll") for(int r=2;r<16;++r)sacc+=pB0[r]; _Pragma("unroll") for(int r=0;r<16;++r)sacc+=pB1[r]; l_reg+=sacc;
    pw0=(u32x4){PKW(pB0,0),PKW(pB0,2),PKW(pB0,4),PKW(pB0,6)};pw1=(u32x4){PKW(pB0,8),PKW(pB0,10),PKW(pB0,12),PKW(pB0,14)};pw2=(u32x4){PKW(pB1,0),PKW(pB1,2),PKW(pB1,4),PKW(pB1,6)};pw3=(u32x4){PKW(pB1,8),PKW(pB1,10),PKW(pB1,12),PKW(pB1,14)};
    SBAR(); const lds_cptr vp_=vp0+i_cur*D1_SLV;
    #pragma unroll
    for(int dq=0;dq<4;++dq){ s16x4 lo[4],hh[4];
      #pragma unroll
      for(int ks=0;ks<4;++ks){ lo[ks]=vtr(vp_+(4*dq+ks)*1024); hh[ks]=vtr(vp_+(4*dq+ks)*1024+512); }
      #define PK_(k) (bf16x8){lo[k][0],lo[k][1],lo[k][2],lo[k][3],hh[k][0],hh[k][1],hh[k][2],hh[k][3]}
      o[dq]=__builtin_amdgcn_mfma_f32_32x32x16_bf16(PAF(0),PK_(0),o[dq],0,0,0); o[dq]=__builtin_amdgcn_mfma_f32_32x32x16_bf16(PAF(1),PK_(1),o[dq],0,0,0);
      o[dq]=__builtin_amdgcn_mfma_f32_32x32x16_bf16(PAF(2),PK_(2),o[dq],0,0,0); o[dq]=__builtin_amdgcn_mfma_f32_32x32x16_bf16(PAF(3),PK_(3),o[dq],0,0,0);
      #undef PK_
    } }
  #undef PKW
  #undef PAF
  #undef PAFN
  #undef VFR
  #undef PIN
  #undef MX3
  #undef GAPA
  #undef GAPB
  #undef EX
  #undef VRD
  #undef KRD
  #undef STEP
  #undef ENDW
  {auto rr=__builtin_amdgcn_permlane32_swap(__float_as_uint(l_reg),__float_as_uint(l_reg),false,false);l_reg=__uint_as_float(rr[0])+__uint_as_float(rr[1]);}
  if(hi==0)wsf[32+r32]=l_reg;
  asm volatile("s_waitcnt lgkmcnt(0)\n\ts_barrier":::"memory");
  float rli[16];
  #pragma unroll
  for(int r=0;r<16;++r)rli[r]=__builtin_amdgcn_rcpf(wsf[32+crow(r,hi)]);
  bf16*Ow=Oj+(long)(q0+wid*QBLK)*opitch;
  { bf16*stg=(bf16*)(shm)+wid*4096;
    #pragma unroll
    for(int r=0;r<16;++r){const int orow=crow(r,hi);
      #pragma unroll
      for(int dq=0;dq<4;++dq)stg[orow*128+dq*32+r32]=__float2bfloat16(o[dq][r]*rli[r]);}
    asm volatile("s_waitcnt lgkmcnt(0)":::"memory");
    #pragma unroll
    for(int i=0;i<8;++i){const int row=i*4+(lane>>4),ch=lane&15; const u32x4 v=*(const u32x4*)(stg+row*128+ch*8); ATTN_STORE16(Ow+(long)row*opitch+ch*8,v);} }
  asm volatile("s_waitcnt lgkmcnt(0)\n\ts_barrier":::"memory");
  #undef DMA_K
  #undef DMA_V
  #undef CMASK
  #undef BIAS
  #undef BIAS_
  #undef START
  #undef RESC
  #undef ROT
}

struct AttnBufs { const bf16* PROJ; bf16* YFOX; bf16* OD; const float* F2; const bf16* KA; const unsigned* NRM; };
template<int THRL> __device__ __forceinline__ void attn_run_fox(const AttnBufs& A,int g,int qb,char*lds){
  const int b=g>>3,h=g&7; const bf16*P=A.PROJ+(long)b*SEQ*PITCH;
  const unsigned*nq=A.NRM+((0*2+b)*8+h)*2,*nk=A.NRM+((1*2+b)*8+h)*2;
  const float twoB=2.04f*sqrtf((__uint_as_float(nq[0])+__uint_as_float(nq[1]))*(__uint_as_float(nk[0])+__uint_as_float(nk[1])));
  attn_unit<0,THRL>(qb,P+PC_FQ+64*h,P+PC_FK+64*h,P+PC_FV+64*h,A.YFOX+(long)b*SEQ*512+64*h,512,A.F2+((long)b*8+h)*SEQ,A.KA+((long)b*8+h)*SEQ*8,twoB,0,lds);
}
template<int THRL> __device__ __forceinline__ void attn_run_diff(const AttnBufs& A,int g,int qb,char*lds){
  const int b=g>>3,h=(g&7)>>1,i=g&1; const bf16*P=A.PROJ+(long)b*SEQ*PITCH;
  attn_unit_d128<THRL>(qb,P+PC_DQ+h*128+i*64,P+PC_DK+h*128+i*64,P+PC_DV+h*128,A.OD+(long)b*SEQ*1024+i*512+h*128,1024,h,lds);
}
__device__ __forceinline__ void attn_build_lut(char*lds,const float*LUTg){
  __attribute__((address_space(3))) float* R=(__attribute__((address_space(3))) float*)((__attribute__((address_space(3))) char*)lds+LDS_LUT);
  for(int u=threadIdx.x;u<4*LUTN;u+=NW*64){ const int h=u/LUTN,i=u%LUTN,dist=383-i; R[u]=(dist>=0&&dist<128)?(LUTg[h*128+dist]-LUTg[h*128+127]):0.f; }
  __syncthreads();
}
#undef SBAR
#undef WAIT_BAR
}
struct Frame {
    LAS unsigned char* lds;
    volatile LAS unsigned* MISC;
    gu32* ctl;
    int tid, lane, wave, vcu, G;
    const float* in[25]; float* out; unsigned char* ws;
};
#define WSP(T, off) ((T*)(F.ws + (off)))
enum { I_X = 0, I_C, I_WADA, I_BADA, I_LN1G, I_WIN, I_BFG, I_BMERGE, I_LQ1, I_LK1, I_LQ2, I_LK2, I_DNG, I_T5, I_WBF, I_WBD, I_WO, I_LN2G, I_WR, I_BR, I_WUP, I_BUP, I_WDN, I_BDN, I_FING };

__device__ __forceinline__ float wave_sum(float v) {
#pragma unroll
    for (int o = 1; o < 64; o <<= 1) v += __shfl_xor(v, o);
    return v;
}
__device__ __forceinline__ float bflo(unsigned w) { return __uint_as_float(w << 16); }
__device__ __forceinline__ float bfhi(unsigned w) { return __uint_as_float(w & 0xffff0000u); }

__device__ __forceinline__ unsigned cvtpk_rne(float lo, float hi) { unsigned r; asm("v_cvt_pk_bf16_f32 %0, %1, %2" : "=v"(r) : "v"(lo), "v"(hi)); return r; }
template <bool NT = false> __device__ __forceinline__ void tr_load(const float* W, int ldw, int src_col0, int kb, int nb, int lane, f32x4 (&t)[8]) {
    const int k0 = 64 * kb, n0 = 32 * nb, kr = lane >> 3, c4 = lane & 7;
#pragma unroll
    for (int i = 0; i < 8; ++i) { const f32x4* p_ = (const f32x4*)(W + (size_t)(k0 + 16 * (i >> 1) + 2 * kr + (i & 1)) * ldw + src_col0 + n0 + 4 * c4); t[i] = NT ? __builtin_nontemporal_load(p_) : *p_; }
}
__device__ __forceinline__ void tr_flush(const f32x4 (&t)[8], int K, bf16* WT, int dst_row0, LAS float* scr, int kb, int nb, int lane) {
    const int k0 = 64 * kb, n0 = 32 * nb, kr = lane >> 3, c4 = lane & 7; LAS unsigned* s32 = (LAS unsigned*)scr;
#pragma unroll
    for (int j = 0; j < 4; ++j)
#pragma unroll
        for (int e = 0; e < 4; ++e) s32[(4 * c4 + e) * 36 + 8 * j + kr] = cvtpk_rne(t[2 * j][e], t[2 * j + 1][e]);
    LDS_WAIT(); asm volatile("" ::: "memory");
    const int c = lane & 7;
#pragma unroll
    for (int jj = 0; jj < 4; ++jj) { const int n = (lane >> 3) + 8 * jj; const v4u o = *(const LAS v4u*)(s32 + n * 36 + 4 * c);
        *(GAS v4u*)(WT + (size_t)(dst_row0 + n0 + n) * K + k0 + 8 * c) = o; }
    LDS_WAIT(); asm volatile("" ::: "memory");
}
template <bool NT = false> __device__ __forceinline__ void transpose_item(const float* W, int ldw, int src_col0, int K, bf16* WT, int dst_row0, LAS float* scr, int kb, int nb, int lane) {
    f32x4 t[8]; tr_load<NT>(W, ldw, src_col0, kb, nb, lane, t); tr_flush(t, K, WT, dst_row0, scr, kb, nb, lane);
}

__device__ __forceinline__ int t5_bucket(int n) {
    if (n < 16) return n;
    int large = 16 + (int)(logf((float)n / 16.0f) / logf(8.0f) * 16.0f);
    return large < 31 ? large : 31;
}

__device__ __forceinline__ float sat_fp8(float x) { return __builtin_amdgcn_fmed3f(x, -448.0f, 448.0f); }
__device__ __forceinline__ unsigned pack4_fp8(float a, float b, float c, float d) { int w = 0; w = __builtin_amdgcn_cvt_pk_fp8_f32(sat_fp8(a), sat_fp8(b), w, false); w = __builtin_amdgcn_cvt_pk_fp8_f32(sat_fp8(c), sat_fp8(d), w, true); return (unsigned)w; }
constexpr float W8_SCALE = 32.0f;
template <bool NT = false> __device__ __forceinline__ void tr_load_f8(const float* W, int ldw, int kb, int nb, int lane, f32x4 (&t)[8], int src_col0 = 0) {
    const int k0 = 64 * kb, n0 = 32 * nb, kr = lane >> 3, c4 = lane & 7;
#pragma unroll
    for (int i = 0; i < 8; ++i) { const f32x4* p_ = (const f32x4*)(W + (size_t)(k0 + 32 * (i >> 2) + 4 * kr + (i & 3)) * ldw + src_col0 + n0 + 4 * c4); t[i] = NT ? __builtin_nontemporal_load(p_) : *p_; }
}
__device__ __forceinline__ void tr_flush_f8(const f32x4 (&t)[8], int K8, unsigned char* WT8, LAS float* scr, int kb, int nb, int lane) {
    const int k0 = 64 * kb, n0 = 32 * nb, kr = lane >> 3, c4 = lane & 7; LAS unsigned* s32 = (LAS unsigned*)scr;
#pragma unroll
    for (int g = 0; g < 2; ++g)
#pragma unroll
        for (int e = 0; e < 4; ++e) s32[(4 * c4 + e) * 20 + 8 * g + kr] = pack4_fp8(t[4 * g][e] * W8_SCALE, t[4 * g + 1][e] * W8_SCALE, t[4 * g + 2][e] * W8_SCALE, t[4 * g + 3][e] * W8_SCALE);
    LDS_WAIT(); asm volatile("" ::: "memory");
#pragma unroll
    for (int jj = 0; jj < 2; ++jj) { const int n = (lane >> 2) + 16 * jj, c = lane & 3; const v4u o = *(const LAS v4u*)(s32 + n * 20 + 4 * c);
        *(GAS v4u*)(WT8 + (size_t)(n0 + n) * K8 + k0 + 16 * c) = o; }
    LDS_WAIT(); asm volatile("" ::: "memory");
}
struct MoeItem { const float* W; unsigned char* WT; int ldw, kb, nb; };
__device__ __forceinline__ MoeItem moe_item(Frame& F, int r) {
    MoeItem d;
    if (r < 32768) { const int e = r / 1024, q = r % 1024; d.W = F.in[I_WUP] + (size_t)e * DM * NUP; d.WT = WSP(unsigned char, WS_WUP) + (size_t)e * NUP * DM; d.ldw = NUP; d.kb = q / 64; d.nb = q % 64; }
    else { r -= 32768; const int e = r / 512, q = r % 512; d.W = F.in[I_WDN] + (size_t)e * DFF * DM; d.WT = WSP(unsigned char, WS_WDN) + (size_t)e * DM * DFF; d.ldw = DM; d.kb = q / 32; d.nb = q % 32; }
    return d;
}
__device__ __forceinline__ void moe_weight_items8(Frame& F, int base, LAS float* scr) {
    f32x4 tc[8], tn[8]; MoeItem dc = moe_item(F, base), dn = dc;
    tr_load_f8<true>(dc.W, dc.ldw, dc.kb, dc.nb, F.lane, tc);
    for (int i = 0; i < 8; ++i) {
        if (i + 1 < 8) { dn = moe_item(F, base + i + 1); tr_load_f8<true>(dn.W, dn.ldw, dn.kb, dn.nb, F.lane, tn); }
        tr_flush_f8(tc, 1024, dc.WT, scr, dc.kb, dc.nb, F.lane);
        dc = dn;
#pragma unroll
        for (int k = 0; k < 8; ++k) tc[k] = tn[k];
    }
}
__device__ __forceinline__ void p0_prologue(Frame& F) {
    float* MOD = WSP(float, WS_MOD);
    {
        LAS float* red = (LAS float*)(F.lds + RING_OFF);
        LAS float* sil = red + 512;
        const float* c = F.in[I_C]; const float* wa = F.in[I_WADA]; const float* ba = F.in[I_BADA];
        if (F.vcu < 192) { for (int q = F.tid; q < 2 * DM; q += NWAVES * 64) { const float cv = c[q]; sil[q] = cv / (1.0f + __expf(-cv)); } __syncthreads(); }
        for (int it = F.vcu; it < 192; it += F.G) {
            const int col = F.lane & 31, j = it * 32 + col, kb = F.wave * 128 + (F.lane >> 5) * 64; float a0 = 0.f, a1 = 0.f;
#pragma unroll
            for (int h2 = 0; h2 < 2; ++h2) { float wv[32];
#pragma unroll
                for (int k = 0; k < 32; ++k) wv[k] = wa[(size_t)(kb + 32 * h2 + k) * (6 * DM) + j];
#pragma unroll
                for (int k = 0; k < 32; ++k) { a0 += sil[kb + 32 * h2 + k] * wv[k]; a1 += sil[DM + kb + 32 * h2 + k] * wv[k]; } }
            a0 += __shfl_xor(a0, 32); a1 += __shfl_xor(a1, 32);
            if (F.lane < 32) { red[(F.wave * 2 + 0) * 32 + col] = a0; red[(F.wave * 2 + 1) * 32 + col] = a1; }
            __syncthreads();
            if (F.tid < 64) { const int b = F.tid >> 5; float s = ba[j];
#pragma unroll
                for (int w = 0; w < 8; ++w) s += red[(w * 2 + b) * 32 + col];
                MOD[(size_t)b * (6 * DM) + j] = s; }
            __syncthreads();
        }
    }
    if (F.vcu == F.G - 2) { for (int u = F.tid; u < 8192; u += NWAVES * 64) WSP(float, WS_FG)[u] = F.in[I_WIN][(size_t)(u >> 3) * INCOLS + 1536 + (u & 7)]; }
    if (F.vcu == F.G - 1) {
        if (F.tid < 512) { const int h = F.tid >> 7, n = F.tid & 127; WSP(float, WS_LUT)[F.tid] = F.in[I_T5][t5_bucket(n) * 4 + h] * LOG2E; }
        if (F.tid == 0) { float s1 = 0.f, s2 = 0.f;
            for (int i = 0; i < 64; ++i) { s1 += F.in[I_LQ1][i] * F.in[I_LK1][i]; s2 += F.in[I_LQ2][i] * F.in[I_LK2][i]; }
            WSP(float, WS_SCAL)[0] = expf(s1) - expf(s2) + LAMBDA_INIT; }
    }
    __syncthreads();
    {
        LAS float* scr = (LAS float*)(F.lds + RING_OFF + F.wave * 16384);
        const int gw = F.vcu * NWAVES + F.wave, NGW = F.G * NWAVES;
        constexpr int I_IN = 16 * 160, I_BF = 8 * 32, I_BD = 8 * 32, I_OO = 16 * 32, I_UP = 32 * 16 * 64, I_DN = 32 * 16 * 32;
        const int NITEMS = I_IN + I_BF + I_BD + I_OO;
        for (int it = gw; it < NITEMS; it += NGW) {
            int r = it;
            if (r < I_IN) { const int kb = r / 160, nb = r % 160; f32x4 t8[8]; tr_load_f8(F.in[I_WIN], INCOLS, kb, nb, F.lane, t8, (nb >= 48) ? 8 : 0); tr_flush_f8(t8, DM, WSP(unsigned char, WS_WIN), scr, kb, nb, F.lane); continue; } r -= I_IN;
            if (r < I_BF) { transpose_item(F.in[I_WBF], DM, 0, 512, WSP(bf16, WS_WBF), 0, scr, r / 32, r % 32, F.lane); continue; } r -= I_BF;
            if (r < I_BD) { transpose_item(F.in[I_WBD], DM, 0, 512, WSP(bf16, WS_WBD), 0, scr, r / 32, r % 32, F.lane); continue; } r -= I_BD;
            if (r < I_OO) { f32x4 t8[8]; tr_load_f8(F.in[I_WO], DM, r / 32, r % 32, F.lane, t8, 0); tr_flush_f8(t8, DM, WSP(unsigned char, WS_WO), scr, r / 32, r % 32, F.lane); continue; } r -= I_OO;
        }
    }
}

__device__ __forceinline__ void norm_mod_row(const float* xrow, const float* g, const float* shift, const float* scale, int lane, f32x4 (&v)[4]) {
    const GAS f32x4* xr = (const GAS f32x4*)xrow + lane; float s = 0.f;
#pragma unroll
    for (int j = 0; j < 4; ++j) { v[j] = xr[64 * j]; s += (v[j].x * v[j].x + v[j].y * v[j].y) + (v[j].z * v[j].z + v[j].w * v[j].w); }
    const float rstd = 1.0f / sqrtf(wave_sum(s) * (1.0f / DM) + 1e-6f);
#pragma unroll
    for (int j = 0; j < 4; ++j) { const f32x4 gg = ((const GAS f32x4*)g)[64 * j + lane], sh = ((const GAS f32x4*)shift)[64 * j + lane], sc = ((const GAS f32x4*)scale)[64 * j + lane];
        v[j] = v[j] * rstd * gg * (sc + 1.0f) + sh; }
}
__device__ __forceinline__ void norm_mod_row_bf16(const bf16* xrow, const float* g, const float* shift, const float* scale, int lane, f32x4 (&v)[4]) {
    const GAS unsigned long long* xr = (const GAS unsigned long long*)xrow + lane; float s = 0.f;
#pragma unroll
    for (int j = 0; j < 4; ++j) { const unsigned long long w = xr[64 * j]; const unsigned lo = (unsigned)w, hi = (unsigned)(w >> 32); v[j] = (f32x4){bflo(lo), bfhi(lo), bflo(hi), bfhi(hi)};
        s += (v[j].x * v[j].x + v[j].y * v[j].y) + (v[j].z * v[j].z + v[j].w * v[j].w); }
    const float rstd = 1.0f / sqrtf(wave_sum(s) * (1.0f / DM) + 1e-6f);
#pragma unroll
    for (int j = 0; j < 4; ++j) { const f32x4 gg = ((const GAS f32x4*)g)[64 * j + lane], sh = ((const GAS f32x4*)shift)[64 * j + lane], sc = ((const GAS f32x4*)scale)[64 * j + lane];
        v[j] = v[j] * rstd * gg * (sc + 1.0f) + sh; }
}
__device__ __forceinline__ void store_row_bf16(bf16* orow, int lane, const f32x4 (&v)[4]) {
    GAS unsigned long long* o8 = (GAS unsigned long long*)orow + lane;
#pragma unroll
    for (int j = 0; j < 4; ++j) o8[64 * j] = (unsigned long long)pk2(v[j].x, v[j].y) | ((unsigned long long)pk2(v[j].z, v[j].w) << 32);
}

__device__ __forceinline__ void p1_norm_fgate(Frame& F) {
    LAS float* wfl = (LAS float*)(F.lds + RING_OFF);
    LAS float* lfs = (LAS float*)(F.lds + RING_OFF + 40960);
    const float* win = F.in[I_WIN]; const float* MOD = WSP(float, WS_MOD);
    for (int q = F.tid; q < 2048; q += NWAVES * 64) { const int u = 4 * q, k = u >> 3; *(LAS f32x4*)(wfl + ((k >> 8) * 64 + ((k >> 2) & 63)) * 36 + (k & 3) * 8 + (u & 7)) = ((const GAS f32x4*)WSP(float, WS_FG))[q]; }
    __syncthreads();
    for (int g = F.vcu; g < M / 64; g += F.G) {
        const int row0_ = g * 64 + F.wave * 8, b = row0_ / SEQ;
        f32x4 gsc[4], shv[4];
#pragma unroll
        for (int j = 0; j < 4; ++j) { const f32x4 gg = ((const GAS f32x4*)F.in[I_LN1G])[64 * j + F.lane], sc = ((const GAS f32x4*)(MOD + (size_t)b * 6 * DM + DM))[64 * j + F.lane];
            gsc[j] = gg * (sc + 1.0f); shv[j] = ((const GAS f32x4*)(MOD + (size_t)b * 6 * DM))[64 * j + F.lane]; }
        f32x4 xn[4];
#pragma unroll
        for (int j = 0; j < 4; ++j) xn[j] = ((const GAS f32x4*)(F.in[I_X] + (size_t)row0_ * DM))[64 * j + F.lane];
        for (int i = 0; i < 8; ++i) {
            const int rl = F.wave * 8 + i, row = g * 64 + rl;
            f32x4 v[4];
#pragma unroll
            for (int j = 0; j < 4; ++j) v[j] = xn[j];
            if (i < 7) {
#pragma unroll
                for (int j = 0; j < 4; ++j) xn[j] = ((const GAS f32x4*)(F.in[I_X] + (size_t)(row + 1) * DM))[64 * j + F.lane]; }
            { float s = 0.f;
#pragma unroll
              for (int j = 0; j < 4; ++j) s += (v[j].x * v[j].x + v[j].y * v[j].y) + (v[j].z * v[j].z + v[j].w * v[j].w);
              const float rstd = 1.0f / sqrtf(wave_sum(s) * (1.0f / DM) + 1e-6f);
#pragma unroll
              for (int j = 0; j < 4; ++j) v[j] = v[j] * rstd * gsc[j] + shv[j]; }
            { GAS unsigned* o4 = (GAS unsigned*)(WSP(unsigned char, WS_XN) + (size_t)row * DM) + F.lane;
#pragma unroll
              for (int j = 0; j < 4; ++j) o4[64 * j] = pack4_fp8(v[j].x, v[j].y, v[j].z, v[j].w); }
            float a[8];
#pragma unroll
            for (int hh = 0; hh < 8; ++hh) a[hh] = 0.f;
#pragma unroll
            for (int j = 0; j < 4; ++j)
#pragma unroll
                for (int e = 0; e < 4; ++e) { const LAS float* wp_ = wfl + (j * 64 + F.lane) * 36 + e * 8; const f32x4 w0 = *(const LAS f32x4*)(wp_), w1 = *(const LAS f32x4*)(wp_ + 4); const float hv = v[j][e];
                    a[0] += hv * w0.x; a[1] += hv * w0.y; a[2] += hv * w0.z; a[3] += hv * w0.w; a[4] += hv * w1.x; a[5] += hv * w1.y; a[6] += hv * w1.z; a[7] += hv * w1.w; }
            float mine = 0.f;
#pragma unroll
            for (int hh = 0; hh < 8; ++hh) { const float s = wave_sum(a[hh]); if (F.lane == hh) mine = s; }
            if (F.lane < 8) { const float z = mine + F.in[I_BFG][F.lane]; lfs[rl * 8 + F.lane] = fminf(z, 0.f) - log1pf(expf(-fabsf(z))); }
        }
        __syncthreads();
        if (F.tid < 8) { float run = 0.f; float* floc = WSP(float, WS_FLOC);
            for (int r = 0; r < 64; ++r) { run += lfs[r * 8 + F.tid]; floc[(size_t)(g * 64 + r) * 8 + F.tid] = run; }
            WSP(float, WS_BT)[g * 8 + F.tid] = run; }
        __syncthreads();
    }
}
__device__ __forceinline__ void p2_finish_f(Frame& F) {
    LAS float* base = (LAS float*)(F.lds + RING_OFF);
    const float* BT = WSP(float, WS_BT); const float* floc = WSP(float, WS_FLOC); float* F2 = WSP(float, WS_F2);
    for (int g = F.vcu; g < M / 64; g += F.G) {
        const int g0 = (g / 128) * 128;
        { const int l0 = g0 + F.lane, l1 = g0 + 64 + F.lane; float s = (l0 < g ? BT[l0 * 8 + F.wave] : 0.f) + (l1 < g ? BT[l1 * 8 + F.wave] : 0.f); s = wave_sum(s); if (F.lane == 0) base[F.wave] = s; }
        __syncthreads();
        { const int r = F.tid >> 3, hh = F.tid & 7, row = g * 64 + r, b = row / SEQ, s = row % SEQ;
          const float f2 = (floc[(size_t)row * 8 + hh] + base[hh]) * LOG2E; F2[((size_t)b * 8 + hh) * SEQ + s] = f2;
          const float x0 = -f2; const unsigned h0 = f2bf(x0); const float r1 = x0 - __uint_as_float(h0 << 16); const unsigned h1 = f2bf(r1); const float r2 = r1 - __uint_as_float(h1 << 16); const unsigned h2 = f2bf(r2);
          v4u w; w.x = h0 | (h1 << 16); w.y = h2 | (0x3F80u << 16); w.z = 0x3F803F80u; w.w = 0u; WSP(v4u, WS_KA)[((size_t)b * 8 + hh) * SEQ + s] = w; }
        __syncthreads();
    }
}

__device__ __forceinline__ void p4_diff_post(Frame& F) {
    const bf16* OD = WSP(bf16, WS_OD); bf16* YD = WSP(bf16, WS_YD); const float lam = WSP(float, WS_SCAL)[0]; const float* gn = F.in[I_DNG];
    const int gw = F.vcu * NWAVES + F.wave, NGW = F.G * NWAVES; const int e0 = (F.lane & 15) * 8;
    float gv[8];
#pragma unroll
    for (int e = 0; e < 8; ++e) gv[e] = gn[e0 + e] * (1.0f - LAMBDA_INIT);
    for (int row = gw; row < M; row += NGW) {
        const v4u a = *(const v4u*)(OD + (size_t)row * 1024 + F.lane * 8), bq = *(const v4u*)(OD + (size_t)row * 1024 + 512 + F.lane * 8);
        float y[8]; y[0] = bflo(a.x) - lam * bflo(bq.x); y[1] = bfhi(a.x) - lam * bfhi(bq.x); y[2] = bflo(a.y) - lam * bflo(bq.y); y[3] = bfhi(a.y) - lam * bfhi(bq.y);
        y[4] = bflo(a.z) - lam * bflo(bq.z); y[5] = bfhi(a.z) - lam * bfhi(bq.z); y[6] = bflo(a.w) - lam * bflo(bq.w); y[7] = bfhi(a.w) - lam * bfhi(bq.w);
        float ss = 0.f;
#pragma unroll
        for (int e = 0; e < 8; ++e) ss += y[e] * y[e];
        ss += __shfl_xor(ss, 1); ss += __shfl_xor(ss, 2); ss += __shfl_xor(ss, 4); ss += __shfl_xor(ss, 8);
        const float rstd = 1.0f / sqrtf(ss * (1.0f / 128.0f) + 1e-5f);
        v4u w; w.x = pk2(y[0] * rstd * gv[0], y[1] * rstd * gv[1]); w.y = pk2(y[2] * rstd * gv[2], y[3] * rstd * gv[3]); w.z = pk2(y[4] * rstd * gv[4], y[5] * rstd * gv[5]); w.w = pk2(y[6] * rstd * gv[6], y[7] * rstd * gv[7]);
        *(v4u*)(YD + (size_t)row * 512 + F.lane * 8) = w;
    }
}

__device__ __forceinline__ void p7_route(Frame& F) {
    typedef float f32x16_t __attribute__((ext_vector_type(16)));
    LAS float* HS = (LAS float*)(F.lds + RING_OFF);
    LAS float* PL = (LAS float*)(F.lds + RING_OFF + 36864);
    LAS unsigned* lcnt = (LAS unsigned*)(F.lds + TAB_OFF);
    LAS int* prs = (LAS int*)(F.lds + TAB_OFF + 512);
    const bf16* X1 = WSP(bf16, WS_X1B); const float* MOD = WSP(float, WS_MOD); const float* wr = F.in[I_WR]; const float* br = F.in[I_BR];
    int* TOPE = WSP(int, WS_TOPE); int* RANK = WSP(int, WS_RANK);
    const int e = F.lane & 31, hh = F.lane >> 5, rt = F.wave & 1, kp = F.wave >> 1;
    const float bre = br[e];
    for (int grp = F.vcu; grp < M / 64; grp += F.G) {
        if (F.tid < 32) lcnt[F.tid] = 0u;
        const int row0 = grp * 64 + F.wave * 8, b = row0 / SEQ;
        f32x4 v[8][4];
#pragma unroll
        for (int r = 0; r < 8; ++r) { norm_mod_row_bf16(X1 + (size_t)(row0 + r) * DM, F.in[I_LN2G], MOD + (size_t)b * 6 * DM + 3 * DM, MOD + (size_t)b * 6 * DM + 4 * DM, F.lane, v[r]);
            { GAS unsigned* o4 = (GAS unsigned*)(WSP(unsigned char, WS_XN) + (size_t)(row0 + r) * DM) + F.lane;
#pragma unroll
              for (int j = 0; j < 4; ++j) o4[64 * j] = pack4_fp8(v[r][j].x, v[r][j].y, v[r][j].z, v[r][j].w); } }
        f32x16_t acc = f32x16_t{};
#pragma unroll
        for (int q = 0; q < 8; ++q) {
            __syncthreads();
            if (hh == (q & 1)) {
#pragma unroll
                for (int r = 0; r < 8; ++r) { LAS float* d_ = HS + (F.wave * 8 + r) * 129 + 4 * e; const f32x4 t_ = v[r][q >> 1]; d_[0] = t_.x; d_[1] = t_.y; d_[2] = t_.z; d_[3] = t_.w; } }
            __syncthreads();
            const LAS float* ap = HS + (rt * 32 + e) * 129 + 32 * kp + hh; const float* bp = wr + (size_t)(128 * q + 32 * kp + hh) * NE + e;
#pragma unroll
            for (int s2 = 0; s2 < 16; ++s2) acc = __builtin_amdgcn_mfma_f32_32x32x2f32(ap[2 * s2], bp[(size_t)(2 * s2) * NE], acc, 0, 0, 0);
        }
#pragma unroll
        for (int r = 0; r < 16; ++r) PL[(kp * 64 + rt * 32 + (r & 3) + 8 * (r >> 2) + 4 * hh) * 32 + e] = acc[r];
        __syncthreads();
#pragma unroll
        for (int it = 0; it < 4; ++it) {
            const int rl = F.wave * 8 + 2 * it + hh;
            float val = ((PL[(0 * 64 + rl) * 32 + e] + PL[(1 * 64 + rl) * 32 + e]) + (PL[(2 * 64 + rl) * 32 + e] + PL[(3 * 64 + rl) * 32 + e])) + bre;
            float tv[4]; int te[4];
#pragma unroll
            for (int kk = 0; kk < 4; ++kk) { float best = val; int bi = e;
#pragma unroll
                for (int o = 1; o < 32; o <<= 1) { const float ov = __shfl_xor(best, o); const int oi = __shfl_xor(bi, o); if (ov > best || (ov == best && oi < bi)) { best = ov; bi = oi; } }
                tv[kk] = best; te[kk] = bi; if (e == bi) val = -INFINITY; }
            const float p1 = __expf(tv[1] - tv[0]), p2 = __expf(tv[2] - tv[0]), p3 = __expf(tv[3] - tv[0]); const float inv = 1.0f / (1.0f + p1 + p2 + p3);
            if (e < 4) { const int me = e == 0 ? te[0] : e == 1 ? te[1] : e == 2 ? te[2] : te[3]; const float mg = (e == 0 ? 1.0f : e == 1 ? p1 : e == 2 ? p2 : p3) * inv;
                const int rk = (int)__hip_atomic_fetch_add(lcnt + me, 1u, __ATOMIC_RELAXED, __HIP_MEMORY_SCOPE_WORKGROUP);
                const int li = rl * 4 + e; prs[3 * li] = me; prs[3 * li + 1] = rk; prs[3 * li + 2] = (int)__float_as_uint(mg);
                TOPE[(size_t)(grp * 64 + rl) * 4 + e] = me; }
        }
        __syncthreads();
        if (F.tid < 32) lcnt[32 + F.tid] = __hip_atomic_fetch_add(F.ctl + CW_CNT + 64 * F.tid, lcnt[F.tid], __ATOMIC_RELAXED, __HIP_MEMORY_SCOPE_AGENT);
        __syncthreads();
        if (F.tid < 256) { const int me = prs[3 * F.tid], rk = (int)lcnt[32 + me] + prs[3 * F.tid + 1]; RANK[(size_t)grp * 256 + F.tid] = rk;
            WSP(int, WS_IDX)[(size_t)me * ECAP + rk] = grp * 64 + (F.tid >> 2); WSP(float, WS_GX)[(size_t)me * ECAP + rk] = __uint_as_float((unsigned)prs[3 * F.tid + 2]); }
        __syncthreads();
    }
}
__device__ __forceinline__ void load_expert_tables(Frame& F) {
    LAS int* tab = (LAS int*)(F.lds + TAB_OFF);
    if (F.tid < 32) tab[F.tid] = (int)__hip_atomic_load(F.ctl + CW_CNT + 64 * F.tid, __ATOMIC_RELAXED, __HIP_MEMORY_SCOPE_AGENT);
    __syncthreads();
    if (F.tid == 0) { int run = 0; for (int e = 0; e < 32; ++e) { const int mt = (tab[e] + 255) >> 8; tab[32 + e] = run; tab[65 + e] = mt; run += mt * 256; } tab[64] = run; }
    __syncthreads();
}
__device__ __forceinline__ int build_units(Frame& F, int NT) {
    load_expert_tables(F);
    LAS int* tab = (LAS int*)(F.lds + TAB_OFF); LAS int* lst = (LAS int*)(F.lds + TAB_OFF + 1024);
    if (F.tid == 0) { int n = 0; int total = 0; for (int e = 0; e < 32; ++e) total += tab[65 + e] * NT;
        for (int i = 0;; ++i) { const int L = i * F.G + F.vcu; if (L >= total || n >= 256) break;
            int e = 0, r = L; while (r >= tab[65 + e] * NT) { r -= tab[65 + e] * NT; ++e; }
            const int pn = r % NT, pml = r / NT;
            const int nr = tab[e] - 256 * pml;
            lst[6 * n] = (tab[32 + e] >> 8) + pml; lst[6 * n + 1] = pn; lst[6 * n + 2] = e * NT + pn; lst[6 * n + 3] = e; lst[6 * n + 4] = e * ECAP + 256 * pml; lst[6 * n + 5] = nr < 256 ? nr : 256; ++n; }
        tab[128] = n; }
    __syncthreads();
    return tab[128];
}
__device__ __forceinline__ void p11_final(Frame& F) {
    load_expert_tables(F); const LAS int* tab = (const LAS int*)(F.lds + TAB_OFF);
    const float* MOD = WSP(float, WS_MOD); const int* TOPE = WSP(int, WS_TOPE); const int* RANK = WSP(int, WS_RANK); const bf16* YP = WSP(bf16, WS_YP); const float* fg = F.in[I_FING];
    const int gw = F.vcu * NWAVES + F.wave, NGW = F.G * NWAVES;
    for (int rb = gw; rb < M; rb += 8 * NGW) {
    int myslot = 0; { const int prow = rb + (F.lane >> 2) * NGW; if (F.lane < 32 && prow < M) { const size_t pi = (size_t)prow * 4 + (F.lane & 3); myslot = tab[32 + TOPE[pi]] + RANK[pi]; } }
#pragma unroll 4
    for (int ri = 0; ri < 8; ++ri) { const int row = rb + ri * NGW; if (row >= M) break;
        const int b = row / SEQ; const float* g2 = MOD + (size_t)b * 6 * DM + 5 * DM;
        GAS f32x4* xr = (GAS f32x4*)(F.out + (size_t)row * DM) + F.lane; const GAS unsigned long long* x1r = (const GAS unsigned long long*)(WSP(bf16, WS_X1B) + (size_t)row * DM) + F.lane;
        int sl[4];
#pragma unroll
        for (int k = 0; k < 4; ++k) sl[k] = __shfl(myslot, ri * 4 + k);
        f32x4 v[4]; float s = 0.f;
#pragma unroll
        for (int j = 0; j < 4; ++j) { f32x4 y = (f32x4){0.f, 0.f, 0.f, 0.f};
#pragma unroll
            for (int k = 0; k < 4; ++k) { const unsigned long long w = *(const unsigned long long*)(YP + (size_t)sl[k] * DM + 256 * j + 4 * F.lane); const unsigned lo = (unsigned)w, hi = (unsigned)(w >> 32);
                y.x += bflo(lo); y.y += bfhi(lo); y.z += bflo(hi); y.w += bfhi(hi); }
            const f32x4 gg = ((const GAS f32x4*)g2)[64 * j + F.lane];
            { const unsigned long long w1 = x1r[64 * j]; const unsigned l1 = (unsigned)w1, h1 = (unsigned)(w1 >> 32); v[j] = (f32x4){bflo(l1), bfhi(l1), bflo(h1), bfhi(h1)} + gg * y; } s += (v[j].x * v[j].x + v[j].y * v[j].y) + (v[j].z * v[j].z + v[j].w * v[j].w); }
        const float rstd = 1.0f / sqrtf(wave_sum(s) * (1.0f / DM) + 1e-6f);
#pragma unroll
        for (int j = 0; j < 4; ++j) { const f32x4 gg = ((const GAS f32x4*)fg)[64 * j + F.lane]; xr[64 * j] = v[j] * rstd * gg; }
    }
    }
}

#ifndef MK_PER_PHASE
#define MK_PER_PHASE 0
#endif
#ifndef MK_REP_MASK
#define MK_REP_MASK 0
#endif
#ifndef MK_LAUNCH_SEQ
#define MK_LAUNCH_SEQ {0, N_PHASES}
#endif
constexpr int N_PHASES = 11;
struct Args { const float* in[25]; float* out; unsigned char* ws; int ph_lo, ph_hi; };
__global__ void __launch_bounds__(NWAVES * 64, 2) skel_fwd(Args args) {
    extern __shared__ __attribute__((aligned(16))) unsigned char lds[];
    Frame F;
    F.lds = (LAS unsigned char*)lds;
    F.MISC = (volatile LAS unsigned*)(F.lds + MISC_OFF);
    F.tid = threadIdx.x; F.lane = F.tid & 63; F.wave = __builtin_amdgcn_readfirstlane(F.tid >> 6);
    F.G = gridDim.x; { const int bx = blockIdx.x; F.vcu = (F.G % 8 == 0) ? (bx % 8) * (F.G / 8) + bx / 8 : bx; }
    F.ws = args.ws; F.out = args.out; F.ctl = (gu32*)(args.ws + WS_CTL);
#pragma unroll
    for (int i = 0; i < 25; ++i) F.in[i] = args.in[i];
    for (int u = F.tid; u < (LDS_BYTES - LDSCTL_OFF) / 4; u += NWAVES * 64) ((LAS unsigned*)(F.lds + LDSCTL_OFF))[u] = 0u;
    __syncthreads();
    XcdBarrier bar; bar.bar = (unsigned*)(F.ctl + CW_BAR); bar.x = 0; bar.st = nullptr;
    const int lo = args.ph_lo, hi = args.ph_hi;
    if (hi - lo > 1) bar = xcd_barrier_post((unsigned*)(F.ctl + CW_BAR), F.MISC + 8);
#define IN(k) (lo <= (k) && (k) < hi)
#define SEAM(k) do { if (IN(k) && IN((k) + 1)) xcd_barrier(bar); } while (0)
#define REFRESH_TID() do { int t_ = threadIdx.x; asm volatile("" : "+v"(t_)); F.tid = t_; F.lane = t_ & 63; } while (0)

    if (IN(0)) for (int rep_ = 0; rep_ <= ((MK_REP_MASK >> 0) & 1); ++rep_) { REFRESH_TID(); p0_prologue(F); } SEAM(0);
    if (IN(1)) for (int rep_ = 0; rep_ <= ((MK_REP_MASK >> 1) & 1); ++rep_) { REFRESH_TID(); p1_norm_fgate(F); } SEAM(1);
    if (IN(2)) for (int rep_ = 0; rep_ <= ((MK_REP_MASK >> 2) & 1); ++rep_) { REFRESH_TID();
        p2_finish_f(F); __syncthreads();
        { LAS float* lbm_ = (LAS float*)(F.lds + EPI_OFF); for (int q = F.tid; q < 2048; q += NWAVES * 64) lbm_[q] = F.in[I_BMERGE][q]; __syncthreads(); }
        pg8::Gemm g{WSP(pg8::bf16_t, WS_XN), WSP(pg8::bf16_t, WS_WIN), M, NPROJ, DM / 2, nullptr, 0u}; pg8::StaticOrder S; S.init(M, NPROJ, F.G, (int)blockIdx.x);
        epi::EpiProj E{WSP(pg8::bf16_t, WS_PROJ), (const PG8_LAS float*)(F.lds + EPI_OFF), (unsigned*)(F.ctl + CW_NRM)};
        pg8::gemm_phase<epi::EpiProj, pg8::StaticOrder, true, true, false, true>(F.lds + RING_OFF, g, S, E);
    } SEAM(2);
    if (IN(3)) for (int rep_ = 0; rep_ <= ((MK_REP_MASK >> 3) & 1); ++rep_) { REFRESH_TID();
        const attn_body::AttnBufs A{(const attn_body::bf16*)WSP(bf16, WS_PROJ), (attn_body::bf16*)WSP(bf16, WS_YFOX), (attn_body::bf16*)WSP(bf16, WS_OD), WSP(float, WS_F2), (const attn_body::bf16*)WSP(bf16, WS_KA), (const unsigned*)(F.ctl + CW_NRM)};
        {
            const int x = (int)blockIdx.x & 7; const bool conv_first = (((int)blockIdx.x >> 3) % 3) == 2;
            gu32* qa = F.ctl + CW_Q + 64 * (2 * x), * qc = F.ctl + CW_Q + 64 * (2 * x + 1);
            volatile LAS int* qs = (volatile LAS int*)(F.lds + TAB_OFF);
#define FETCH_(q) ({ if (F.tid == 0) qs[0] = (int)__hip_atomic_fetch_add(q, 1u, __ATOMIC_RELAXED, __HIP_MEMORY_SCOPE_AGENT); __syncthreads(); const int v_ = __builtin_amdgcn_readfirstlane(qs[0]); __syncthreads(); v_; })
#define CONV_LOOP_() do { for (;;) { REFRESH_TID(); const int v = FETCH_(qc); if (v >= 96) break; LAS float* scr = (LAS float*)(F.lds + RING_OFF + F.wave * 16384); const int base = (v * 8 + x) * 64 + F.wave * 8; \
                moe_weight_items8(F, base, scr); __syncthreads(); } } while (0)
            if (conv_first) CONV_LOOP_();
            attn_body::attn_build_lut((char*)lds + RING_OFF, WSP(float, WS_LUT));
            for (;;) { REFRESH_TID(); const int v = FETCH_(qa); if (v >= 128) break;
                const int j = 2 * x + (v & 1), qb = 31 - ((v & 63) >> 1);
                if (v < 64) attn_body::attn_run_diff<8>(A, j, qb, (char*)lds + RING_OFF); else attn_body::attn_run_fox<8>(A, j, qb, (char*)lds + RING_OFF); }
            if (!conv_first) CONV_LOOP_();
#undef FETCH_
#undef CONV_LOOP_
        }
    } SEAM(3);
    if (IN(4)) for (int rep_ = 0; rep_ <= ((MK_REP_MASK >> 4) & 1); ++rep_) { REFRESH_TID(); p4_diff_post(F); } SEAM(4);
    if (IN(5)) for (int rep_ = 0; rep_ <= ((MK_REP_MASK >> 5) & 1); ++rep_) { REFRESH_TID();
        { pg8::Gemm g{WSP(pg8::bf16_t, WS_YFOX), WSP(pg8::bf16_t, WS_WBF), M, DM, 512, nullptr, 0u}; pg8::StaticOrder S; S.init(M, DM, F.G, (int)blockIdx.x);
          epi::EpiBranch<0> E{WSP(pg8::bf16_t, WS_PROJ), nullptr, WSP(pg8::bf16_t, WS_T1)};
          pg8::gemm_phase<epi::EpiBranch<0>, pg8::StaticOrder, true, true>(F.lds + RING_OFF, g, S, E); }
        VM_WAIT(); __syncthreads();
        { pg8::Gemm g{WSP(pg8::bf16_t, WS_YD), WSP(pg8::bf16_t, WS_WBD), M, DM, 512, nullptr, 0u}; pg8::StaticOrder S; S.init(M, DM, F.G, (int)blockIdx.x);
          epi::EpiBranch<1> E{WSP(pg8::bf16_t, WS_PROJ), WSP(pg8::bf16_t, WS_T1), WSP(pg8::bf16_t, WS_MRG)};
          pg8::gemm_phase<epi::EpiBranch<1>, pg8::StaticOrder, true, true>(F.lds + RING_OFF, g, S, E); }
    } SEAM(5);
    if (IN(6)) for (int rep_ = 0; rep_ <= ((MK_REP_MASK >> 6) & 1); ++rep_) { REFRESH_TID();
        pg8::Gemm g{WSP(pg8::bf16_t, WS_MRG), WSP(pg8::bf16_t, WS_WO), M, DM, DM / 2, nullptr, 0u}; pg8::StaticOrder S; S.init(M, DM, F.G, (int)blockIdx.x);
        epi::EpiWo E{F.in[I_X], WSP(float, WS_MOD), WSP(pg8::bf16_t, WS_X1B)};
        pg8::gemm_phase<epi::EpiWo, pg8::StaticOrder, true, true, false, true>(F.lds + RING_OFF, g, S, E);
    } SEAM(6);
    if (IN(7)) for (int rep_ = 0; rep_ <= ((MK_REP_MASK >> 7) & 1); ++rep_) { REFRESH_TID(); p7_route(F); } SEAM(7);
    if (IN(8)) for (int rep_ = 0; rep_ <= ((MK_REP_MASK >> 8) & 1); ++rep_) { REFRESH_TID();
        const int n = build_units(F, NUP / 256);
        LAS unsigned short* tokt = (LAS unsigned short*)(F.lds + TOK_OFF);
        { const LAS int* lst_ = (const LAS int*)(F.lds + TAB_OFF + 1024); const int* idx_ = WSP(int, WS_IDX);
          for (int q = F.tid; q < n * 256; q += NWAVES * 64) { const int un = q >> 8, r = q & 255; tokt[q] = (unsigned short)((r < lst_[6 * un + 5]) ? idx_[lst_[6 * un + 4] + r] : 0); }
          __syncthreads(); }
        pg8::Gemm g{WSP(pg8::bf16_t, WS_XN), WSP(pg8::bf16_t, WS_WUP), PMAX, NUP, DM / 2, WSP(int, WS_IDX), 0u, (const PG8_LAS unsigned short*)tokt}; epi::ListOrder S{(const PG8_LAS int*)(F.lds + TAB_OFF + 1024), n};
        LAS float* lbu = (LAS float*)(F.lds + EPI_OFF);
        { const LAS int* lst_ = (const LAS int*)(F.lds + TAB_OFF + 1024); const float* bup_ = F.in[I_BUP];
          for (int q = F.tid; q < n * 256; q += NWAVES * 64) { const int un = q >> 8; lbu[q] = bup_[(size_t)lst_[6 * un + 3] * NUP + lst_[6 * un + 1] * 256 + (q & 255)]; }
          __syncthreads(); }
        epi::EpiUp E{(const PG8_LAS float*)lbu, WSP(unsigned char, WS_ACT)};
        pg8::gemm_phase<epi::EpiUp, epi::ListOrder, true, true, true, true>(F.lds + RING_OFF, g, S, E);
    } SEAM(8);
    if (IN(9)) for (int rep_ = 0; rep_ <= ((MK_REP_MASK >> 9) & 1); ++rep_) { REFRESH_TID();
        const int n = build_units(F, DM / 256);
        pg8::Gemm g{WSP(pg8::bf16_t, WS_ACT), WSP(pg8::bf16_t, WS_WDN), PMAX, DM, DFF / 2, nullptr, 0u}; epi::ListOrder S{(const PG8_LAS int*)(F.lds + TAB_OFF + 1024), n};
        LAS float* lbd = (LAS float*)(F.lds + EPI_OFF); LAS float* lgd = lbd + EPI_UNITS_DN * 256;
        { const LAS int* lst_ = (const LAS int*)(F.lds + TAB_OFF + 1024); const float* bdn_ = F.in[I_BDN]; const float* gx_ = WSP(float, WS_GX);
          for (int q = F.tid; q < n * 256; q += NWAVES * 64) { const int un = q >> 8, c = q & 255; lbd[q] = bdn_[(size_t)lst_[6 * un + 3] * DM + lst_[6 * un + 1] * 256 + c]; lgd[q] = gx_[(size_t)lst_[6 * un + 4] + c]; }
          __syncthreads(); }
        epi::EpiDown E{(const PG8_LAS float*)lbd, (const PG8_LAS float*)lgd, WSP(pg8::bf16_t, WS_YP)};
        pg8::gemm_phase<epi::EpiDown, epi::ListOrder, true, true, false, true>(F.lds + RING_OFF, g, S, E);
    } SEAM(9);
    if (IN(10)) for (int rep_ = 0; rep_ <= ((MK_REP_MASK >> 10) & 1); ++rep_) { REFRESH_TID(); p11_final(F); }
#undef IN
#undef SEAM
}

extern "C" void kernel_launch(void* const* d_in, const int* in_sizes, int n_in, void* d_out, int out_size, void* d_ws, size_t ws_size, hipStream_t stream) {
    static int grid = 0;
    if (grid == 0) {
        if (n_in != 25 || in_sizes[0] != M * DM || out_size != M * DM || ws_size < WS_END) { fprintf(stderr, "kernel_launch: unexpected problem (n_in %d, in0 %d, out %d, ws %zu, need %zu); nothing launched\n", n_in, n_in > 0 ? in_sizes[0] : -1, out_size, ws_size, (size_t)WS_END); grid = -1; return; }
        int dev = 0, cus = 0, per_cu = 0;
        if (hipGetDevice(&dev) != hipSuccess || hipDeviceGetAttribute(&cus, hipDeviceAttributeMultiprocessorCount, dev) != hipSuccess) { grid = -1; return; }
        if (hipFuncSetAttribute((const void*)skel_fwd, hipFuncAttributeMaxDynamicSharedMemorySize, LDS_BYTES) != hipSuccess) { fprintf(stderr, "kernel_launch: hipFuncSetAttribute failed\n"); grid = -1; return; }
        if (hipOccupancyMaxActiveBlocksPerMultiprocessor(&per_cu, (const void*)skel_fwd, NWAVES * 64, LDS_BYTES) != hipSuccess || per_cu < 1) { fprintf(stderr, "kernel_launch: occupancy query reports %d blocks per CU\n", per_cu); }
        (void)hipGetLastError();
        grid = cus;
        if ((PMAX / 256 * (NUP / 256) + cus - 1) / cus > TOK_UNITS || (PMAX / 256 * (NUP / 256) + cus - 1) / cus > EPI_UNITS_UP || (PMAX / 256 * (DM / 256) + cus - 1) / cus > EPI_UNITS_DN) { fprintf(stderr, "kernel_launch: %d CUs give more than %d expert units per workgroup (LDS row tables)\n", cus, TOK_UNITS); grid = -1; return; }
    }
    if (grid < 0) return;
    if (hipMemsetAsync((char*)d_ws + WS_CTL, 0, CTL_ZERO_BYTES, stream) != hipSuccess) { fprintf(stderr, "kernel_launch: memset failed\n"); return; }
    Args a{};
    for (int i = 0; i < 25; ++i) a.in[i] = (const float*)d_in[i];
    a.out = (float*)d_out; a.ws = (unsigned char*)d_ws;
#if MK_PER_PHASE
    for (int p = 0; p < N_PHASES; ++p) { a.ph_lo = p; a.ph_hi = p + 1; hipLaunchKernelGGL(skel_fwd, dim3(grid), dim3(NWAVES * 64), LDS_BYTES, stream, a); }
#else
    { const int seq[] = MK_LAUNCH_SEQ; constexpr int nseq = sizeof(seq) / sizeof(int) / 2;
      for (int p = 0; p < nseq; ++p) { a.ph_lo = seq[2 * p]; a.ph_hi = seq[2 * p + 1];
          if (p > 0) (void)hipMemsetAsync((char*)d_ws + WS_CTL, 0, CTL_ZERO_BYTES, stream);
          hipLaunchKernelGGL(skel_fwd, dim3(grid), dim3(NWAVES * 64), LDS_BYTES, stream, a); } }
#endif
    const hipError_t le = hipPeekAtLastError();
    if (le != hipSuccess) fprintf(stderr, "kernel_launch: launch failed: %s\n", hipGetErrorName(le));
}
```
